# Optimizing an MI355X kernel written in HIP

```python
import jax, jax.numpy as jnp
from jax import lax
import numpy as np

D_MODEL = 1024
BATCH = 8
SEQ = 4096
DEPTH = 2

CTX_LEN = 256
GRID_W = 64
D_GROUP = D_MODEL // 4
HG_HEADS = 4
HG_DK = D_GROUP // HG_HEADS
HG_DV = D_GROUP // HG_HEADS
HG_CHUNK = 16
RET_HEADS = 4
RET_DK = D_GROUP // RET_HEADS
RET_DV = D_GROUP // RET_HEADS
RET_CHUNK = 64
ROPE_BASE = 10000.0
GDN_HEADS = 4
GDN_DK = D_GROUP // GDN_HEADS
GDN_DV = D_GROUP // GDN_HEADS
GDN_CHUNK = 64
CONV_K = 3
S5_GROUP = 16
S5_GROUPS = D_GROUP // S5_GROUP
S5_STATE = 64
D_FF = 4 * D_MODEL
N_MOD = 6
EPS = 1e-6
LB_FLOOR = 1e-30
IN_SIZES = (D_GROUP, D_GROUP, D_GROUP, 2 * D_GROUP,
            D_GROUP, D_GROUP, D_GROUP, D_GROUP,
            3 * D_GROUP, D_GROUP, 2 * GDN_HEADS, 2 * GDN_HEADS,
            D_GROUP)
D_IN = sum(IN_SIZES)

kernel_name = 'hybrid_parallel_heads_dit_block'

F32 = jnp.float32


def rmsnorm(x, g):
    xf = x.astype(F32)
    return xf * lax.rsqrt(jnp.mean(xf * xf, axis=-1, keepdims=True) + EPS) * g.astype(F32)


def split_heads(a, h):
    return a.reshape(a.shape[:-1] + (h, a.shape[-1] // h))


def flip_t(a):
    return jnp.flip(a, axis=1)


def to_chunks(a, c):
    b, t = a.shape[:2]
    a = a.reshape((b, t // c, c) + a.shape[2:])
    return jnp.moveaxis(a, (1, 3), (0, 2))


def from_chunks(a):
    a = jnp.moveaxis(a, (0, 2), (1, 3))
    return a.reshape((a.shape[0], a.shape[1] * a.shape[2]) + a.shape[3:])


def gated_head_norm(o, gate, g):
    y = o * lax.rsqrt(jnp.mean(o * o, axis=-1, keepdims=True) + EPS)
    if g is not None:
        y = y * g.astype(F32)
    return y.reshape(gate.shape) * jax.nn.silu(gate)


def l2norm(a):
    return a * lax.rsqrt(jnp.sum(a * a, axis=-1, keepdims=True) + EPS)


def bidirectional_prefix_scan(core, ctx_seq, lat_seq, par, s0):
    outs_c, outs_l = [], []
    for d in range(2):
        tf = (lambda a: a) if d == 0 else flip_t
        oc, s_ctx = core(tuple(tf(a) for a in ctx_seq[d]), par[d], s0)
        ol, _ = core(tuple(tf(a) for a in lat_seq[d]), par[d], s_ctx)
        outs_c.append(tf(oc))
        outs_l.append(tf(ol))
    return outs_c[0] + outs_c[1], outs_l[0] + outs_l[1]


def gla_chunked(seq, par, s0):
    q, v, log_f = seq
    k = -jnp.expm1(log_f)
    bsz, t, h, _ = q.shape
    c = HG_CHUNK
    q, k, v, b = (to_chunks(a, c) for a in (q, k, v, log_f))
    b = jnp.cumsum(b, axis=3)
    tri = jnp.tril(jnp.ones((c, c), bool))[:, :, None]
    diff = b[..., :, None, :] - b[..., None, :, :]
    decay = jnp.where(tri, jnp.exp(jnp.minimum(diff, 0.0)), 0.0)
    attn = jnp.einsum('nbhik,nbhjk,nbhijk->nbhij', q, k, decay)
    o_intra = jnp.einsum('nbhij,nbhjv->nbhiv', attn, v)
    q_dec = q * jnp.exp(b)
    k_dec = k * jnp.exp(b[..., -1:, :] - b)
    c_dec = jnp.exp(b[..., -1, :])
    kv = jnp.einsum('nbhjk,nbhjv->nbhkv', k_dec, v)

    def step(s, xs):
        kv_n, cd_n = xs
        return s * cd_n[..., None] + kv_n, s

    s_fin, s_prev = lax.scan(step, s0, (kv, c_dec))
    o = o_intra + jnp.einsum('nbhik,nbhkv->nbhiv', q_dec, s_prev)
    return from_chunks(o), s_fin


def forget_log(f_raw, lb):
    return jnp.logaddexp(jnp.log(jnp.maximum(lb, LB_FLOOR)) + jax.nn.log_sigmoid(-f_raw),
                         jax.nn.log_sigmoid(f_raw))


def hgrn2_mixer(pc, pl, lb, norm_g):
    def prep(p):
        q, i, g, f = p
        q = split_heads(jax.nn.silu(q), HG_HEADS) * HG_DK ** -0.5
        v = split_heads(i, HG_HEADS)
        f_dir = jnp.split(f, 2, axis=-1)
        seqs = tuple((q, v, split_heads(forget_log(f_dir[d], lb[d]), HG_HEADS)) for d in range(2))
        return seqs, g
    sc, gc = prep(pc)
    sl, gl = prep(pl)
    s0 = jnp.zeros((pc[0].shape[0], HG_HEADS, HG_DK, HG_DV), F32)
    oc, ol = bidirectional_prefix_scan(gla_chunked, sc, sl, ((), ()), s0)
    return gated_head_norm(oc, gc, norm_g), gated_head_norm(ol, gl, norm_g)


def rope(x, pos):
    half = x.shape[-1] // 2
    inv = ROPE_BASE ** (-jnp.arange(half, dtype=F32) / half)
    ang = pos.astype(F32)[:, None] * inv[None, :]
    cos = jnp.cos(ang)[None, :, None, :]
    sin = jnp.sin(ang)[None, :, None, :]
    x1, x2 = x[..., :half], x[..., half:]
    return jnp.concatenate([x1 * cos - x2 * sin, x1 * sin + x2 * cos], axis=-1)


def retention_chunked(seq, par, s0):
    q, k, v = seq
    (log_g,) = par
    c = RET_CHUNK
    q, k, v = (to_chunks(a, c) for a in (q, k, v))
    idx = jnp.arange(c, dtype=F32)
    lg = log_g[:, None]
    rel = idx[:, None] - idx[None, :]
    dmat = jnp.where(rel >= 0, jnp.exp(jnp.maximum(rel, 0.0)[None] * lg[..., None]), 0.0)
    attn = jnp.einsum('nbhik,nbhjk->nbhij', q, k) * dmat
    o_intra = jnp.einsum('nbhij,nbhjv->nbhiv', attn, v)
    q_dec = jnp.exp((idx + 1.0)[None, :] * lg)
    k_dec = jnp.exp((c - 1.0 - idx)[None, :] * lg)
    c_dec = jnp.exp(c * log_g)
    kv = jnp.einsum('nbhjk,hj,nbhjv->nbhkv', k, k_dec, v)

    def step(s, kv_n):
        return s * c_dec[:, None, None] + kv_n, s

    s_fin, s_prev = lax.scan(step, s0, kv)
    o = o_intra + jnp.einsum('nbhik,hi,nbhkv->nbhiv', q, q_dec, s_prev)
    return from_chunks(o), s_fin


def retention_mixer(pc, pl, log_gamma, pos_c, pos_l):
    def prep(p, pos):
        q, k, v, g = p
        q = rope(split_heads(q, RET_HEADS), pos)
        k = rope(split_heads(k, RET_HEADS), pos) * RET_DK ** -0.5
        s = (q, k, split_heads(v, RET_HEADS))
        return (s, s), g
    sc, gc = prep(pc, pos_c)
    sl, gl = prep(pl, pos_l)
    s0 = jnp.zeros((pc[0].shape[0], RET_HEADS, RET_DK, RET_DV), F32)
    par = ((log_gamma[0],), (log_gamma[1],))
    oc, ol = bidirectional_prefix_scan(retention_chunked, sc, sl, par, s0)
    return gated_head_norm(oc, gc, None), gated_head_norm(ol, gl, None)


def gated_delta_chunked(seq, par, s0):
    c = GDN_CHUNK
    q, k, v, log_a, beta = (to_chunks(a, c) for a in seq)
    dv = v.shape[-1]
    g = jnp.cumsum(log_a, axis=-1)
    tri = jnp.tril(jnp.ones((c, c), bool))
    strict = jnp.tril(jnp.ones((c, c), bool), -1)
    diff = g[..., :, None] - g[..., None, :]
    lmat = jnp.where(tri, jnp.exp(jnp.minimum(diff, 0.0)), 0.0)
    kb = k * beta[..., None]
    a_mat = jnp.where(strict, jnp.einsum('nbhik,nbhjk->nbhij', kb, k) * lmat, 0.0)
    rhs = jnp.concatenate([v * beta[..., None], kb * jnp.exp(g)[..., None]], axis=-1)
    uw = lax.linalg.triangular_solve(a_mat + jnp.eye(c, dtype=F32), rhs, left_side=True, lower=True)
    u, w = uw[..., :dv], uw[..., dv:]
    qk = jnp.where(tri, jnp.einsum('nbhik,nbhjk->nbhij', q, k) * lmat, 0.0)
    q_dec = q * jnp.exp(g)[..., None]
    k_dec = k * jnp.exp(g[..., -1:] - g)[..., None]
    c_dec = jnp.exp(g[..., -1])

    def step(s, xs):
        u_n, w_n, qk_n, qd_n, kd_n, cd_n = xs
        v_new = u_n - jnp.einsum('bhck,bhkv->bhcv', w_n, s)
        o_n = jnp.einsum('bhck,bhkv->bhcv', qd_n, s) + jnp.einsum('bhij,bhjv->bhiv', qk_n, v_new)
        s = s * cd_n[..., None, None] + jnp.einsum('bhck,bhcv->bhkv', kd_n, v_new)
        return s, o_n

    s_fin, o = lax.scan(step, s0, (u, w, qk, q_dec, k_dec, c_dec))
    return from_chunks(o), s_fin


def depthwise_conv2d(x, w):
    ch = x.shape[-1]
    return lax.conv_general_dilated(x, w[:, :, None, :], window_strides=(1, 1), padding='SAME',
                                    dimension_numbers=('NHWC', 'HWIO', 'NHWC'),
                                    feature_group_count=ch)


def gdn_mixer(pc, pl, rows, conv_w, a_log, dt_bias, norm_g):
    conv_w = conv_w.astype(F32)

    def prep(p, n_rows):
        qkv, g, a, b = p
        bsz, t, ch = qkv.shape
        grid = qkv.reshape(bsz, n_rows, t // n_rows, ch)
        qkv = jax.nn.silu(depthwise_conv2d(grid, conv_w)).reshape(bsz, t, ch)
        q, k, v = jnp.split(qkv, 3, axis=-1)
        q = l2norm(split_heads(q, GDN_HEADS)) * GDN_DK ** -0.5
        k = l2norm(split_heads(k, GDN_HEADS))
        v = split_heads(v, GDN_HEADS)
        a_dir = jnp.split(a, 2, axis=-1)
        b_dir = jnp.split(b, 2, axis=-1)
        seqs = tuple((q, k, v,
                      -jnp.exp(a_log[d]) * jax.nn.softplus(a_dir[d] + dt_bias[d]),
                      jax.nn.sigmoid(b_dir[d])) for d in range(2))
        return seqs, g
    sc, gc = prep(pc, 1)
    sl, gl = prep(pl, rows)
    s0 = jnp.zeros((pc[0].shape[0], GDN_HEADS, GDN_DK, GDN_DV), F32)
    oc, ol = bidirectional_prefix_scan(gated_delta_chunked, sc, sl, ((), ()), s0)
    return gated_head_norm(oc, gc, norm_g), gated_head_norm(ol, gl, norm_g)


def s5_core(seq, par, s0):
    (u,) = seq
    lam_re, lam_im, log_dt, b_re, b_im, c_re, c_im = par
    bsz, t, _ = u.shape
    ug = u.reshape(bsz, t, S5_GROUPS, S5_GROUP)
    dt = jnp.exp(log_dt)[:, None]
    mag = jnp.exp(lam_re * dt)
    ar, ai = mag * jnp.cos(lam_im * dt), mag * jnp.sin(lam_im * dt)
    den = lam_re * lam_re + lam_im * lam_im
    nr, ni = ar - 1.0, ai
    fr = (nr * lam_re + ni * lam_im) / den
    fi = (ni * lam_re - nr * lam_im) / den
    bbr = fr[..., None] * b_re - fi[..., None] * b_im
    bbi = fr[..., None] * b_im + fi[..., None] * b_re
    xr = jnp.einsum('gpc,btgc->tbgp', bbr, ug)
    xi = jnp.einsum('gpc,btgc->tbgp', bbi, ug)
    h0r, h0i = s0
    xr = xr.at[0].add(ar * h0r - ai * h0i)
    xi = xi.at[0].add(ar * h0i + ai * h0r)
    a_r = jnp.broadcast_to(ar, (t, 1) + ar.shape)
    a_i = jnp.broadcast_to(ai, (t, 1) + ai.shape)

    def combine(e1, e2):
        a1r, a1i, b1r, b1i = e1
        a2r, a2i, b2r, b2i = e2
        return (a2r * a1r - a2i * a1i, a2r * a1i + a2i * a1r,
                a2r * b1r - a2i * b1i + b2r, a2r * b1i + a2i * b1r + b2i)

    _, _, hr, hi = lax.associative_scan(combine, (a_r, a_i, xr, xi), axis=0)
    y = jnp.einsum('gcp,tbgp->btgc', c_re, hr) - jnp.einsum('gcp,tbgp->btgc', c_im, hi)
    return y.reshape(bsz, t, D_GROUP), (hr[-1], hi[-1])


def s5_mixer(uc, ul, lam_re, lam_im, log_dt, b_re, b_im, c_re, c_im, d_skip, glu_w, glu_b):
    f = lambda a: a.astype(F32)
    par = tuple((f(lam_re[d]), f(lam_im[d]), f(log_dt[d]), f(b_re), f(b_im), f(c_re), f(c_im))
                for d in range(2))
    zero = jnp.zeros((uc.shape[0], S5_GROUPS, S5_STATE), F32)
    oc, ol = bidirectional_prefix_scan(s5_core, ((uc,), (uc,)), ((ul,), (ul,)), par, (zero, zero))

    def finish(y, u):
        y = jax.nn.gelu(y + u * f(d_skip))
        return y * jax.nn.sigmoid(y @ f(glu_w) + f(glu_b))
    return finish(oc, uc), finish(ol, ul)


def split_cols(z):
    parts = jnp.split(z.astype(F32), np.cumsum(IN_SIZES)[:-1].tolist(), axis=-1)
    hq, hi, hg, hf, rq, rk, rv, rg, gqkv, gg, ga, gb, su = parts
    return (hq, hi, hg, hf), (rq, rk, rv, rg), (gqkv, gg, ga, gb), su


def hybrid_mixer(hc, hl, rows, pos_c, pos_l, need_ctx, w_in, lb, hg_norm_g, ret_log_gamma,
                 conv_w, a_log, dt_bias, gdn_norm_g, lam_re, lam_im, log_dt, b_re, b_im,
                 c_re, c_im, d_skip, glu_w, glu_b, w_out):
    pc = split_cols(hc @ w_in)
    pl = split_cols(hl @ w_in)
    a_c, a_l = hgrn2_mixer(pc[0], pl[0], lb, hg_norm_g)
    r_c, r_l = retention_mixer(pc[1], pl[1], ret_log_gamma, pos_c, pos_l)
    g_c, g_l = gdn_mixer(pc[2], pl[2], rows, conv_w, a_log.astype(F32), dt_bias.astype(F32), gdn_norm_g)
    s_c, s_l = s5_mixer(pc[3], pl[3], lam_re, lam_im, log_dt, b_re, b_im, c_re, c_im, d_skip, glu_w, glu_b)
    y_l = jnp.concatenate([a_l, r_l, g_l, s_l], axis=-1) @ w_out.astype(F32)
    y_c = jnp.concatenate([a_c, r_c, g_c, s_c], axis=-1) @ w_out.astype(F32) if need_ctx else None
    return y_c, y_l


def modulation(cvec, w, b):
    m = jax.nn.silu(cvec.reshape(-1, cvec.shape[-1]).astype(F32)) @ w.astype(F32) + b.astype(F32)
    return jnp.split(m[:, None, :], N_MOD, axis=-1)


def modulate(h, shift, scale):
    return h * (1.0 + scale) + shift


def sqrelu_mlp(h, w1, w2):
    return jnp.square(jax.nn.relu(h @ w1.astype(F32))) @ w2.astype(F32)


def setup_inputs(seed: int = 0) -> dict:
    key = jax.random.key(seed)
    ks = jax.random.split(key, 32)
    L, D, G, P = DEPTH, D_MODEL, S5_GROUPS, S5_STATE

    def nrm(k, shape, s=1.0):
        return s * jax.random.normal(k, shape, F32)

    ret_logit = jnp.log(2.0 ** (5.0 + jnp.arange(RET_HEADS, dtype=F32)) - 1.0)
    lo, hi = float(np.log(1e-3)), float(np.log(1e-1))
    gdn_dt = jnp.exp(jax.random.uniform(ks[16], (L, 2, GDN_HEADS), F32, lo, hi))
    return {
        'x': nrm(ks[0], (BATCH, SEQ, D)),
        'c': nrm(ks[1], (BATCH, D)),
        'ctx': nrm(ks[2], (BATCH, CTX_LEN, D)),
        'c_ctx': nrm(ks[3], (D,)),
        'mod_w': nrm(ks[4], (L, D, N_MOD * D), 0.5 * D ** -0.5),
        'mod_b': nrm(ks[5], (L, N_MOD * D), 0.02),
        'norm1_g': 1.0 + nrm(ks[6], (L, D), 0.02),
        'norm2_g': 1.0 + nrm(ks[7], (L, D), 0.02),
        'w_in': nrm(ks[8], (L, D, D_IN), D ** -0.5),
        'hgrn_lb_logits': nrm(ks[9], (L, 2, D_GROUP), 0.1),
        'hgrn_norm_g': 1.0 + nrm(ks[10], (L, HG_DV), 0.02),
        'ret_decay_logit': ret_logit + nrm(ks[11], (L, 2, RET_HEADS), 0.05),
        'gdn_conv_w': nrm(ks[12], (L, CONV_K, CONV_K, 3 * D_GROUP), 1.0 / CONV_K),
        'gdn_a_log': jnp.log(jax.random.uniform(ks[13], (L, 2, GDN_HEADS), F32, 1.0, 16.0)),
        'gdn_dt_bias': gdn_dt + jnp.log(-jnp.expm1(-gdn_dt)),
        'gdn_norm_g': 1.0 + nrm(ks[14], (L, GDN_DV), 0.02),
        's5_lam_re': -0.5 + nrm(ks[15], (L, 2, G, P), 0.01),
        's5_lam_im': jnp.pi * jnp.arange(P, dtype=F32) + nrm(ks[17], (L, 2, G, P), 0.01),
        's5_log_dt': jax.random.uniform(ks[18], (L, 2, G), F32, lo, hi),
        's5_b_re': nrm(ks[19], (L, G, P, S5_GROUP), (2 * S5_GROUP) ** -0.5),
        's5_b_im': nrm(ks[20], (L, G, P, S5_GROUP), (2 * S5_GROUP) ** -0.5),
        's5_c_re': nrm(ks[21], (L, G, S5_GROUP, P), P ** -0.5),
        's5_c_im': nrm(ks[22], (L, G, S5_GROUP, P), P ** -0.5),
        's5_d': nrm(ks[23], (L, D_GROUP)),
        's5_glu_w': nrm(ks[24], (L, D_GROUP, D_GROUP), D_GROUP ** -0.5),
        's5_glu_b': nrm(ks[25], (L, D_GROUP), 0.02),
        'w_out': nrm(ks[26], (L, D, D), D ** -0.5),
        'mlp_w1': nrm(ks[27], (L, D, D_FF), D ** -0.5),
        'mlp_w2': nrm(ks[28], (L, D_FF, D), D_FF ** -0.5),
        'final_norm_g': 1.0 + nrm(ks[29], (D,), 0.02),
    }


def reference(x, c, ctx, c_ctx, mod_w, mod_b, norm1_g, norm2_g, w_in, hgrn_lb_logits, hgrn_norm_g,
              ret_decay_logit, gdn_conv_w, gdn_a_log, gdn_dt_bias, gdn_norm_g, s5_lam_re, s5_lam_im,
              s5_log_dt, s5_b_re, s5_b_im, s5_c_re, s5_c_im, s5_d, s5_glu_w, s5_glu_b, w_out,
              mlp_w1, mlp_w2, final_norm_g):
    t_lat, t_ctx = x.shape[1], ctx.shape[1]
    rows = t_lat // GRID_W
    pos_c = jnp.arange(t_ctx)
    pos_l = t_ctx + jnp.arange(t_lat)
    sm = jax.nn.softmax(hgrn_lb_logits.astype(F32), axis=0)
    lbs = jnp.cumsum(sm, axis=0) - sm[:1]
    for l in range(DEPTH):
        need_ctx = l < DEPTH - 1
        ml = modulation(c, mod_w[l], mod_b[l])
        mc = modulation(c_ctx, mod_w[l], mod_b[l])
        hl = modulate(rmsnorm(x, norm1_g[l]), ml[0], ml[1])
        hc = modulate(rmsnorm(ctx, norm1_g[l]), mc[0], mc[1])
        y_c, y_l = hybrid_mixer(
            hc, hl, rows, pos_c, pos_l, need_ctx, w_in[l].astype(F32), lbs[l], hgrn_norm_g[l],
            jax.nn.log_sigmoid(ret_decay_logit[l].astype(F32)), gdn_conv_w[l], gdn_a_log[l],
            gdn_dt_bias[l], gdn_norm_g[l], s5_lam_re[l], s5_lam_im[l], s5_log_dt[l], s5_b_re[l],
            s5_b_im[l], s5_c_re[l], s5_c_im[l], s5_d[l], s5_glu_w[l], s5_glu_b[l], w_out[l])
        x = x + (ml[2] * y_l).astype(x.dtype)
        h2 = modulate(rmsnorm(x, norm2_g[l]), ml[3], ml[4])
        x = x + (ml[5] * sqrelu_mlp(h2, mlp_w1[l], mlp_w2[l])).astype(x.dtype)
        if need_ctx:
            ctx = ctx + (mc[2] * y_c).astype(ctx.dtype)
            h2c = modulate(rmsnorm(ctx, norm2_g[l]), mc[3], mc[4])
            ctx = ctx + (mc[5] * sqrelu_mlp(h2c, mlp_w1[l], mlp_w2[l])).astype(ctx.dtype)
    return rmsnorm(x, final_norm_g).astype(x.dtype)
```

```cpp
#include <hip/hip_runtime.h>
#include <hip/hip_cooperative_groups.h>
#include <cstdio>
#include <cstdint>
namespace cg = cooperative_groups;

#ifndef MK_MULTI
#define MK_MULTI 1
#endif

#define LAS __attribute__((address_space(3)))
typedef unsigned short bf16_t;
typedef short bf16x8 __attribute__((ext_vector_type(8)));
typedef float f32x4 __attribute__((ext_vector_type(4)));
typedef float f32x2 __attribute__((ext_vector_type(2)));
typedef unsigned u32x4 __attribute__((ext_vector_type(4)));
typedef unsigned u32x2 __attribute__((ext_vector_type(2)));

constexpr int NB = 8, TLAT = 4096, TCTX = 256, DM = 1024, DEPTH = 2, DG = 256, DIN = 3600, NZ = 3584, DFF = 4096;
constexpr int MCTX = NB * TCTX, MLAT = NB * TLAT, MALL = MCTX + MLAT;
constexpr int TSEQ = TCTX + TLAT;
constexpr float EPS = 1e-6f;
constexpr int ZC_HQ = 0, ZC_HI = 256, ZC_HG = 512, ZC_HF = 768, ZC_RQ = 1280, ZC_RK = 1536, ZC_RV = 1792, ZC_RG = 2048, ZC_GQKV = 2304, ZC_GG = 3072, ZC_SU = 3328;

constexpr size_t SZ_WIN = (size_t)NZ * DM * 2, SZ_WOUT = (size_t)DM * DM * 2, SZ_W1 = (size_t)DFF * DM * 2, SZ_W2 = (size_t)DM * DFF * 2, SZ_GLU = (size_t)DG * DG * 2, SZ_WAB = 16 * DM * 4;
constexpr size_t SZ_WL = SZ_WIN + SZ_WOUT + SZ_W1 + SZ_W2 + SZ_GLU + SZ_WAB;
constexpr size_t WS_W = 0;
constexpr size_t WS_MOD = WS_W + 2 * SZ_WL;
constexpr size_t WS_ROPE = WS_MOD + (size_t)2 * 9 * 6144 * 4;
constexpr size_t WS_LB = WS_ROPE + (size_t)TSEQ * 32 * 2 * 4;
constexpr size_t WS_S5P = WS_LB + 4096;
constexpr size_t WS_XC = WS_S5P + (size_t)2 * 2 * 16 * 64 * 34 * 4;
constexpr size_t WS_AB = WS_XC + (size_t)MCTX * DM * 4;
constexpr size_t WS_HB = WS_AB + (size_t)MALL * 16 * 4;
constexpr size_t WS_Z = WS_HB + (size_t)MALL * DM * 2;
constexpr size_t WS_OF = WS_Z + (size_t)MALL * NZ * 2;
constexpr size_t WS_OB = WS_OF + (size_t)MALL * DM * 2;
constexpr size_t WS_END = WS_OB + (size_t)MALL * DM * 2;
constexpr size_t WS_U = WS_Z;
static_assert(WS_U + (size_t)MALL * DFF * 2 <= WS_END, "U overlay");
static_assert(WS_MOD % 256 == 0 && WS_ROPE % 256 == 0 && WS_S5P % 256 == 0 && WS_XC % 256 == 0 && WS_AB % 256 == 0 && WS_HB % 256 == 0 && WS_Z % 256 == 0 && WS_OF % 256 == 0, "align");

constexpr int LDS_BYTES = 147456;
constexpr int NPHASE = 22;

struct Params {
    const float* in[30];
    float* out;
    unsigned char* ws;
    int ph_lo, ph_hi;
};
typedef const __attribute__((address_space(4))) Params* KP;
struct TC { int tid, bid, G; };

__device__ __forceinline__ unsigned f2bf(float f) { unsigned u = __builtin_bit_cast(unsigned, f); return (u + 0x7fffu + ((u >> 16) & 1u)) >> 16; }
__device__ __forceinline__ unsigned pk2(float lo, float hi) { return f2bf(lo) | (f2bf(hi) << 16); }
__device__ __forceinline__ float bflo(unsigned w) { return __builtin_bit_cast(float, w << 16); }
__device__ __forceinline__ float bfhi(unsigned w) { return __builtin_bit_cast(float, w & 0xffff0000u); }
__device__ __forceinline__ float wave_sum(float v) {
#pragma unroll
    for (int o = 1; o < 64; o <<= 1) v += __shfl_xor(v, o);
    return v;
}
__device__ __forceinline__ float quad_sum(float x) {
    x += __builtin_bit_cast(float, __builtin_amdgcn_mov_dpp(__builtin_bit_cast(int, x), 0xB1, 0xf, 0xf, true));
    x += __builtin_bit_cast(float, __builtin_amdgcn_mov_dpp(__builtin_bit_cast(int, x), 0x4E, 0xf, 0xf, true));
    return x;
}
__device__ __forceinline__ float sigmoidf_(float x) { return __builtin_amdgcn_rcpf(1.0f + __builtin_amdgcn_exp2f(-1.4426950408889634f * x)); }
__device__ __forceinline__ float siluf_(float x) { return x / (1.0f + __expf(-x)); }
__device__ __forceinline__ float gelu_tanh(float x) { const float u = 0.7978845608028654f * (x + 0.044715f * x * x * x); return 0.5f * x * (1.0f + tanhf(u)); }
__device__ __forceinline__ float reduce16(float (&p)[16], int lane) {
    bool b = (lane & 32) != 0;
#pragma unroll
    for (int i = 0; i < 8; ++i) { const float keep = b ? p[i + 8] : p[i], send = b ? p[i] : p[i + 8]; p[i] = keep + __shfl_xor(send, 32); }
    b = (lane & 16) != 0;
#pragma unroll
    for (int i = 0; i < 4; ++i) { const float keep = b ? p[i + 4] : p[i], send = b ? p[i] : p[i + 4]; p[i] = keep + __shfl_xor(send, 16); }
    b = (lane & 8) != 0;
#pragma unroll
    for (int i = 0; i < 2; ++i) { const float keep = b ? p[i + 2] : p[i], send = b ? p[i] : p[i + 2]; p[i] = keep + __shfl_xor(send, 8); }
    b = (lane & 4) != 0;
    { const float keep = b ? p[1] : p[0], send = b ? p[0] : p[1]; p[0] = keep + __shfl_xor(send, 4); }
    p[0] += __shfl_xor(p[0], 2); p[0] += __shfl_xor(p[0], 1);
    return p[0];
}
__device__ __forceinline__ int seq_row(int b, int d, int j) {
    if (j < TCTX) return b * TCTX + (d ? (TCTX - 1 - j) : j);
    const int t = j - TCTX; return MCTX + b * TLAT + (d ? (TLAT - 1 - t) : t);
}

namespace pg8 {
constexpr int BM = 256, BK = 64, HALF = 128, HTB = HALF * BK * 2, STAGE_BYTES = 8 * HTB, NXCD = 8, WGM = 8;
__host__ __device__ __forceinline__ int lds_byte(int r, int c) { const int st = (r >> 4) * 2 + (c >> 5), rr = r & 15, cc = c & 31, ob = rr * 64 + cc * 2; return st * 1024 + (ob ^ (((ob >> 9) & 1) << 5)); }
__host__ __device__ __forceinline__ void stage_rc(int b, int& R, int& C) { const int st = b / 1024, sb = b % 1024, swz = sb ^ (((sb >> 9) & 1) << 5); R = (st >> 1) * 16 + swz / 64; C = (st & 1) * 32 + (swz % 64) / 2; }
__host__ __device__ __forceinline__ int perm32(int rho) { const int n = rho >> 4, i = rho & 15; return 8 * (i >> 2) + 4 * n + (i & 3); }
struct Unit { int pm, pn; };
struct Gemm { const bf16_t* A; const bf16_t* Bt; int M, N, K, lda; };
struct StaticOrder {
    int nM, nN, nwg, G, c;
    __device__ void init(int M, int N, int G_, int c_) { nM = M / BM; nN = N / BM; nwg = nM * nN; G = G_; c = c_; }
    __device__ bool next(int i, Unit& u) const {
        const long L = (long)i * G + c; if (L >= nwg) return false;
        int wgid = (int)L; { const int q = nwg / NXCD, r = nwg % NXCD, xcd = wgid % NXCD, off = wgid / NXCD; wgid = (xcd < r ? xcd * (q + 1) : r * (q + 1) + (xcd - r) * q) + off; }
        const int nig = WGM * nN, gid = wgid / nig, fm = gid * WGM, gsz = (nM - fm) < WGM ? (nM - fm) : WGM;
        u.pm = fm + ((wgid % nig) % gsz); u.pn = (wgid % nig) / gsz; return true;
    }
};
template <class Epi>
__device__ __forceinline__ void gemm_phase(const TC tc, LAS unsigned char* lds, const Gemm g, const StaticOrder& S, const Epi& E) {
    const int tid = tc.tid, wid = __builtin_amdgcn_readfirstlane(tid >> 6), lane = tid & 63, wr = wid >> 2, wc = wid & 3, fr = lane & 15, fq = lane >> 4;
    const int K = g.K, nt = K / BK, lda = g.lda;
    unsigned voffA[2], voffB[2];
#pragma unroll
    for (int i = 0; i < 2; ++i) { int R, C; stage_rc(tid * 16 + i * 8192, R, C); const int Rb = Epi::PERM ? ((R & ~31) + perm32(R & 31)) : R;
        voffA[i] = (unsigned)(R * lda + C) * 2u; voffB[i] = (unsigned)(Rb * K + C) * 2u; }
    const size_t kstep = (size_t)(BK * 2);
    const size_t hstepA = (size_t)HALF * lda * 2, hstepB = (size_t)HALF * K * 2;
    const size_t tstepA = 2 * hstepA, tstepB = 2 * hstepB;
    const unsigned ldsw = (unsigned)wid * 1024u;
    const int aoff = lds_byte(wr * 64 + fr, fq * 8), boff = lds_byte(wc * 32 + fr, fq * 8);
#define PG8_SA(b, h) (((b) * 2 + (h)) * HTB)
#define PG8_SB(b, h) ((4 + (b) * 2 + (h)) * HTB)
#define PG8_STAGE(bufoff, gbase, voff) do { _Pragma("unroll") for (int _i = 0; _i < 2; ++_i) \
        __builtin_amdgcn_global_load_lds((const unsigned*)((const char*)(gbase) + (voff)[_i]), (LAS unsigned*)(lds + (bufoff) + ldsw + _i * 8192), 16, 0, 0); } while (0)
#define PG8_LDA(dst, b, h) do { _Pragma("unroll") for (int m = 0; m < 4; ++m) _Pragma("unroll") for (int k = 0; k < 2; ++k) dst[m][k] = *(const LAS bf16x8*)(lds + PG8_SA(b, h) + aoff + m * 2048 + k * 1024); } while (0)
#define PG8_LDB(dst, b, h) do { _Pragma("unroll") for (int n = 0; n < 2; ++n) _Pragma("unroll") for (int k = 0; k < 2; ++k) dst[n][k] = *(const LAS bf16x8*)(lds + PG8_SB(b, h) + boff + n * 2048 + k * 1024); } while (0)
#define PG8_MMA(ai, bj, At, Bt) do { __builtin_amdgcn_s_setprio(1); _Pragma("unroll") for (int m = 0; m < 4; ++m) _Pragma("unroll") for (int n = 0; n < 2; ++n) _Pragma("unroll") for (int k = 0; k < 2; ++k) \
        acc[ai][bj][m][n] = __builtin_amdgcn_mfma_f32_16x16x32_bf16(Bt[n][k], At[m][k], acc[ai][bj][m][n], 0, 0, 0); __builtin_amdgcn_s_setprio(0); } while (0)
#define PG8_WAIT_V(n) asm volatile("s_waitcnt vmcnt(" #n ")" ::: "memory")
#define PG8_WAIT_L(n) asm volatile("s_waitcnt lgkmcnt(" #n ")" ::: "memory")
#define PG8_BAR __builtin_amdgcn_s_barrier()
#define PG8_SCHED __builtin_amdgcn_sched_barrier(0)
    Unit cur, nxt; int ui = 0;
    if (!S.next(0, cur)) return;
    f32x4 acc[2][2][4][2];
#pragma unroll
    for (int a = 0; a < 2; ++a)
#pragma unroll
        for (int b = 0; b < 2; ++b)
#pragma unroll
            for (int m = 0; m < 4; ++m)
#pragma unroll
                for (int n = 0; n < 2; ++n) acc[a][b][m][n] = (f32x4){0.f, 0.f, 0.f, 0.f};
    bf16x8 At[4][2], B0[2][2], B1[2][2];
    const char* cA = (const char*)g.A + (size_t)cur.pm * tstepA; const char* cB = (const char*)g.Bt + (size_t)cur.pn * tstepB;
    PG8_STAGE(PG8_SB(0, 0), cB, voffB); PG8_STAGE(PG8_SB(0, 1), cB + hstepB, voffB); PG8_STAGE(PG8_SA(0, 0), cA, voffA); PG8_STAGE(PG8_SA(0, 1), cA + hstepA, voffA);
    if (wr == 1) PG8_BAR;
    PG8_WAIT_V(2); PG8_BAR;
    PG8_STAGE(PG8_SB(1, 0), cB + kstep, voffB); PG8_STAGE(PG8_SA(1, 0), cA + kstep, voffA); PG8_STAGE(PG8_SB(1, 1), cB + hstepB + kstep, voffB);
    PG8_WAIT_V(6); PG8_BAR;
    for (;;) {
        const bool has_next = S.next(ui + 1, nxt);
        const char* nA = has_next ? (const char*)g.A + (size_t)nxt.pm * tstepA : cA; const char* nB = has_next ? (const char*)g.Bt + (size_t)nxt.pn * tstepB : cB;
        for (int t = 0; t < nt; t += 2) {
            const bool last = (t == nt - 2);
            const char* a1 = cA + (size_t)(t + 1) * kstep;
            const char* a2 = last ? nA : cA + (size_t)(t + 2) * kstep; const char* b2 = last ? nB : cB + (size_t)(t + 2) * kstep;
            const char* a3 = a2 + kstep; const char* b3 = b2 + kstep;
            PG8_LDB(B0, 0, 0); PG8_LDB(B1, 0, 1); PG8_SCHED; PG8_LDA(At, 0, 0); PG8_STAGE(PG8_SA(1, 1), a1 + hstepA, voffA);
            PG8_WAIT_V(8); PG8_WAIT_L(0); PG8_BAR; PG8_MMA(0, 0, At, B0); PG8_MMA(0, 1, At, B1); PG8_BAR; PG8_SCHED;
            PG8_LDA(At, 0, 1); PG8_STAGE(PG8_SB(0, 0), b2, voffB); PG8_STAGE(PG8_SB(0, 1), b2 + hstepB, voffB); PG8_STAGE(PG8_SA(0, 0), a2, voffA);
            PG8_WAIT_V(8); PG8_WAIT_L(0); PG8_BAR; PG8_MMA(1, 0, At, B0); PG8_MMA(1, 1, At, B1); PG8_BAR; PG8_SCHED;
            PG8_LDB(B0, 1, 0); PG8_LDB(B1, 1, 1); PG8_SCHED; PG8_LDA(At, 1, 0); PG8_STAGE(PG8_SA(0, 1), a2 + hstepA, voffA);
            PG8_WAIT_V(8); PG8_WAIT_L(0); PG8_BAR; PG8_MMA(0, 0, At, B0); PG8_MMA(0, 1, At, B1); PG8_BAR; PG8_SCHED;
            PG8_LDA(At, 1, 1); PG8_STAGE(PG8_SB(1, 0), b3, voffB); PG8_STAGE(PG8_SB(1, 1), b3 + hstepB, voffB); PG8_STAGE(PG8_SA(1, 0), a3, voffA);
            PG8_WAIT_V(8); PG8_WAIT_L(0); PG8_BAR; PG8_MMA(1, 0, At, B0); PG8_MMA(1, 1, At, B1); PG8_BAR; PG8_SCHED;
        }
        if (wr == 0) PG8_BAR;
        E(acc, cur, wr, wc, fr, fq);
        if (!has_next) break;
#pragma unroll
        for (int a = 0; a < 2; ++a)
#pragma unroll
            for (int b = 0; b < 2; ++b)
#pragma unroll
                for (int m = 0; m < 4; ++m)
#pragma unroll
                    for (int n = 0; n < 2; ++n) acc[a][b][m][n] = (f32x4){0.f, 0.f, 0.f, 0.f};
        cur = nxt; cA = nA; cB = nB; ++ui;
        if (wr == 1) PG8_BAR;
    }
    PG8_WAIT_V(0);
    PG8_BAR;
#undef PG8_SA
#undef PG8_SB
#undef PG8_STAGE
#undef PG8_LDA
#undef PG8_LDB
#undef PG8_MMA
#undef PG8_WAIT_V
#undef PG8_WAIT_L
#undef PG8_BAR
#undef PG8_SCHED
}

template <int ACT> struct EpiBf {
    static constexpr bool PERM = true;
    bf16_t* O; int ldc;
    __device__ __forceinline__ void operator()(const f32x4 (&acc)[2][2][4][2], const Unit& u, int wr, int wc, int fr, int fq) const {
        const int row0 = u.pm * BM + wr * 64 + fr, col0 = u.pn * BM + wc * 32 + 8 * fq;
#pragma unroll
        for (int ai = 0; ai < 2; ++ai)
#pragma unroll
            for (int m = 0; m < 4; ++m) { bf16_t* rowp = O + (size_t)(row0 + ai * HALF + m * 16) * ldc + col0;
#pragma unroll
                for (int bj = 0; bj < 2; ++bj) { f32x4 v0 = acc[ai][bj][m][0], v1 = acc[ai][bj][m][1];
                    if (ACT == 1) {
#pragma unroll
                        for (int e = 0; e < 4; ++e) { const float a = fmaxf(v0[e], 0.f), b = fmaxf(v1[e], 0.f); v0[e] = a * a; v1[e] = b * b; } }
                    u32x4 w; w.x = pk2(v0[0], v0[1]); w.y = pk2(v0[2], v0[3]); w.z = pk2(v1[0], v1[1]); w.w = pk2(v1[2], v1[3]);
                    *(u32x4*)(rowp + bj * HALF) = w; } }
    }
};
struct EpiRes {
    static constexpr bool PERM = false;
    const float* in_lat; const float* in_ctx; float* out_lat; float* out_ctx; const float* gate; int pm_off;
    __device__ __forceinline__ void operator()(const f32x4 (&acc)[2][2][4][2], const Unit& u, int wr, int wc, int fr, int fq) const {
        const int gpm = u.pm + pm_off;
        const float* rin; float* rout; int v;
        if (gpm < 8) { rin = in_ctx + (size_t)gpm * 256 * DM; rout = out_ctx + (size_t)gpm * 256 * DM; v = 8; }
        else { rin = in_lat + (size_t)(gpm - 8) * 256 * DM; rout = out_lat + (size_t)(gpm - 8) * 256 * DM; v = (gpm - 8) >> 4; }
        const int col0 = u.pn * BM + wc * 32 + 4 * fq;
        const float* gp = gate + (size_t)v * 6144 + col0;
        f32x4 gv[2][2];
#pragma unroll
        for (int bj = 0; bj < 2; ++bj)
#pragma unroll
            for (int n = 0; n < 2; ++n) gv[bj][n] = *(const f32x4*)(gp + bj * HALF + n * 16);
#pragma unroll
        for (int ai = 0; ai < 2; ++ai)
#pragma unroll
            for (int m = 0; m < 4; ++m) { const size_t off = (size_t)(ai * HALF + wr * 64 + m * 16 + fr) * DM + col0;
#pragma unroll
                for (int bj = 0; bj < 2; ++bj)
#pragma unroll
                    for (int n = 0; n < 2; ++n) { const f32x4 x = *(const f32x4*)(rin + off + bj * HALF + n * 16); *(f32x4*)(rout + off + bj * HALF + n * 16) = x + gv[bj][n] * acc[ai][bj][m][n]; }
                asm volatile("" ::: "memory"); }
    }
};
}

__device__ __forceinline__ void transpose_item(const float* W, int ldw, int c0, int K, bf16_t* WT, int nblk, LAS float* scr, int item, int lane) {
    const int kb = item / nblk, nb = item % nblk, k0 = 64 * kb, n0 = 32 * nb;
#pragma unroll 8
    for (int i = 0; i < 32; ++i) { const int kk = 2 * i + (lane >> 5); scr[kk * 33 + (lane & 31)] = W[(size_t)(k0 + kk) * ldw + c0 + n0 + (lane & 31)]; }
    asm volatile("s_waitcnt lgkmcnt(0)" ::: "memory");
    const int c = lane & 7;
#pragma unroll
    for (int j = 0; j < 4; ++j) { const int n = (lane >> 3) + 8 * j; const LAS float* s = scr + (8 * c) * 33 + n;
        u32x4 o; o.x = pk2(s[0 * 33], s[1 * 33]); o.y = pk2(s[2 * 33], s[3 * 33]); o.z = pk2(s[4 * 33], s[5 * 33]); o.w = pk2(s[6 * 33], s[7 * 33]);
        *(u32x4*)(WT + (size_t)(n0 + n) * K + k0 + 8 * c) = o; }
    asm volatile("s_waitcnt lgkmcnt(0)" ::: "memory");
}

__device__ __forceinline__ void phase_prologue(const TC tc, KP P, LAS unsigned char* lds) {
    const int tid = tc.tid, lane = tid & 63, wave = tid >> 6;
    const int G = tc.G, gw = tc.bid * 8 + wave, NGW = G * 8;
    unsigned char* ws = P->ws;
    {
        LAS float* scr = (LAS float*)(lds + wave * 8704);
        constexpr int I_IN_A = 16 * 104, I_IN_B = 16 * 8, I_OUT = 16 * 32, I_1 = 16 * 128, I_2 = 64 * 32, I_G = 4 * 8;
        constexpr int I_L = I_IN_A + I_IN_B + I_OUT + I_1 + I_2 + I_G;
        for (int it = gw; it < 2 * I_L; it += NGW) {
            const int l = it / I_L; int r = it % I_L;
            unsigned char* wl = ws + WS_W + (size_t)l * SZ_WL;
            bf16_t* win = (bf16_t*)wl; bf16_t* wout = (bf16_t*)(wl + SZ_WIN); bf16_t* w1 = (bf16_t*)(wl + SZ_WIN + SZ_WOUT); bf16_t* w2 = (bf16_t*)(wl + SZ_WIN + SZ_WOUT + SZ_W1);
            bf16_t* wg = (bf16_t*)(wl + SZ_WIN + SZ_WOUT + SZ_W1 + SZ_W2);
            if (r < I_IN_A) { transpose_item(P->in[8] + (size_t)l * DM * DIN, DIN, 0, DM, win, 104, scr, r, lane); continue; } r -= I_IN_A;
            if (r < I_IN_B) { transpose_item(P->in[8] + (size_t)l * DM * DIN, DIN, 3344, DM, win + (size_t)3328 * DM, 8, scr, r, lane); continue; } r -= I_IN_B;
            if (r < I_OUT) { transpose_item(P->in[26] + (size_t)l * DM * DM, DM, 0, DM, wout, 32, scr, r, lane); continue; } r -= I_OUT;
            if (r < I_1) { transpose_item(P->in[27] + (size_t)l * DM * DFF, DFF, 0, DM, w1, 128, scr, r, lane); continue; } r -= I_1;
            if (r < I_2) { transpose_item(P->in[28] + (size_t)l * DFF * DM, DM, 0, DFF, w2, 32, scr, r, lane); continue; } r -= I_2;
            transpose_item(P->in[24] + (size_t)l * DG * DG, DG, 0, DG, wg, 8, scr, r, lane);
        }
    }
    const int gt = tc.bid * 512 + tid, NGT = G * 512;
    for (int i = gt; i < 2 * 16 * DM; i += NGT) { const int l = i / (16 * DM), c = (i / DM) % 16, k = i % DM;
        ((float*)(ws + WS_W + (size_t)l * SZ_WL + SZ_WL - SZ_WAB))[c * DM + k] = P->in[8][(size_t)l * DM * DIN + (size_t)k * DIN + 3328 + c]; }
    for (int i = gt; i < TSEQ * 32; i += NGT) { const int pos = i >> 5, f = i & 31;
        const float inv = powf(10000.0f, -(float)f / 32.0f); const float ang = (float)pos * inv; float s, c; sincosf(ang, &s, &c);
        ((f32x2*)(ws + WS_ROPE))[i] = (f32x2){c, s}; }
    for (int i = gt; i < 2 * DG; i += NGT) { const float a = P->in[9][i], b = P->in[9][2 * DG + i]; const float mx = fmaxf(a, b), ea = expf(a - mx), eb = expf(b - mx);
        float* lb = (float*)(ws + WS_LB); lb[i] = 0.f; lb[2 * DG + i] = eb / (ea + eb); }
    for (int i = gt; i < 2 * 2 * 16 * 64; i += NGT) { const int p = i & 63, g = (i >> 6) & 15, d = (i >> 10) & 1, l = i >> 11;
        const float lr = P->in[16][i], li = P->in[17][i]; const float dt = expf(P->in[18][(l * 2 + d) * 16 + g]);
        const float mag = expf(lr * dt); float sn, cs; sincosf(li * dt, &sn, &cs); const float ar = mag * cs, ai = mag * sn;
        const float den = lr * lr + li * li, nr = ar - 1.0f, ni = ai; const float fr = (nr * lr + ni * li) / den, fi = (ni * lr - nr * li) / den;
        float* o = (float*)(ws + WS_S5P) + (size_t)i * 34; o[0] = ar; o[1] = ai;
        const float* bre = P->in[19] + ((size_t)(l * 16 + g) * 64 + p) * 16; const float* bim = P->in[20] + ((size_t)(l * 16 + g) * 64 + p) * 16;
        for (int c = 0; c < 16; ++c) { o[2 + c] = fr * bre[c] - fi * bim[c]; o[18 + c] = fr * bim[c] + fi * bre[c]; } }
    __syncthreads();
    {
        LAS float* sc = (LAS float*)lds;
        LAS float* red = (LAS float*)(lds + 36864);
        for (int i = tid; i < 9 * DM; i += 512) { const int v = i >> 10, k = i & 1023; const float x = v < 8 ? P->in[1][v * DM + k] : P->in[3][k]; sc[i] = siluf_(x); }
        __syncthreads();
        for (int item = tc.bid; item < 2 * 96; item += G) {
            const int l = item / 96, cg0 = (item % 96) * 64;
            const int c4 = (tid & 15) * 4, kl = tid >> 4;
            const float* W = P->in[4] + (size_t)l * DM * 6144 + cg0 + c4;
            f32x4 a[9];
#pragma unroll
            for (int v = 0; v < 9; ++v) a[v] = (f32x4){0.f, 0.f, 0.f, 0.f};
            for (int k = kl; k < DM; k += 32) { const f32x4 w = *(const f32x4*)(W + (size_t)k * 6144);
#pragma unroll
                for (int v = 0; v < 9; ++v) a[v] += w * sc[v * DM + k]; }
#pragma unroll
            for (int v = 0; v < 9; ++v) *(LAS f32x4*)(red + kl * 576 + v * 64 + c4) = a[v];
            __syncthreads();
            for (int o = tid; o < 576; o += 512) { float s = 0.f; for (int q = 0; q < 32; ++q) s += red[q * 576 + o];
                const int v = o >> 6, c = cg0 + (o & 63);
                ((float*)(ws + WS_MOD))[((size_t)l * 9 + v) * 6144 + c] = s + P->in[5][l * 6144 + c]; }
            __syncthreads();
        }
    }
}

__device__ __forceinline__ void phase_norm(const TC tc, KP P, LAS unsigned char* lds, int l, int which, const float* src_lat, const float* src_ctx, int r0, bool do_ab) {
    const int tid = tc.tid, lane = tid & 63, wave = tid >> 6;
    const int gw = tc.bid * 8 + wave, NGW = tc.G * 8;
    unsigned char* ws = P->ws;
    LAS float* wab = (LAS float*)lds;
    if (do_ab) { const float* src = (const float*)(ws + WS_W + (size_t)l * SZ_WL + SZ_WL - SZ_WAB);
        for (int i = tid; i < 16 * DM / 4; i += 512) ((LAS f32x4*)wab)[i] = ((const f32x4*)src)[i];
        __syncthreads(); }
    const float* gvec = P->in[which ? 7 : 6] + l * DM;
    const float* mod = (const float*)(ws + WS_MOD) + (size_t)l * 9 * 6144;
    bf16_t* H = (bf16_t*)(ws + WS_HB);
    float* AB = (float*)(ws + WS_AB);
    for (int r = r0 + gw; r < MALL; r += NGW) {
        const float* xrow; int v;
        if (r < MCTX) { xrow = src_ctx + (size_t)r * DM; v = 8; } else { xrow = src_lat + (size_t)(r - MCTX) * DM; v = (r - MCTX) >> 12; }
        const float* sh = mod + (size_t)v * 6144 + (which ? 3 : 0) * DM; const float* scl = mod + (size_t)v * 6144 + (which ? 4 : 1) * DM;
        f32x4 x[4]; float ss = 0.f;
#pragma unroll
        for (int j = 0; j < 4; ++j) { x[j] = ((const f32x4*)xrow)[j * 64 + lane]; ss += (x[j].x * x[j].x + x[j].y * x[j].y) + (x[j].z * x[j].z + x[j].w * x[j].w); }
        const float rstd = rsqrtf(wave_sum(ss) * (1.0f / DM) + EPS);
#pragma unroll
        for (int j = 0; j < 4; ++j) { const f32x4 g = ((const f32x4*)gvec)[j * 64 + lane], s1 = ((const f32x4*)scl)[j * 64 + lane], s0 = ((const f32x4*)sh)[j * 64 + lane];
            x[j] = x[j] * rstd * g * (1.0f + s1) + s0;
            u32x2 w; w.x = pk2(x[j].x, x[j].y); w.y = pk2(x[j].z, x[j].w);
            ((u32x2*)(H + (size_t)r * DM))[j * 64 + lane] = w; }
        if (do_ab) {
#pragma unroll 1
            for (int cq = 0; cq < 4; ++cq) {
                float p[4];
#pragma unroll
                for (int c = 0; c < 4; ++c) { float a = 0.f;
#pragma unroll
                    for (int j = 0; j < 4; ++j) { const f32x4 w = *(const LAS f32x4*)(wab + (cq * 4 + c) * DM + (j * 64 + lane) * 4); a += (x[j].x * w.x + x[j].y * w.y) + (x[j].z * w.z + x[j].w * w.w); }
                    p[c] = a; }
                bool bb = (lane & 32) != 0;
                { const float k0 = bb ? p[2] : p[0], s0 = bb ? p[0] : p[2], k1 = bb ? p[3] : p[1], s1 = bb ? p[1] : p[3]; p[0] = k0 + __shfl_xor(s0, 32); p[1] = k1 + __shfl_xor(s1, 32); }
                bb = (lane & 16) != 0;
                { const float k0 = bb ? p[1] : p[0], s0 = bb ? p[0] : p[1]; p[0] = k0 + __shfl_xor(s0, 16); }
                float tot = p[0];
                tot += __shfl_xor(tot, 8); tot += __shfl_xor(tot, 4); tot += __shfl_xor(tot, 2); tot += __shfl_xor(tot, 1);
                if ((lane & 15) == 0) { const int c = cq * 4 + 2 * ((lane >> 5) & 1) + ((lane >> 4) & 1);
                    float o;
                    if (c < 8) { const int d = c >> 2, h = c & 3; const float xx = tot + P->in[14][(l * 2 + d) * 4 + h]; const float sp = xx > 20.f ? xx : log1pf(expf(xx));
                        o = -expf(P->in[13][(l * 2 + d) * 4 + h]) * sp; }
                    else o = 1.0f / (1.0f + expf(-tot));
                    AB[(size_t)r * 16 + c] = o; }
            }
        }
    }
}

__device__ __forceinline__ void phase_mixpre(const TC tc, KP P, int l) {
    const int tid = tc.tid, lane = tid & 63, wave = tid >> 6;
    const int gw = tc.bid * 8 + wave, NGW = tc.G * 8;
    unsigned char* ws = P->ws;
    bf16_t* Z = (bf16_t*)(ws + WS_Z);
    bf16_t* QC = (bf16_t*)(ws + WS_HB);
    const float* lb = (const float*)(ws + WS_LB) + l * 2 * DG;
    const f32x2* rope = (const f32x2*)(ws + WS_ROPE);
    const float* cw = P->in[12] + (size_t)l * 9 * 768;
    for (int r = gw; r < MALL; r += NGW) {
        bf16_t* zr = Z + (size_t)r * NZ;
        int pos, b, s; bool isctx = r < MCTX;
        if (isctx) { b = r >> 8; s = r & 255; pos = s; } else { b = (r - MCTX) >> 12; s = (r - MCTX) & 4095; pos = TCTX + s; }
        { u32x2 w = ((u32x2*)(zr + ZC_HQ))[lane];
          w.x = pk2(siluf_(bflo(w.x)) * 0.125f, siluf_(bfhi(w.x)) * 0.125f); w.y = pk2(siluf_(bflo(w.y)) * 0.125f, siluf_(bfhi(w.y)) * 0.125f);
          ((u32x2*)(zr + ZC_HQ))[lane] = w; }
        { u32x4 w = ((u32x4*)(zr + ZC_HF))[lane]; const int c0 = lane * 8; unsigned* pw = (unsigned*)&w;
#pragma unroll
          for (int e = 0; e < 4; ++e) { const int c = c0 + 2 * e;
              const float f0 = bflo(pw[e]), f1 = bfhi(pw[e]);
              const float l0 = fmaxf(lb[c], 1e-30f), l1 = fmaxf(lb[c + 1], 1e-30f);
              const float s0 = 1.0f / (1.0f + expf(-f0)), s1 = 1.0f / (1.0f + expf(-f1));
              pw[e] = pk2(logf(l0 * (1.0f - s0) + s0), logf(l1 * (1.0f - s1) + s1)); }
          ((u32x4*)(zr + ZC_HF))[lane] = w; }
        {
#pragma unroll
          for (int qk = 0; qk < 2; ++qk) { bf16_t* base = zr + (qk ? ZC_RK : ZC_RQ) + (lane >> 4) * 64 + (lane & 15) * 2;
              const unsigned w1 = *(const unsigned*)base, w2 = *(const unsigned*)(base + 32);
              const f32x2 cs0 = rope[pos * 32 + (lane & 15) * 2], cs1 = rope[pos * 32 + (lane & 15) * 2 + 1];
              const float sc = qk ? 0.125f : 1.0f;
              const float a0 = bflo(w1), a1 = bfhi(w1), b0 = bflo(w2), b1 = bfhi(w2);
              *(unsigned*)base = pk2((a0 * cs0.x - b0 * cs0.y) * sc, (a1 * cs1.x - b1 * cs1.y) * sc);
              *(unsigned*)(base + 32) = pk2((a0 * cs0.y + b0 * cs0.x) * sc, (a1 * cs1.y + b1 * cs1.x) * sc); } }
        {
            float acc[3][4];
#pragma unroll
            for (int g = 0; g < 3; ++g)
#pragma unroll
                for (int e = 0; e < 4; ++e) acc[g][e] = 0.f;
            const int gx = isctx ? s : (s & 63), gy = isctx ? 0 : (s >> 6), W = isctx ? TCTX : 64, Hh = isctx ? 1 : 64;
#pragma unroll
            for (int dy = 0; dy < 3; ++dy) { const int yy = gy + dy - 1; if (yy < 0 || yy >= Hh) continue;
#pragma unroll
                for (int dx = 0; dx < 3; ++dx) { const int xx = gx + dx - 1; if (xx < 0 || xx >= W) continue;
                    const int rr = r + (dy - 1) * 64 + (dx - 1);
                    const bf16_t* zn = Z + (size_t)rr * NZ + ZC_GQKV + lane * 4; const float* wp = cw + (dy * 3 + dx) * 768 + lane * 4;
#pragma unroll
                    for (int g = 0; g < 3; ++g) { const u32x2 w = *(const u32x2*)(zn + g * 256); const f32x4 k = *(const f32x4*)(wp + g * 256);
                        acc[g][0] += bflo(w.x) * k.x; acc[g][1] += bfhi(w.x) * k.y; acc[g][2] += bflo(w.y) * k.z; acc[g][3] += bfhi(w.y) * k.w; } } }
#pragma unroll
            for (int g = 0; g < 3; ++g) {
#pragma unroll
                for (int e = 0; e < 4; ++e) acc[g][e] = siluf_(acc[g][e]);
                if (g < 2) { float ss = (acc[g][0] * acc[g][0] + acc[g][1] * acc[g][1]) + (acc[g][2] * acc[g][2] + acc[g][3] * acc[g][3]);
                    ss += __shfl_xor(ss, 1); ss += __shfl_xor(ss, 2); ss += __shfl_xor(ss, 4); ss += __shfl_xor(ss, 8);
                    const float rn = rsqrtf(ss + EPS) * (g == 0 ? 0.125f : 1.0f);
#pragma unroll
                    for (int e = 0; e < 4; ++e) acc[g][e] *= rn; }
                u32x2 w; w.x = pk2(acc[g][0], acc[g][1]); w.y = pk2(acc[g][2], acc[g][3]);
                *(u32x2*)(QC + (size_t)r * 768 + g * 256 + lane * 4) = w; }
        }
    }
}

constexpr int TB = 32, NBATCH = TSEQ / TB;
constexpr int CH_ARR = TB * 64 * 4;
constexpr int CH_BUF = 4 * CH_ARR + 256;
constexpr int CH_OS = 2 * CH_BUF;
static_assert(CH_OS + 2 * CH_ARR <= LDS_BYTES, "chain LDS");

template <int KIND>
__device__ __forceinline__ void chain_matrix(const TC tc, KP P, LAS unsigned char* lds, int l, int chain) {
    const int tid = tc.tid, lane = tid & 63, wave = tid >> 6;
    const int b = chain >> 3, h = (chain >> 1) & 3, d = chain & 1;
    unsigned char* ws = P->ws;
    const bf16_t* Z = (const bf16_t*)(ws + WS_Z);
    const bf16_t* QC = (const bf16_t*)(ws + WS_HB);
    const float* AB = (const float*)(ws + WS_AB);
    bf16_t* O = (bf16_t*)(ws + (d ? WS_OB : WS_OF));
    const int ocol = KIND * 256 + h * 64;
    const bool loader = wave >= 4;
    const int lt = tid - 256, ltok = lt >> 3, lseg = lt & 7;
    float gam = 0.f;
    if (KIND == 1) gam = 1.0f / (1.0f + expf(-P->in[11][(l * 2 + d) * 4 + h]));
    auto load = [&](int n, int bi) {
        const int row = seq_row(b, d, n * TB + ltok);
        LAS float* base = (LAS float*)(lds + bi * CH_BUF) + ltok * 64 + lseg * 8;
        u32x4 q, k, v;
        if (KIND == 0) { const bf16_t* zr = Z + (size_t)row * NZ + h * 64 + lseg * 8; q = *(const u32x4*)(zr + ZC_HQ); k = *(const u32x4*)(zr + ZC_HF + d * 256); v = *(const u32x4*)(zr + ZC_HI); }
        else if (KIND == 1) { const bf16_t* zr = Z + (size_t)row * NZ + h * 64 + lseg * 8; q = *(const u32x4*)(zr + ZC_RQ); k = *(const u32x4*)(zr + ZC_RK); v = *(const u32x4*)(zr + ZC_RV); }
        else { const bf16_t* qr = QC + (size_t)row * 768 + h * 64 + lseg * 8; q = *(const u32x4*)qr; k = *(const u32x4*)(qr + 256); v = *(const u32x4*)(qr + 512);
            if (lseg == 0) { LAS float* sc = (LAS float*)(lds + bi * CH_BUF + 4 * CH_ARR); sc[ltok * 2] = expf(AB[(size_t)row * 16 + d * 4 + h]); sc[ltok * 2 + 1] = AB[(size_t)row * 16 + 8 + d * 4 + h]; } }
        const unsigned* pq = (const unsigned*)&q; const unsigned* pk = (const unsigned*)&k; const unsigned* pv = (const unsigned*)&v;
#pragma unroll
        for (int e = 0; e < 4; ++e) {
            base[2 * e] = bflo(pq[e]); base[2 * e + 1] = bfhi(pq[e]);
            base[3 * TB * 64 + 2 * e] = bflo(pv[e]); base[3 * TB * 64 + 2 * e + 1] = bfhi(pv[e]);
            if (KIND == 0) { const float l0 = bflo(pk[e]), l1 = bfhi(pk[e]); const float f0 = expf(l0), f1 = expf(l1);
                base[TB * 64 + 2 * e] = f0; base[TB * 64 + 2 * e + 1] = f1; base[2 * TB * 64 + 2 * e] = -expm1f(l0); base[2 * TB * 64 + 2 * e + 1] = -expm1f(l1); }
            else { base[TB * 64 + 2 * e] = bflo(pk[e]); base[TB * 64 + 2 * e + 1] = bfhi(pk[e]); }
        }
    };
    auto store = [&](int n, int bi) {
        const int row = seq_row(b, d, n * TB + ltok);
        const LAS float* os = (const LAS float*)(lds + CH_OS + bi * CH_ARR) + ltok * 64 + lseg * 8;
        u32x4 w; w.x = pk2(os[0], os[1]); w.y = pk2(os[2], os[3]); w.z = pk2(os[4], os[5]); w.w = pk2(os[6], os[7]);
        *(u32x4*)(O + (size_t)row * DM + ocol + lseg * 8) = w;
    };
    float S[16];
#pragma unroll
    for (int i = 0; i < 16; ++i) S[i] = 0.f;
    const int vl = lane >> 2, kg = lane & 3, vcol = (wave & 3) * 16 + vl;
    if (loader) load(0, 0);
    __syncthreads();
    for (int n = 0; n < NBATCH; ++n) {
        if (loader) { if (n + 1 < NBATCH) load(n + 1, (n + 1) & 1); if (n >= 1) store(n - 1, (n - 1) & 1); }
        else {
            const LAS float* A0 = (const LAS float*)(lds + (n & 1) * CH_BUF);
            const LAS float* sc = (const LAS float*)(lds + (n & 1) * CH_BUF + 4 * CH_ARR);
            LAS float* os = (LAS float*)(lds + CH_OS + (n & 1) * CH_ARR);
#pragma unroll 2
            for (int tt = 0; tt < TB; ++tt) {
                const LAS float* a = A0 + tt * 64 + kg * 16;
                float q[16], k[16];
#pragma unroll
                for (int i = 0; i < 4; ++i) { const f32x4 t4 = *(const LAS f32x4*)(a + 4 * i); q[4 * i] = t4.x; q[4 * i + 1] = t4.y; q[4 * i + 2] = t4.z; q[4 * i + 3] = t4.w; }
#pragma unroll
                for (int i = 0; i < 4; ++i) { const f32x4 t4 = *(const LAS f32x4*)(a + TB * 64 + 4 * i); k[4 * i] = t4.x; k[4 * i + 1] = t4.y; k[4 * i + 2] = t4.z; k[4 * i + 3] = t4.w; }
                const float vv = A0[3 * TB * 64 + tt * 64 + vcol];
                float o = 0.f;
                if (KIND == 0) {
                    float kk[16];
#pragma unroll
                    for (int i = 0; i < 4; ++i) { const f32x4 t4 = *(const LAS f32x4*)(a + 2 * TB * 64 + 4 * i); kk[4 * i] = t4.x; kk[4 * i + 1] = t4.y; kk[4 * i + 2] = t4.z; kk[4 * i + 3] = t4.w; }
#pragma unroll
                    for (int i = 0; i < 16; ++i) { S[i] = k[i] * S[i] + kk[i] * vv; o += q[i] * S[i]; }
                } else if (KIND == 1) {
#pragma unroll
                    for (int i = 0; i < 16; ++i) { S[i] = gam * S[i] + k[i] * vv; o += q[i] * S[i]; }
                } else {
                    const float alpha = sc[tt * 2], beta = sc[tt * 2 + 1];
                    float r = 0.f;
#pragma unroll
                    for (int i = 0; i < 16; ++i) r += k[i] * S[i];
                    r = quad_sum(r);
                    const float c = beta * (vv - alpha * r);
#pragma unroll
                    for (int i = 0; i < 16; ++i) { S[i] = alpha * S[i] + k[i] * c; o += q[i] * S[i]; }
                }
                o = quad_sum(o);
                if (kg == 0) os[tt * 64 + vcol] = o;
            }
        }
        __syncthreads();
    }
    if (loader) store(NBATCH - 1, (NBATCH - 1) & 1);
    __syncthreads();
}

constexpr int S5_US = 0, S5_YS = 2 * 4 * TB * 16 * 4;
__device__ __forceinline__ void chain_s5(const TC tc, KP P, LAS unsigned char* lds, int l, int item) {
    const int tid = tc.tid, lane = tid & 63, wave = tid >> 6;
    const int b = item >> 3, d = (item >> 2) & 1, gq = item & 3;
    unsigned char* ws = P->ws;
    const bf16_t* Z = (const bf16_t*)(ws + WS_Z);
    bf16_t* O = (bf16_t*)(ws + (d ? WS_OB : WS_OF));
    const bool loader = wave >= 4;
    const int lt = tid - 256, lch = lt >> 6, ltok = (lt >> 1) & 31, lhalf = lt & 1;
    auto load = [&](int n, int bi) {
        const int row = seq_row(b, d, n * TB + ltok);
        const u32x4 u = *(const u32x4*)(Z + (size_t)row * NZ + ZC_SU + gq * 64 + lch * 16 + lhalf * 8);
        LAS float* us = (LAS float*)(lds + S5_US) + ((bi * 4 + lch) * TB + ltok) * 16 + lhalf * 8; const unsigned* pu = (const unsigned*)&u;
#pragma unroll
        for (int e = 0; e < 4; ++e) { us[2 * e] = bflo(pu[e]); us[2 * e + 1] = bfhi(pu[e]); }
    };
    auto store = [&](int n, int bi) {
        const int row = seq_row(b, d, n * TB + ltok);
        const LAS float* ys = (const LAS float*)(lds + S5_YS) + ((bi * 4 + lch) * TB + ltok) * 16 + lhalf * 8;
        u32x4 w; w.x = pk2(ys[0], ys[1]); w.y = pk2(ys[2], ys[3]); w.z = pk2(ys[4], ys[5]); w.w = pk2(ys[6], ys[7]);
        *(u32x4*)(O + (size_t)row * DM + 768 + gq * 64 + lch * 16 + lhalf * 8) = w;
    };
    float bre[16], bim[16], cre[16], cim[16], ar = 0.f, ai = 0.f, hr = 0.f, hi = 0.f;
    if (!loader) {
        const int g = gq * 4 + wave;
        const float* sp = (const float*)(ws + WS_S5P) + ((size_t)((l * 2 + d) * 16 + g) * 64 + lane) * 34;
        ar = sp[0]; ai = sp[1];
#pragma unroll
        for (int c = 0; c < 16; ++c) { bre[c] = sp[2 + c]; bim[c] = sp[18 + c];
            cre[c] = P->in[21][((size_t)(l * 16 + g) * 16 + c) * 64 + lane]; cim[c] = P->in[22][((size_t)(l * 16 + g) * 16 + c) * 64 + lane]; }
    }
    if (loader) load(0, 0);
    __syncthreads();
    for (int n = 0; n < NBATCH; ++n) {
        if (loader) { if (n + 1 < NBATCH) load(n + 1, (n + 1) & 1); if (n >= 1) store(n - 1, (n - 1) & 1); }
        else {
            const LAS float* us = (const LAS float*)(lds + S5_US) + (((n & 1) * 4 + wave) * TB) * 16;
            LAS float* ys = (LAS float*)(lds + S5_YS) + (((n & 1) * 4 + wave) * TB) * 16;
            for (int tt = 0; tt < TB; ++tt) {
                float u[16];
#pragma unroll
                for (int i = 0; i < 4; ++i) { const f32x4 t4 = *(const LAS f32x4*)(us + tt * 16 + 4 * i); u[4 * i] = t4.x; u[4 * i + 1] = t4.y; u[4 * i + 2] = t4.z; u[4 * i + 3] = t4.w; }
                float xr = 0.f, xi = 0.f;
#pragma unroll
                for (int c = 0; c < 16; ++c) { xr += bre[c] * u[c]; xi += bim[c] * u[c]; }
                const float nhr = ar * hr - ai * hi + xr, nhi = ar * hi + ai * hr + xi; hr = nhr; hi = nhi;
                float p[16];
#pragma unroll
                for (int c = 0; c < 16; ++c) p[c] = cre[c] * hr - cim[c] * hi;
                const float tot = reduce16(p, lane);
                if ((lane & 3) == 0) { const int c = 8 * ((lane >> 5) & 1) + 4 * ((lane >> 4) & 1) + 2 * ((lane >> 3) & 1) + ((lane >> 2) & 1); ys[tt * 16 + c] = tot; }
            }
        }
        __syncthreads();
    }
    if (loader) store(NBATCH - 1, (NBATCH - 1) & 1);
    __syncthreads();
}

__device__ __forceinline__ void phase_mixscan(const TC tc, KP P, LAS unsigned char* lds, int l) {
    for (int item = tc.bid; item < 256; item += tc.G) {
        const int kind = item >> 6, c = item & 63;
        if (kind == 0) chain_matrix<0>(tc, P, lds, l, c);
        else if (kind == 1) chain_matrix<1>(tc, P, lds, l, c);
        else if (kind == 2) chain_matrix<2>(tc, P, lds, l, c);
        else chain_s5(tc, P, lds, l, c);
    }
}

__device__ __forceinline__ void phase_combine(const TC tc, KP P, int l, int r0) {
    const int tid = tc.tid, lane = tid & 63, wave = tid >> 6;
    const int gw = tc.bid * 8 + wave, NGW = tc.G * 8;
    unsigned char* ws = P->ws;
    const bf16_t* Z = (const bf16_t*)(ws + WS_Z);
    const bf16_t* OF = (const bf16_t*)(ws + WS_OF); const bf16_t* OB = (const bf16_t*)(ws + WS_OB);
    bf16_t* CAT = (bf16_t*)(ws + WS_HB);
    const float* ghg = P->in[10] + l * 64; const float* ggd = P->in[15] + l * 64; const float* dsk = P->in[23] + l * DG;
    const int hc = (lane & 15) * 4;
    const f32x4 g_h = *(const f32x4*)(ghg + hc), g_g = *(const f32x4*)(ggd + hc);
    const f32x4 dv = *(const f32x4*)(dsk + lane * 4);
    for (int r = r0 + gw; r < MALL; r += NGW) {
        const bf16_t* zr = Z + (size_t)r * NZ;
#pragma unroll
        for (int mx = 0; mx < 3; ++mx) {
            const u32x2 a = *(const u32x2*)(OF + (size_t)r * DM + mx * 256 + lane * 4), bb = *(const u32x2*)(OB + (size_t)r * DM + mx * 256 + lane * 4);
            f32x4 o = (f32x4){bflo(a.x) + bflo(bb.x), bfhi(a.x) + bfhi(bb.x), bflo(a.y) + bflo(bb.y), bfhi(a.y) + bfhi(bb.y)};
            float ss = (o.x * o.x + o.y * o.y) + (o.z * o.z + o.w * o.w);
            ss += __shfl_xor(ss, 1); ss += __shfl_xor(ss, 2); ss += __shfl_xor(ss, 4); ss += __shfl_xor(ss, 8);
            const float rn = rsqrtf(ss * (1.0f / 64.0f) + EPS);
            o = o * rn; if (mx == 0) o = o * g_h; if (mx == 2) o = o * g_g;
            const u32x2 gt = *(const u32x2*)(zr + (mx == 0 ? ZC_HG : mx == 1 ? ZC_RG : ZC_GG) + lane * 4);
            u32x2 w; w.x = pk2(o.x * siluf_(bflo(gt.x)), o.y * siluf_(bfhi(gt.x))); w.y = pk2(o.z * siluf_(bflo(gt.y)), o.w * siluf_(bfhi(gt.y)));
            *(u32x2*)(CAT + (size_t)r * DM + mx * 256 + lane * 4) = w;
        }
        { const u32x2 a = *(const u32x2*)(OF + (size_t)r * DM + 768 + lane * 4), bb = *(const u32x2*)(OB + (size_t)r * DM + 768 + lane * 4);
          const u32x2 uu = *(const u32x2*)(zr + ZC_SU + lane * 4);
          const float y0 = bflo(a.x) + bflo(bb.x) + bflo(uu.x) * dv.x, y1 = bfhi(a.x) + bfhi(bb.x) + bfhi(uu.x) * dv.y, y2 = bflo(a.y) + bflo(bb.y) + bflo(uu.y) * dv.z, y3 = bfhi(a.y) + bfhi(bb.y) + bfhi(uu.y) * dv.w;
          u32x2 w; w.x = pk2(gelu_tanh(y0), gelu_tanh(y1)); w.y = pk2(gelu_tanh(y2), gelu_tanh(y3));
          *(u32x2*)(CAT + (size_t)r * DM + 768 + lane * 4) = w; }
    }
}

__device__ __forceinline__ void phase_glu(const TC tc, KP P, LAS unsigned char* lds, int l, int r0) {
    const int tid = tc.tid, lane = tid & 63, wave = tid >> 6;
    const int gw = tc.bid * 8 + wave, NGW = tc.G * 8;
    const int ntile = (MALL - r0) / 16;
    if (tc.bid * 8 >= ntile) return;
    unsigned char* ws = P->ws;
    const bf16_t* wg = (const bf16_t*)(ws + WS_W + (size_t)l * SZ_WL + SZ_WIN + SZ_WOUT + SZ_W1 + SZ_W2);
    for (int i = tid; i < 256 * 32; i += 512) { const int n = i >> 5, c = i & 31; *(LAS u32x4*)(lds + n * 528 + c * 16) = *(const u32x4*)(wg + n * 256 + c * 8); }
    __syncthreads();
    bf16_t* CAT = (bf16_t*)(ws + WS_HB);
    const float* bias = P->in[25] + l * DG;
    const int fr = lane & 15, fq = lane >> 4;
    for (int t = gw; t < ntile; t += NGW) {
        bf16_t* rowp = CAT + (size_t)(r0 + t * 16 + fr) * DM + 768;
        bf16x8 af[8];
#pragma unroll
        for (int ks = 0; ks < 8; ++ks) af[ks] = *(const bf16x8*)(rowp + ks * 32 + fq * 8);
        f32x4 acc[16];
#pragma unroll
        for (int nt = 0; nt < 16; ++nt) acc[nt] = (f32x4){0.f, 0.f, 0.f, 0.f};
#pragma unroll
        for (int ks = 0; ks < 8; ++ks)
#pragma unroll
            for (int nt = 0; nt < 16; ++nt) { const bf16x8 wf = *(const LAS bf16x8*)(lds + (nt * 16 + fr) * 528 + (ks * 32 + fq * 8) * 2);
                acc[nt] = __builtin_amdgcn_mfma_f32_16x16x32_bf16(wf, af[ks], acc[nt], 0, 0, 0); if ((nt & 7) == 7) asm volatile("" ::: "memory"); }
#pragma unroll
        for (int nt = 0; nt < 16; ++nt) { const int c = nt * 16 + 4 * fq; asm volatile("" ::: "memory"); const f32x4 bv = *(const f32x4*)(bias + c); const u32x2 y = *(const u32x2*)(rowp + c);
            u32x2 w; w.x = pk2(bflo(y.x) * sigmoidf_(acc[nt][0] + bv[0]), bfhi(y.x) * sigmoidf_(acc[nt][1] + bv[1])); w.y = pk2(bflo(y.y) * sigmoidf_(acc[nt][2] + bv[2]), bfhi(y.y) * sigmoidf_(acc[nt][3] + bv[3]));
            *(u32x2*)(rowp + c) = w; }
    }
}

__device__ __forceinline__ void phase_final(const TC tc, KP P) {
    const int tid = tc.tid, lane = tid & 63, wave = tid >> 6;
    const int gw = tc.bid * 8 + wave, NGW = tc.G * 8;
    const float* g = P->in[29];
    for (int r = gw; r < MLAT; r += NGW) {
        float* xr = P->out + (size_t)r * DM;
        f32x4 x[4]; float ss = 0.f;
#pragma unroll
        for (int j = 0; j < 4; ++j) { x[j] = ((const f32x4*)xr)[j * 64 + lane]; ss += (x[j].x * x[j].x + x[j].y * x[j].y) + (x[j].z * x[j].z + x[j].w * x[j].w); }
        const float rstd = rsqrtf(wave_sum(ss) * (1.0f / DM) + EPS);
#pragma unroll
        for (int j = 0; j < 4; ++j) ((f32x4*)xr)[j * 64 + lane] = x[j] * rstd * ((const f32x4*)g)[j * 64 + lane];
    }
}

__global__ void __launch_bounds__(512, 2) mega(Params Pk) {
    extern __shared__ __attribute__((aligned(16))) unsigned char lds_raw[];
    LAS unsigned char* lds = (LAS unsigned char*)lds_raw;
    cg::grid_group grid = cg::this_grid();
    for (int ph = Pk.ph_lo; ph < Pk.ph_hi; ++ph) {
        KP P = (KP)__builtin_amdgcn_kernarg_segment_ptr();
        asm volatile("" : "+s"(P));
        TC tc; tc.tid = threadIdx.x; tc.bid = blockIdx.x; tc.G = gridDim.x;
        asm volatile("" : "+v"(tc.tid)); asm volatile("" : "+s"(tc.bid)); asm volatile("" : "+s"(tc.G));
        unsigned char* ws = P->ws;
#ifndef PHMASK
#define PHMASK 0xFFFF
#endif
        if (ph == 0) { if (PHMASK & 1) phase_prologue(tc, P, lds); }
        else if (ph == NPHASE - 1) { if (PHMASK & 2) phase_final(tc, P); }
        else {
            const int l = (ph - 1) / 10, sp = (ph - 1) % 10;
            const int pm_off = (l == DEPTH - 1) ? 8 : 0, r0 = pm_off * 256, Mrows = MALL - r0;
#define WL(off) ((const bf16_t*)(ws + WS_W + (size_t)l * SZ_WL + (off)))
#define HB_ ((bf16_t*)(ws + WS_HB))
#define XC_ ((float*)(ws + WS_XC))
#define MODL ((const float*)(ws + WS_MOD) + (size_t)l * 9 * 6144)
            switch (sp) {
            case 0: if (PHMASK & (1 << 2)) phase_norm(tc, P, lds, l, 0, (l == 0) ? P->in[0] : (const float*)P->out, (l == 0) ? P->in[2] : (const float*)XC_, 0, true); break;
            case 1: if (PHMASK & (1 << 3)) { pg8::Gemm g{HB_, WL(0), MALL, NZ, DM, DM}; pg8::StaticOrder S; S.init(MALL, NZ, tc.G, tc.bid); pg8::EpiBf<0> E{(bf16_t*)(ws + WS_Z), NZ}; pg8::gemm_phase(tc, lds, g, S, E); } break;
            case 2: if (PHMASK & (1 << 4)) phase_mixpre(tc, P, l); break;
            case 3: if (PHMASK & (1 << 5)) phase_mixscan(tc, P, lds, l); break;
            case 4: if (PHMASK & (1 << 6)) phase_combine(tc, P, l, r0); break;
            case 5: if (PHMASK & (1 << 7)) phase_glu(tc, P, lds, l, r0); break;
            case 6: if (PHMASK & (1 << 8)) { pg8::Gemm g{HB_ + (size_t)r0 * DM, WL(SZ_WIN), Mrows, DM, DM, DM}; pg8::StaticOrder S; S.init(Mrows, DM, tc.G, tc.bid);
                      pg8::EpiRes E{(l == 0) ? P->in[0] : (const float*)P->out, (l == 0) ? P->in[2] : (const float*)XC_, P->out, XC_, MODL + 2 * DM, pm_off}; pg8::gemm_phase(tc, lds, g, S, E); } break;
            case 7: if (PHMASK & (1 << 9)) phase_norm(tc, P, lds, l, 1, P->out, XC_, r0, false); break;
            case 8: if (PHMASK & (1 << 10)) { pg8::Gemm g{HB_ + (size_t)r0 * DM, WL(SZ_WIN + SZ_WOUT), Mrows, DFF, DM, DM}; pg8::StaticOrder S; S.init(Mrows, DFF, tc.G, tc.bid); pg8::EpiBf<1> E{(bf16_t*)(ws + WS_U) + (size_t)r0 * DFF, DFF}; pg8::gemm_phase(tc, lds, g, S, E); } break;
            case 9: if (PHMASK & (1 << 11)) { pg8::Gemm g{(const bf16_t*)(ws + WS_U) + (size_t)r0 * DFF, WL(SZ_WIN + SZ_WOUT + SZ_W1), Mrows, DM, DFF, DFF}; pg8::StaticOrder S; S.init(Mrows, DM, tc.G, tc.bid);
                      pg8::EpiRes E{P->out, XC_, P->out, XC_, MODL + 5 * DM, pm_off}; pg8::gemm_phase(tc, lds, g, S, E); } break;
            }
        }
        if (ph + 1 < Pk.ph_hi) grid.sync();
    }
}

extern "C" void kernel_launch(void* const* d_in, const int* in_sizes, int n_in, void* d_out, int out_size, void* d_ws, size_t ws_size, hipStream_t stream) {
    static int grid = 0;
    if (grid == 0) {
        if (n_in != 30 || in_sizes[0] != MLAT * DM || out_size != MLAT * DM || ws_size < WS_END) {
            fprintf(stderr, "kernel_launch: unexpected shapes: n_in %d in0 %d out %d ws %zu (need %zu)\n", n_in, n_in > 0 ? in_sizes[0] : -1, out_size, ws_size, (size_t)WS_END); grid = -1; return; }
        int dev = 0, cus = 0, per_cu = 0;
        hipGetDevice(&dev); hipDeviceGetAttribute(&cus, hipDeviceAttributeMultiprocessorCount, dev);
        if (hipFuncSetAttribute((const void*)mega, hipFuncAttributeMaxDynamicSharedMemorySize, LDS_BYTES) != hipSuccess) { fprintf(stderr, "kernel_launch: hipFuncSetAttribute failed\n"); grid = -1; return; }
        if (hipOccupancyMaxActiveBlocksPerMultiprocessor(&per_cu, (const void*)mega, 512, LDS_BYTES) != hipSuccess || per_cu < 1) { fprintf(stderr, "kernel_launch: occupancy query failed (%d)\n", per_cu); (void)hipGetLastError(); per_cu = 1; }
        grid = cus * 1;
        if (per_cu < 1) grid = -1;
    }
    if (grid < 0) return;
    Params p{};
    for (int i = 0; i < 30; ++i) p.in[i] = (const float*)d_in[i];
    p.out = (float*)d_out; p.ws = (unsigned char*)d_ws;
#if MK_MULTI
    for (int ph = 0; ph < NPHASE; ++ph) { p.ph_lo = ph; p.ph_hi = ph + 1; hipLaunchKernelGGL(mega, dim3(grid), dim3(512), LDS_BYTES, stream, p); }
#else
    p.ph_lo = 0; p.ph_hi = NPHASE;
    void* args[] = {&p};
    hipError_t e = hipLaunchCooperativeKernel((const void*)mega, dim3(grid), dim3(512), args, LDS_BYTES, stream);
    if (e != hipSuccess) fprintf(stderr, "cooperative launch failed: %s (grid %d)\n", hipGetErrorString(e), grid);
#endif
}
```

```cpp
#include <hip/hip_runtime.h>
#include <hip/hip_cooperative_groups.h>
#include <cstdio>
#include <cstdint>
namespace cg = cooperative_groups;

#ifndef MK_MULTI
#define MK_MULTI 0
#endif

#define LAS __attribute__((address_space(3)))
typedef unsigned short bf16_t;
typedef short bf16x8 __attribute__((ext_vector_type(8)));
typedef float f32x4 __attribute__((ext_vector_type(4)));
typedef float f32x2 __attribute__((ext_vector_type(2)));
typedef unsigned u32x4 __attribute__((ext_vector_type(4)));
typedef unsigned u32x2 __attribute__((ext_vector_type(2)));

constexpr int NB = 8, TLAT = 4096, TCTX = 256, DM = 1024, DEPTH = 2, DG = 256, DIN = 3600, NZ = 3584, DFF = 4096;
constexpr int MCTX = NB * TCTX, MLAT = NB * TLAT, MALL = MCTX + MLAT;
constexpr int TSEQ = TCTX + TLAT;
constexpr float EPS = 1e-6f;
constexpr int ZC_HQ = 0, ZC_HI = 256, ZC_HG = 512, ZC_HF = 768, ZC_RQ = 1280, ZC_RK = 1536, ZC_RV = 1792, ZC_RG = 2048, ZC_GQKV = 2304, ZC_GG = 3072, ZC_SU = 3328;

constexpr size_t SZ_WIN = (size_t)NZ * DM * 2, SZ_WOUT = (size_t)DM * DM * 2, SZ_W1 = (size_t)DFF * DM * 2, SZ_W2 = (size_t)DM * DFF * 2, SZ_GLU = (size_t)DG * DG * 2, SZ_WAB = 16 * DM * 4;
constexpr size_t SZ_WL = SZ_WIN + SZ_WOUT + SZ_W1 + SZ_W2 + SZ_GLU + SZ_WAB;
constexpr size_t WS_W = 0;
constexpr size_t WS_MOD = WS_W + 2 * SZ_WL;
constexpr size_t WS_ROPE = WS_MOD + (size_t)2 * 9 * 6144 * 4;
constexpr size_t WS_LB = WS_ROPE + (size_t)TSEQ * 32 * 2 * 4;
constexpr size_t WS_S5P = WS_LB + 4096;
constexpr size_t WS_XC = WS_S5P + (size_t)2 * 2 * 16 * 64 * 34 * 4;
constexpr size_t WS_AB = WS_XC + (size_t)MCTX * DM * 4;
constexpr size_t WS_HB = WS_AB + (size_t)MALL * 16 * 4;
constexpr size_t WS_Z = WS_HB + (size_t)MALL * DM * 2;
constexpr size_t WS_OF = WS_Z + (size_t)MALL * NZ * 2;
constexpr size_t WS_OB = WS_OF + (size_t)MALL * DM * 2;
constexpr size_t WS_END = WS_OB + (size_t)MALL * DM * 2;
constexpr size_t WS_U = WS_Z;
static_assert(WS_U + (size_t)MALL * DFF * 2 <= WS_END, "U overlay");
static_assert(WS_MOD % 256 == 0 && WS_ROPE % 256 == 0 && WS_S5P % 256 == 0 && WS_XC % 256 == 0 && WS_AB % 256 == 0 && WS_HB % 256 == 0 && WS_Z % 256 == 0 && WS_OF % 256 == 0, "align");

constexpr int LDS_BYTES = 147456;
constexpr int NPHASE = 22;

struct Params {
    const float* in[30];
    float* out;
    unsigned char* ws;
    int ph_lo, ph_hi;
};
typedef const __attribute__((address_space(4))) Params* KP;
struct TC { int tid, bid, G; };

__device__ __forceinline__ unsigned f2bf(float f) { unsigned u = __builtin_bit_cast(unsigned, f); return (u + 0x7fffu + ((u >> 16) & 1u)) >> 16; }
__device__ __forceinline__ unsigned pk2(float lo, float hi) { return f2bf(lo) | (f2bf(hi) << 16); }
__device__ __forceinline__ float bflo(unsigned w) { return __builtin_bit_cast(float, w << 16); }
__device__ __forceinline__ float bfhi(unsigned w) { return __builtin_bit_cast(float, w & 0xffff0000u); }
__device__ __forceinline__ float wave_sum(float v) {
#pragma unroll
    for (int o = 1; o < 64; o <<= 1) v += __shfl_xor(v, o);
    return v;
}
__device__ __forceinline__ float quad_sum(float x) {
    x += __builtin_bit_cast(float, __builtin_amdgcn_mov_dpp(__builtin_bit_cast(int, x), 0xB1, 0xf, 0xf, true));
    x += __builtin_bit_cast(float, __builtin_amdgcn_mov_dpp(__builtin_bit_cast(int, x), 0x4E, 0xf, 0xf, true));
    return x;
}
__device__ __forceinline__ float sigmoidf_(float x) { return __builtin_amdgcn_rcpf(1.0f + __builtin_amdgcn_exp2f(-1.4426950408889634f * x)); }
__device__ __forceinline__ float siluf_(float x) { return x / (1.0f + __expf(-x)); }
__device__ __forceinline__ float gelu_tanh(float x) { const float u = 0.7978845608028654f * (x + 0.044715f * x * x * x); return 0.5f * x * (1.0f + tanhf(u)); }
__device__ __forceinline__ float reduce16(float (&p)[16], int lane) {
    bool b = (lane & 32) != 0;
#pragma unroll
    for (int i = 0; i < 8; ++i) { const float keep = b ? p[i + 8] : p[i], send = b ? p[i] : p[i + 8]; p[i] = keep + __shfl_xor(send, 32); }
    b = (lane & 16) != 0;
#pragma unroll
    for (int i = 0; i < 4; ++i) { const float keep = b ? p[i + 4] : p[i], send = b ? p[i] : p[i + 4]; p[i] = keep + __shfl_xor(send, 16); }
    b = (lane & 8) != 0;
#pragma unroll
    for (int i = 0; i < 2; ++i) { const float keep = b ? p[i + 2] : p[i], send = b ? p[i] : p[i + 2]; p[i] = keep + __shfl_xor(send, 8); }
    b = (lane & 4) != 0;
    { const float keep = b ? p[1] : p[0], send = b ? p[0] : p[1]; p[0] = keep + __shfl_xor(send, 4); }
    p[0] += __shfl_xor(p[0], 2); p[0] += __shfl_xor(p[0], 1);
    return p[0];
}
__device__ __forceinline__ int seq_row(int b, int d, int j) {
    if (j < TCTX) return b * TCTX + (d ? (TCTX - 1 - j) : j);
    const int t = j - TCTX; return MCTX + b * TLAT + (d ? (TLAT - 1 - t) : t);
}

namespace pg8 {
constexpr int BM = 256, BK = 64, HALF = 128, HTB = HALF * BK * 2, STAGE_BYTES = 8 * HTB, NXCD = 8, WGM = 8;
__host__ __device__ __forceinline__ int lds_byte(int r, int c) { const int st = (r >> 4) * 2 + (c >> 5), rr = r & 15, cc = c & 31, ob = rr * 64 + cc * 2; return st * 1024 + (ob ^ (((ob >> 9) & 1) << 5)); }
__host__ __device__ __forceinline__ void stage_rc(int b, int& R, int& C) { const int st = b / 1024, sb = b % 1024, swz = sb ^ (((sb >> 9) & 1) << 5); R = (st >> 1) * 16 + swz / 64; C = (st & 1) * 32 + (swz % 64) / 2; }
__host__ __device__ __forceinline__ int perm32(int rho) { const int n = rho >> 4, i = rho & 15; return 8 * (i >> 2) + 4 * n + (i & 3); }
struct Unit { int pm, pn; };
struct Gemm { const bf16_t* A; const bf16_t* Bt; int M, N, K, lda; };
struct StaticOrder {
    int nM, nN, nwg, G, c;
    __device__ void init(int M, int N, int G_, int c_) { nM = M / BM; nN = N / BM; nwg = nM * nN; G = G_; c = c_; }
    __device__ bool next(int i, Unit& u) const {
        const long L = (long)i * G + c; if (L >= nwg) return false;
        int wgid = (int)L; { const int q = nwg / NXCD, r = nwg % NXCD, xcd = wgid % NXCD, off = wgid / NXCD; wgid = (xcd < r ? xcd * (q + 1) : r * (q + 1) + (xcd - r) * q) + off; }
        const int nig = WGM * nN, gid = wgid / nig, fm = gid * WGM, gsz = (nM - fm) < WGM ? (nM - fm) : WGM;
        u.pm = fm + ((wgid % nig) % gsz); u.pn = (wgid % nig) / gsz; return true;
    }
};
template <class Epi>
__device__ __forceinline__ void gemm_phase(const TC tc, LAS unsigned char* lds, const Gemm g, const StaticOrder& S, const Epi& E) {
    const int tid = tc.tid, wid = __builtin_amdgcn_readfirstlane(tid >> 6), lane = tid & 63, wr = wid >> 2, wc = wid & 3, fr = lane & 15, fq = lane >> 4;
    const int K = g.K, nt = K / BK, lda = g.lda;
    unsigned voffA[2], voffB[2];
#pragma unroll
    for (int i = 0; i < 2; ++i) { int R, C; stage_rc(tid * 16 + i * 8192, R, C); const int Rb = Epi::PERM ? ((R & ~31) + perm32(R & 31)) : R;
        voffA[i] = (unsigned)(R * lda + C) * 2u; voffB[i] = (unsigned)(Rb * K + C) * 2u; }
    const size_t kstep = (size_t)(BK * 2);
    const size_t hstepA = (size_t)HALF * lda * 2, hstepB = (size_t)HALF * K * 2;
    const size_t tstepA = 2 * hstepA, tstepB = 2 * hstepB;
    const unsigned ldsw = (unsigned)wid * 1024u;
    const int aoff = lds_byte(wr * 64 + fr, fq * 8), boff = lds_byte(wc * 32 + fr, fq * 8);
#define PG8_SA(b, h) (((b) * 2 + (h)) * HTB)
#define PG8_SB(b, h) ((4 + (b) * 2 + (h)) * HTB)
#define PG8_STAGE(bufoff, gbase, voff) do { _Pragma("unroll") for (int _i = 0; _i < 2; ++_i) \
        __builtin_amdgcn_global_load_lds((const unsigned*)((const char*)(gbase) + (voff)[_i]), (LAS unsigned*)(lds + (bufoff) + ldsw + _i * 8192), 16, 0, 0); } while (0)
#define PG8_LDA(dst, b, h) do { _Pragma("unroll") for (int m = 0; m < 4; ++m) _Pragma("unroll") for (int k = 0; k < 2; ++k) dst[m][k] = *(const LAS bf16x8*)(lds + PG8_SA(b, h) + aoff + m * 2048 + k * 1024); } while (0)
#define PG8_LDB(dst, b, h) do { _Pragma("unroll") for (int n = 0; n < 2; ++n) _Pragma("unroll") for (int k = 0; k < 2; ++k) dst[n][k] = *(const LAS bf16x8*)(lds + PG8_SB(b, h) + boff + n * 2048 + k * 1024); } while (0)
#define PG8_MMA(ai, bj, At, Bt) do { __builtin_amdgcn_s_setprio(1); _Pragma("unroll") for (int m = 0; m < 4; ++m) _Pragma("unroll") for (int n = 0; n < 2; ++n) _Pragma("unroll") for (int k = 0; k < 2; ++k) \
        acc[ai][bj][m][n] = __builtin_amdgcn_mfma_f32_16x16x32_bf16(Bt[n][k], At[m][k], acc[ai][bj][m][n], 0, 0, 0); __builtin_amdgcn_s_setprio(0); } while (0)
#define PG8_WAIT_V(n) asm volatile("s_waitcnt vmcnt(" #n ")" ::: "memory")
#define PG8_WAIT_L(n) asm volatile("s_waitcnt lgkmcnt(" #n ")" ::: "memory")
#define PG8_BAR __builtin_amdgcn_s_barrier()
#define PG8_SCHED __builtin_amdgcn_sched_barrier(0)
    Unit cur, nxt; int ui = 0;
    if (!S.next(0, cur)) return;
    f32x4 acc[2][2][4][2];
#pragma unroll
    for (int a = 0; a < 2; ++a)
#pragma unroll
        for (int b = 0; b < 2; ++b)
#pragma unroll
            for (int m = 0; m < 4; ++m)
#pragma unroll
                for (int n = 0; n < 2; ++n) acc[a][b][m][n] = (f32x4){0.f, 0.f, 0.f, 0.f};
    bf16x8 At[4][2], B0[2][2], B1[2][2];
    const char* cA = (const char*)g.A + (size_t)cur.pm * tstepA; const char* cB = (const char*)g.Bt + (size_t)cur.pn * tstepB;
    PG8_STAGE(PG8_SB(0, 0), cB, voffB); PG8_STAGE(PG8_SB(0, 1), cB + hstepB, voffB); PG8_STAGE(PG8_SA(0, 0), cA, voffA); PG8_STAGE(PG8_SA(0, 1), cA + hstepA, voffA);
    if (wr == 1) PG8_BAR;
    PG8_WAIT_V(2); PG8_BAR;
    PG8_STAGE(PG8_SB(1, 0), cB + kstep, voffB); PG8_STAGE(PG8_SA(1, 0), cA + kstep, voffA); PG8_STAGE(PG8_SB(1, 1), cB + hstepB + kstep, voffB);
    PG8_WAIT_V(6); PG8_BAR;
    for (;;) {
        const bool has_next = S.next(ui + 1, nxt);
        const char* nA = has_next ? (const char*)g.A + (size_t)nxt.pm * tstepA : cA; const char* nB = has_next ? (const char*)g.Bt + (size_t)nxt.pn * tstepB : cB;
        for (int t = 0; t < nt; t += 2) {
            const bool last = (t == nt - 2);
            const char* a1 = cA + (size_t)(t + 1) * kstep;
            const char* a2 = last ? nA : cA + (size_t)(t + 2) * kstep; const char* b2 = last ? nB : cB + (size_t)(t + 2) * kstep;
            const char* a3 = a2 + kstep; const char* b3 = b2 + kstep;
            PG8_LDB(B0, 0, 0); PG8_LDB(B1, 0, 1); PG8_SCHED; PG8_LDA(At, 0, 0); PG8_STAGE(PG8_SA(1, 1), a1 + hstepA, voffA);
            PG8_WAIT_V(8); PG8_WAIT_L(0); PG8_BAR; PG8_MMA(0, 0, At, B0); PG8_MMA(0, 1, At, B1); PG8_BAR; PG8_SCHED;
            PG8_LDA(At, 0, 1); PG8_STAGE(PG8_SB(0, 0), b2, voffB); PG8_STAGE(PG8_SB(0, 1), b2 + hstepB, voffB); PG8_STAGE(PG8_SA(0, 0), a2, voffA);
            PG8_WAIT_V(8); PG8_WAIT_L(0); PG8_BAR; PG8_MMA(1, 0, At, B0); PG8_MMA(1, 1, At, B1); PG8_BAR; PG8_SCHED;
            PG8_LDB(B0, 1, 0); PG8_LDB(B1, 1, 1); PG8_SCHED; PG8_LDA(At, 1, 0); PG8_STAGE(PG8_SA(0, 1), a2 + hstepA, voffA);
            PG8_WAIT_V(8); PG8_WAIT_L(0); PG8_BAR; PG8_MMA(0, 0, At, B0); PG8_MMA(0, 1, At, B1); PG8_BAR; PG8_SCHED;
            PG8_LDA(At, 1, 1); PG8_STAGE(PG8_SB(1, 0), b3, voffB); PG8_STAGE(PG8_SB(1, 1), b3 + hstepB, voffB); PG8_STAGE(PG8_SA(1, 0), a3, voffA);
            PG8_WAIT_V(8); PG8_WAIT_L(0); PG8_BAR; PG8_MMA(1, 0, At, B0); PG8_MMA(1, 1, At, B1); PG8_BAR; PG8_SCHED;
        }
        if (wr == 0) PG8_BAR;
        E(acc, cur, wr, wc, fr, fq);
        if (!has_next) break;
#pragma unroll
        for (int a = 0; a < 2; ++a)
#pragma unroll
            for (int b = 0; b < 2; ++b)
#pragma unroll
                for (int m = 0; m < 4; ++m)
#pragma unroll
                    for (int n = 0; n < 2; ++n) acc[a][b][m][n] = (f32x4){0.f, 0.f, 0.f, 0.f};
        cur = nxt; cA = nA; cB = nB; ++ui;
        if (wr == 1) PG8_BAR;
    }
    PG8_WAIT_V(0);
    PG8_BAR;
#undef PG8_SA
#undef PG8_SB
#undef PG8_STAGE
#undef PG8_LDA
#undef PG8_LDB
#undef PG8_MMA
#undef PG8_WAIT_V
#undef PG8_WAIT_L
#undef PG8_BAR
#undef PG8_SCHED
}

template <int ACT> struct EpiBf {
    static constexpr bool PERM = true;
    bf16_t* O; int ldc;
    __device__ __forceinline__ void operator()(const f32x4 (&acc)[2][2][4][2], const Unit& u, int wr, int wc, int fr, int fq) const {
        const int row0 = u.pm * BM + wr * 64 + fr, col0 = u.pn * BM + wc * 32 + 8 * fq;
#pragma unroll
        for (int ai = 0; ai < 2; ++ai)
#pragma unroll
            for (int m = 0; m < 4; ++m) { bf16_t* rowp = O + (size_t)(row0 + ai * HALF + m * 16) * ldc + col0;
#pragma unroll
                for (int bj = 0; bj < 2; ++bj) { f32x4 v0 = acc[ai][bj][m][0], v1 = acc[ai][bj][m][1];
                    if (ACT == 1) {
#pragma unroll
                        for (int e = 0; e < 4; ++e) { const float a = fmaxf(v0[e], 0.f), b = fmaxf(v1[e], 0.f); v0[e] = a * a; v1[e] = b * b; } }
                    u32x4 w; w.x = pk2(v0[0], v0[1]); w.y = pk2(v0[2], v0[3]); w.z = pk2(v1[0], v1[1]); w.w = pk2(v1[2], v1[3]);
                    *(u32x4*)(rowp + bj * HALF) = w; } }
    }
};
struct EpiRes {
    static constexpr bool PERM = false;
    const float* in_lat; const float* in_ctx; float* out_lat; float* out_ctx; const float* gate; int pm_off;
    __device__ __forceinline__ void operator()(const f32x4 (&acc)[2][2][4][2], const Unit& u, int wr, int wc, int fr, int fq) const {
        const int gpm = u.pm + pm_off;
        const float* rin; float* rout; int v;
        if (gpm < 8) { rin = in_ctx + (size_t)gpm * 256 * DM; rout = out_ctx + (size_t)gpm * 256 * DM; v = 8; }
        else { rin = in_lat + (size_t)(gpm - 8) * 256 * DM; rout = out_lat + (size_t)(gpm - 8) * 256 * DM; v = (gpm - 8) >> 4; }
        const int col0 = u.pn * BM + wc * 32 + 4 * fq;
        const float* gp = gate + (size_t)v * 6144 + col0;
        f32x4 gv[2][2];
#pragma unroll
        for (int bj = 0; bj < 2; ++bj)
#pragma unroll
            for (int n = 0; n < 2; ++n) gv[bj][n] = *(const f32x4*)(gp + bj * HALF + n * 16);
#pragma unroll
        for (int ai = 0; ai < 2; ++ai)
#pragma unroll
            for (int m = 0; m < 4; ++m) { const size_t off = (size_t)(ai * HALF + wr * 64 + m * 16 + fr) * DM + col0;
#pragma unroll
                for (int bj = 0; bj < 2; ++bj)
#pragma unroll
                    for (int n = 0; n < 2; ++n) { const f32x4 x = *(const f32x4*)(rin + off + bj * HALF + n * 16); *(f32x4*)(rout + off + bj * HALF + n * 16) = x + gv[bj][n] * acc[ai][bj][m][n]; }
                asm volatile("" ::: "memory"); }
    }
};
}

__device__ __forceinline__ void transpose_item(const float* W, int ldw, int c0, int K, bf16_t* WT, int nblk, LAS float* scr, int item, int lane) {
    const int kb = item / nblk, nb = item % nblk, k0 = 64 * kb, n0 = 32 * nb;
#pragma unroll 8
    for (int i = 0; i < 32; ++i) { const int kk = 2 * i + (lane >> 5); scr[kk * 33 + (lane & 31)] = W[(size_t)(k0 + kk) * ldw + c0 + n0 + (lane & 31)]; }
    asm volatile("s_waitcnt lgkmcnt(0)" ::: "memory");
    const int c = lane & 7;
#pragma unroll
    for (int j = 0; j < 4; ++j) { const int n = (lane >> 3) + 8 * j; const LAS float* s = scr + (8 * c) * 33 + n;
        u32x4 o; o.x = pk2(s[0 * 33], s[1 * 33]); o.y = pk2(s[2 * 33], s[3 * 33]); o.z = pk2(s[4 * 33], s[5 * 33]); o.w = pk2(s[6 * 33], s[7 * 33]);
        *(u32x4*)(WT + (size_t)(n0 + n) * K + k0 + 8 * c) = o; }
    asm volatile("s_waitcnt lgkmcnt(0)" ::: "memory");
}

__device__ __forceinline__ void phase_prologue(const TC tc, KP P, LAS unsigned char* lds) {
    const int tid = tc.tid, lane = tid & 63, wave = tid >> 6;
    const int G = tc.G, gw = tc.bid * 8 + wave, NGW = G * 8;
    unsigned char* ws = P->ws;
    {
        LAS float* scr = (LAS float*)(lds + wave * 8704);
        constexpr int I_IN_A = 16 * 104, I_IN_B = 16 * 8, I_OUT = 16 * 32, I_1 = 16 * 128, I_2 = 64 * 32, I_G = 4 * 8;
        constexpr int I_L = I_IN_A + I_IN_B + I_OUT + I_1 + I_2 + I_G;
        for (int it = gw; it < 2 * I_L; it += NGW) {
            const int l = it / I_L; int r = it % I_L;
            unsigned char* wl = ws + WS_W + (size_t)l * SZ_WL;
            bf16_t* win = (bf16_t*)wl; bf16_t* wout = (bf16_t*)(wl + SZ_WIN); bf16_t* w1 = (bf16_t*)(wl + SZ_WIN + SZ_WOUT); bf16_t* w2 = (bf16_t*)(wl + SZ_WIN + SZ_WOUT + SZ_W1);
            bf16_t* wg = (bf16_t*)(wl + SZ_WIN + SZ_WOUT + SZ_W1 + SZ_W2);
            if (r < I_IN_A) { transpose_item(P->in[8] + (size_t)l * DM * DIN, DIN, 0, DM, win, 104, scr, r, lane); continue; } r -= I_IN_A;
            if (r < I_IN_B) { transpose_item(P->in[8] + (size_t)l * DM * DIN, DIN, 3344, DM, win + (size_t)3328 * DM, 8, scr, r, lane); continue; } r -= I_IN_B;
            if (r < I_OUT) { transpose_item(P->in[26] + (size_t)l * DM * DM, DM, 0, DM, wout, 32, scr, r, lane); continue; } r -= I_OUT;
            if (r < I_1) { transpose_item(P->in[27] + (size_t)l * DM * DFF, DFF, 0, DM, w1, 128, scr, r, lane); continue; } r -= I_1;
            if (r < I_2) { transpose_item(P->in[28] + (size_t)l * DFF * DM, DM, 0, DFF, w2, 32, scr, r, lane); continue; } r -= I_2;
            transpose_item(P->in[24] + (size_t)l * DG * DG, DG, 0, DG, wg, 8, scr, r, lane);
        }
    }
    const int gt = tc.bid * 512 + tid, NGT = G * 512;
    for (int i = gt; i < 2 * 16 * DM; i += NGT) { const int l = i / (16 * DM), c = (i / DM) % 16, k = i % DM;
        ((float*)(ws + WS_W + (size_t)l * SZ_WL + SZ_WL - SZ_WAB))[c * DM + k] = P->in[8][(size_t)l * DM * DIN + (size_t)k * DIN + 3328 + c]; }
    for (int i = gt; i < TSEQ * 32; i += NGT) { const int pos = i >> 5, f = i & 31;
        const float inv = powf(10000.0f, -(float)f / 32.0f); const float ang = (float)pos * inv; float s, c; sincosf(ang, &s, &c);
        ((f32x2*)(ws + WS_ROPE))[i] = (f32x2){c, s}; }
    for (int i = gt; i < 2 * DG; i += NGT) { const float a = P->in[9][i], b = P->in[9][2 * DG + i]; const float mx = fmaxf(a, b), ea = expf(a - mx), eb = expf(b - mx);
        float* lb = (float*)(ws + WS_LB); lb[i] = 0.f; lb[2 * DG + i] = eb / (ea + eb); }
    for (int i = gt; i < 2 * 2 * 16 * 64; i += NGT) { const int p = i & 63, g = (i >> 6) & 15, d = (i >> 10) & 1, l = i >> 11;
        const float lr = P->in[16][i], li = P->in[17][i]; const float dt = expf(P->in[18][(l * 2 + d) * 16 + g]);
        const float mag = expf(lr * dt); float sn, cs; sincosf(li * dt, &sn, &cs); const float ar = mag * cs, ai = mag * sn;
        const float den = lr * lr + li * li, nr = ar - 1.0f, ni = ai; const float fr = (nr * lr + ni * li) / den, fi = (ni * lr - nr * li) / den;
        float* o = (float*)(ws + WS_S5P) + (size_t)i * 34; o[0] = ar; o[1] = ai;
        const float* bre = P->in[19] + ((size_t)(l * 16 + g) * 64 + p) * 16; const float* bim = P->in[20] + ((size_t)(l * 16 + g) * 64 + p) * 16;
        for (int c = 0; c < 16; ++c) { o[2 + c] = fr * bre[c] - fi * bim[c]; o[18 + c] = fr * bim[c] + fi * bre[c]; } }
    __syncthreads();
    {
        LAS float* sc = (LAS float*)lds;
        LAS float* red = (LAS float*)(lds + 36864);
        for (int i = tid; i < 9 * DM; i += 512) { const int v = i >> 10, k = i & 1023; const float x = v < 8 ? P->in[1][v * DM + k] : P->in[3][k]; sc[i] = siluf_(x); }
        __syncthreads();
        for (int item = tc.bid; item < 2 * 96; item += G) {
            const int l = item / 96, cg0 = (item % 96) * 64;
            const int c4 = (tid & 15) * 4, kl = tid >> 4;
            const float* W = P->in[4] + (size_t)l * DM * 6144 + cg0 + c4;
            f32x4 a[9];
#pragma unroll
            for (int v = 0; v < 9; ++v) a[v] = (f32x4){0.f, 0.f, 0.f, 0.f};
            for (int k = kl; k < DM; k += 32) { const f32x4 w = *(const f32x4*)(W + (size_t)k * 6144);
#pragma unroll
                for (int v = 0; v < 9; ++v) a[v] += w * sc[v * DM + k]; }
#pragma unroll
            for (int v = 0; v < 9; ++v) *(LAS f32x4*)(red + kl * 576 + v * 64 + c4) = a[v];
            __syncthreads();
            for (int o = tid; o < 576; o += 512) { float s = 0.f; for (int q = 0; q < 32; ++q) s += red[q * 576 + o];
                const int v = o >> 6, c = cg0 + (o & 63);
                ((float*)(ws + WS_MOD))[((size_t)l * 9 + v) * 6144 + c] = s + P->in[5][l * 6144 + c]; }
            __syncthreads();
        }
    }
}

__device__ __forceinline__ void phase_norm(const TC tc, KP P, LAS unsigned char* lds, int l, int which, const float* src_lat, const float* src_ctx, int r0, bool do_ab) {
    const int tid = tc.tid, lane = tid & 63, wave = tid >> 6;
    const int gw = tc.bid * 8 + wave, NGW = tc.G * 8;
    unsigned char* ws = P->ws;
    LAS float* wab = (LAS float*)lds;
    if (do_ab) { const float* src = (const float*)(ws + WS_W + (size_t)l * SZ_WL + SZ_WL - SZ_WAB);
        for (int i = tid; i < 16 * DM / 4; i += 512) ((LAS f32x4*)wab)[i] = ((const f32x4*)src)[i];
        __syncthreads(); }
    const float* gvec = P->in[which ? 7 : 6] + l * DM;
    const float* mod = (const float*)(ws + WS_MOD) + (size_t)l * 9 * 6144;
    bf16_t* H = (bf16_t*)(ws + WS_HB);
    float* AB = (float*)(ws + WS_AB);
    for (int r = r0 + gw; r < MALL; r += NGW) {
        const float* xrow; int v;
        if (r < MCTX) { xrow = src_ctx + (size_t)r * DM; v = 8; } else { xrow = src_lat + (size_t)(r - MCTX) * DM; v = (r - MCTX) >> 12; }
        const float* sh = mod + (size_t)v * 6144 + (which ? 3 : 0) * DM; const float* scl = mod + (size_t)v * 6144 + (which ? 4 : 1) * DM;
        f32x4 x[4]; float ss = 0.f;
#pragma unroll
        for (int j = 0; j < 4; ++j) { x[j] = ((const f32x4*)xrow)[j * 64 + lane]; ss += (x[j].x * x[j].x + x[j].y * x[j].y) + (x[j].z * x[j].z + x[j].w * x[j].w); }
        const float rstd = rsqrtf(wave_sum(ss) * (1.0f / DM) + EPS);
#pragma unroll
        for (int j = 0; j < 4; ++j) { const f32x4 g = ((const f32x4*)gvec)[j * 64 + lane], s1 = ((const f32x4*)scl)[j * 64 + lane], s0 = ((const f32x4*)sh)[j * 64 + lane];
            x[j] = x[j] * rstd * g * (1.0f + s1) + s0;
            u32x2 w; w.x = pk2(x[j].x, x[j].y); w.y = pk2(x[j].z, x[j].w);
            ((u32x2*)(H + (size_t)r * DM))[j * 64 + lane] = w; }
        if (do_ab) {
#pragma unroll 1
            for (int cq = 0; cq < 4; ++cq) {
                float p[4];
#pragma unroll
                for (int c = 0; c < 4; ++c) { float a = 0.f;
#pragma unroll
                    for (int j = 0; j < 4; ++j) { const f32x4 w = *(const LAS f32x4*)(wab + (cq * 4 + c) * DM + (j * 64 + lane) * 4); a += (x[j].x * w.x + x[j].y * w.y) + (x[j].z * w.z + x[j].w * w.w); }
                    p[c] = a; }
                bool bb = (lane & 32) != 0;
                { const float k0 = bb ? p[2] : p[0], s0 = bb ? p[0] : p[2], k1 = bb ? p[3] : p[1], s1 = bb ? p[1] : p[3]; p[0] = k0 + __shfl_xor(s0, 32); p[1] = k1 + __shfl_xor(s1, 32); }
                bb = (lane & 16) != 0;
                { const float k0 = bb ? p[1] : p[0], s0 = bb ? p[0] : p[1]; p[0] = k0 + __shfl_xor(s0, 16); }
                float tot = p[0];
                tot += __shfl_xor(tot, 8); tot += __shfl_xor(tot, 4); tot += __shfl_xor(tot, 2); tot += __shfl_xor(tot, 1);
                if ((lane & 15) == 0) { const int c = cq * 4 + 2 * ((lane >> 5) & 1) + ((lane >> 4) & 1);
                    float o;
                    if (c < 8) { const int d = c >> 2, h = c & 3; const float xx = tot + P->in[14][(l * 2 + d) * 4 + h]; const float sp = xx > 20.f ? xx : log1pf(expf(xx));
                        o = -expf(P->in[13][(l * 2 + d) * 4 + h]) * sp; }
                    else o = 1.0f / (1.0f + expf(-tot));
                    AB[(size_t)r * 16 + c] = o; }
            }
        }
    }
}

__device__ __forceinline__ void phase_mixpre(const TC tc, KP P, int l) {
    const int tid = tc.tid, lane = tid & 63, wave = tid >> 6;
    const int gw = tc.bid * 8 + wave, NGW = tc.G * 8;
    unsigned char* ws = P->ws;
    bf16_t* Z = (bf16_t*)(ws + WS_Z);
    bf16_t* QC = (bf16_t*)(ws + WS_HB);
    const float* lb = (const float*)(ws + WS_LB) + l * 2 * DG;
    const f32x2* rope = (const f32x2*)(ws + WS_ROPE);
    const float* cw = P->in[12] + (size_t)l * 9 * 768;
    for (int r = gw; r < MALL; r += NGW) {
        bf16_t* zr = Z + (size_t)r * NZ;
        int pos, b, s; bool isctx = r < MCTX;
        if (isctx) { b = r >> 8; s = r & 255; pos = s; } else { b = (r - MCTX) >> 12; s = (r - MCTX) & 4095; pos = TCTX + s; }
        { u32x2 w = ((u32x2*)(zr + ZC_HQ))[lane];
          w.x = pk2(siluf_(bflo(w.x)) * 0.125f, siluf_(bfhi(w.x)) * 0.125f); w.y = pk2(siluf_(bflo(w.y)) * 0.125f, siluf_(bfhi(w.y)) * 0.125f);
          ((u32x2*)(zr + ZC_HQ))[lane] = w; }
        { u32x4 w = ((u32x4*)(zr + ZC_HF))[lane]; const int c0 = lane * 8; unsigned* pw = (unsigned*)&w;
#pragma unroll
          for (int e = 0; e < 4; ++e) { const int c = c0 + 2 * e;
              const float f0 = bflo(pw[e]), f1 = bfhi(pw[e]);
              const float l0 = fmaxf(lb[c], 1e-30f), l1 = fmaxf(lb[c + 1], 1e-30f);
              const float s0 = 1.0f / (1.0f + expf(-f0)), s1 = 1.0f / (1.0f + expf(-f1));
              pw[e] = pk2(logf(l0 * (1.0f - s0) + s0), logf(l1 * (1.0f - s1) + s1)); }
          ((u32x4*)(zr + ZC_HF))[lane] = w; }
        {
#pragma unroll
          for (int qk = 0; qk < 2; ++qk) { bf16_t* base = zr + (qk ? ZC_RK : ZC_RQ) + (lane >> 4) * 64 + (lane & 15) * 2;
              const unsigned w1 = *(const unsigned*)base, w2 = *(const unsigned*)(base + 32);
              const f32x2 cs0 = rope[pos * 32 + (lane & 15) * 2], cs1 = rope[pos * 32 + (lane & 15) * 2 + 1];
              const float sc = qk ? 0.125f : 1.0f;
              const float a0 = bflo(w1), a1 = bfhi(w1), b0 = bflo(w2), b1 = bfhi(w2);
              *(unsigned*)base = pk2((a0 * cs0.x - b0 * cs0.y) * sc, (a1 * cs1.x - b1 * cs1.y) * sc);
              *(unsigned*)(base + 32) = pk2((a0 * cs0.y + b0 * cs0.x) * sc, (a1 * cs1.y + b1 * cs1.x) * sc); } }
        {
            float acc[3][4];
#pragma unroll
            for (int g = 0; g < 3; ++g)
#pragma unroll
                for (int e = 0; e < 4; ++e) acc[g][e] = 0.f;
            const int gx = isctx ? s : (s & 63), gy = isctx ? 0 : (s >> 6), W = isctx ? TCTX : 64, Hh = isctx ? 1 : 64;
#pragma unroll
            for (int dy = 0; dy < 3; ++dy) { const int yy = gy + dy - 1; if (yy < 0 || yy >= Hh) continue;
#pragma unroll
                for (int dx = 0; dx < 3; ++dx) { const int xx = gx + dx - 1; if (xx < 0 || xx >= W) continue;
                    const int rr = r + (dy - 1) * 64 + (dx - 1);
                    const bf16_t* zn = Z + (size_t)rr * NZ + ZC_GQKV + lane * 4; const float* wp = cw + (dy * 3 + dx) * 768 + lane * 4;
#pragma unroll
                    for (int g = 0; g < 3; ++g) { const u32x2 w = *(const u32x2*)(zn + g * 256); const f32x4 k = *(const f32x4*)(wp + g * 256);
                        acc[g][0] += bflo(w.x) * k.x; acc[g][1] += bfhi(w.x) * k.y; acc[g][2] += bflo(w.y) * k.z; acc[g][3] += bfhi(w.y) * k.w; } } }
#pragma unroll
            for (int g = 0; g < 3; ++g) {
#pragma unroll
                for (int e = 0; e < 4; ++e) acc[g][e] = siluf_(acc[g][e]);
                if (g < 2) { float ss = (acc[g][0] * acc[g][0] + acc[g][1] * acc[g][1]) + (acc[g][2] * acc[g][2] + acc[g][3] * acc[g][3]);
                    ss += __shfl_xor(ss, 1); ss += __shfl_xor(ss, 2); ss += __shfl_xor(ss, 4); ss += __shfl_xor(ss, 8);
                    const float rn = rsqrtf(ss + EPS) * (g == 0 ? 0.125f : 1.0f);
#pragma unroll
                    for (int e = 0; e < 4; ++e) acc[g][e] *= rn; }
                u32x2 w; w.x = pk2(acc[g][0], acc[g][1]); w.y = pk2(acc[g][2], acc[g][3]);
                *(u32x2*)(QC + (size_t)r * 768 + g * 256 + lane * 4) = w; }
        }
    }
}

constexpr int TB = 32, NBATCH = TSEQ / TB;
constexpr int CH_ARR = TB * 64 * 4;
constexpr int CH_BUF = 4 * CH_ARR + 256;
constexpr int CH_OS = 2 * CH_BUF;
static_assert(CH_OS + 2 * CH_ARR <= LDS_BYTES, "chain LDS");

template <int KIND>
__device__ __forceinline__ void chain_matrix(const TC tc, KP P, LAS unsigned char* lds, int l, int chain) {
    const int tid = tc.tid, lane = tid & 63, wave = tid >> 6;
    const int b = chain >> 3, h = (chain >> 1) & 3, d = chain & 1;
    unsigned char* ws = P->ws;
    const bf16_t* Z = (const bf16_t*)(ws + WS_Z);
    const bf16_t* QC = (const bf16_t*)(ws + WS_HB);
    const float* AB = (const float*)(ws + WS_AB);
    bf16_t* O = (bf16_t*)(ws + (d ? WS_OB : WS_OF));
    const int ocol = KIND * 256 + h * 64;
    const bool loader = wave >= 4;
    const int lt = tid - 256, ltok = lt >> 3, lseg = lt & 7;
    float gam = 0.f;
    if (KIND == 1) gam = 1.0f / (1.0f + expf(-P->in[11][(l * 2 + d) * 4 + h]));
    auto load = [&](int n, int bi) {
        const int row = seq_row(b, d, n * TB + ltok);
        LAS float* base = (LAS float*)(lds + bi * CH_BUF) + ltok * 64 + lseg * 8;
        u32x4 q, k, v;
        if (KIND == 0) { const bf16_t* zr = Z + (size_t)row * NZ + h * 64 + lseg * 8; q = *(const u32x4*)(zr + ZC_HQ); k = *(const u32x4*)(zr + ZC_HF + d * 256); v = *(const u32x4*)(zr + ZC_HI); }
        else if (KIND == 1) { const bf16_t* zr = Z + (size_t)row * NZ + h * 64 + lseg * 8; q = *(const u32x4*)(zr + ZC_RQ); k = *(const u32x4*)(zr + ZC_RK); v = *(const u32x4*)(zr + ZC_RV); }
        else { const bf16_t* qr = QC + (size_t)row * 768 + h * 64 + lseg * 8; q = *(const u32x4*)qr; k = *(const u32x4*)(qr + 256); v = *(const u32x4*)(qr + 512);
            if (lseg == 0) { LAS float* sc = (LAS float*)(lds + bi * CH_BUF + 4 * CH_ARR); sc[ltok * 2] = expf(AB[(size_t)row * 16 + d * 4 + h]); sc[ltok * 2 + 1] = AB[(size_t)row * 16 + 8 + d * 4 + h]; } }
        const unsigned* pq = (const unsigned*)&q; const unsigned* pk = (const unsigned*)&k; const unsigned* pv = (const unsigned*)&v;
#pragma unroll
        for (int e = 0; e < 4; ++e) {
            base[2 * e] = bflo(pq[e]); base[2 * e + 1] = bfhi(pq[e]);
            base[3 * TB * 64 + 2 * e] = bflo(pv[e]); base[3 * TB * 64 + 2 * e + 1] = bfhi(pv[e]);
            if (KIND == 0) { const float l0 = bflo(pk[e]), l1 = bfhi(pk[e]); const float f0 = expf(l0), f1 = expf(l1);
                base[TB * 64 + 2 * e] = f0; base[TB * 64 + 2 * e + 1] = f1; base[2 * TB * 64 + 2 * e] = -expm1f(l0); base[2 * TB * 64 + 2 * e + 1] = -expm1f(l1); }
            else { base[TB * 64 + 2 * e] = bflo(pk[e]); base[TB * 64 + 2 * e + 1] = bfhi(pk[e]); }
        }
    };
    auto store = [&](int n, int bi) {
        const int row = seq_row(b, d, n * TB + ltok);
        const LAS float* os = (const LAS float*)(lds + CH_OS + bi * CH_ARR) + ltok * 64 + lseg * 8;
        u32x4 w; w.x = pk2(os[0], os[1]); w.y = pk2(os[2], os[3]); w.z = pk2(os[4], os[5]); w.w = pk2(os[6], os[7]);
        *(u32x4*)(O + (size_t)row * DM + ocol + lseg * 8) = w;
    };
    float S[16];
#pragma unroll
    for (int i = 0; i < 16; ++i) S[i] = 0.f;
    const int vl = lane >> 2, kg = lane & 3, vcol = (wave & 3) * 16 + vl;
    if (loader) load(0, 0);
    __syncthreads();
    for (int n = 0; n < NBATCH; ++n) {
        if (loader) { if (n + 1 < NBATCH) load(n + 1, (n + 1) & 1); if (n >= 1) store(n - 1, (n - 1) & 1); }
        else {
            const LAS float* A0 = (const LAS float*)(lds + (n & 1) * CH_BUF);
            const LAS float* sc = (const LAS float*)(lds + (n & 1) * CH_BUF + 4 * CH_ARR);
            LAS float* os = (LAS float*)(lds + CH_OS + (n & 1) * CH_ARR);
#pragma unroll 2
            for (int tt = 0; tt < TB; ++tt) {
                const LAS float* a = A0 + tt * 64 + kg * 16;
                float q[16], k[16];
#pragma unroll
                for (int i = 0; i < 4; ++i) { const f32x4 t4 = *(const LAS f32x4*)(a + 4 * i); q[4 * i] = t4.x; q[4 * i + 1] = t4.y; q[4 * i + 2] = t4.z; q[4 * i + 3] = t4.w; }
#pragma unroll
                for (int i = 0; i < 4; ++i) { const f32x4 t4 = *(const LAS f32x4*)(a + TB * 64 + 4 * i); k[4 * i] = t4.x; k[4 * i + 1] = t4.y; k[4 * i + 2] = t4.z; k[4 * i + 3] = t4.w; }
                const float vv = A0[3 * TB * 64 + tt * 64 + vcol];
                float o = 0.f;
                if (KIND == 0) {
                    float kk[16];
#pragma unroll
                    for (int i = 0; i < 4; ++i) { const f32x4 t4 = *(const LAS f32x4*)(a + 2 * TB * 64 + 4 * i); kk[4 * i] = t4.x; kk[4 * i + 1] = t4.y; kk[4 * i + 2] = t4.z; kk[4 * i + 3] = t4.w; }
#pragma unroll
                    for (int i = 0; i < 16; ++i) { S[i] = k[i] * S[i] + kk[i] * vv; o += q[i] * S[i]; }
                } else if (KIND == 1) {
#pragma unroll
                    for (int i = 0; i < 16; ++i) { S[i] = gam * S[i] + k[i] * vv; o += q[i] * S[i]; }
                } else {
                    const float alpha = sc[tt * 2], beta = sc[tt * 2 + 1];
                    float r = 0.f;
#pragma unroll
                    for (int i = 0; i < 16; ++i) r += k[i] * S[i];
                    r = quad_sum(r);
                    const float c = beta * (vv - alpha * r);
#pragma unroll
                    for (int i = 0; i < 16; ++i) { S[i] = alpha * S[i] + k[i] * c; o += q[i] * S[i]; }
                }
                o = quad_sum(o);
                if (kg == 0) os[tt * 64 + vcol] = o;
            }
        }
        __syncthreads();
    }
    if (loader) store(NBATCH - 1, (NBATCH - 1) & 1);
    __syncthreads();
}

constexpr int S5_US = 0, S5_YS = 2 * 4 * TB * 16 * 4;
__device__ __forceinline__ void chain_s5(const TC tc, KP P, LAS unsigned char* lds, int l, int item) {
    const int tid = tc.tid, lane = tid & 63, wave = tid >> 6;
    const int b = item >> 3, d = (item >> 2) & 1, gq = item & 3;
    unsigned char* ws = P->ws;
    const bf16_t* Z = (const bf16_t*)(ws + WS_Z);
    bf16_t* O = (bf16_t*)(ws + (d ? WS_OB : WS_OF));
    const bool loader = wave >= 4;
    const int lt = tid - 256, lch = lt >> 6, ltok = (lt >> 1) & 31, lhalf = lt & 1;
    auto load = [&](int n, int bi) {
        const int row = seq_row(b, d, n * TB + ltok);
        const u32x4 u = *(const u32x4*)(Z + (size_t)row * NZ + ZC_SU + gq * 64 + lch * 16 + lhalf * 8);
        LAS float* us = (LAS float*)(lds + S5_US) + ((bi * 4 + lch) * TB + ltok) * 16 + lhalf * 8; const unsigned* pu = (const unsigned*)&u;
#pragma unroll
        for (int e = 0; e < 4; ++e) { us[2 * e] = bflo(pu[e]); us[2 * e + 1] = bfhi(pu[e]); }
    };
    auto store = [&](int n, int bi) {
        const int row = seq_row(b, d, n * TB + ltok);
        const LAS float* ys = (const LAS float*)(lds + S5_YS) + ((bi * 4 + lch) * TB + ltok) * 16 + lhalf * 8;
        u32x4 w; w.x = pk2(ys[0], ys[1]); w.y = pk2(ys[2], ys[3]); w.z = pk2(ys[4], ys[5]); w.w = pk2(ys[6], ys[7]);
        *(u32x4*)(O + (size_t)row * DM + 768 + gq * 64 + lch * 16 + lhalf * 8) = w;
    };
    float bre[16], bim[16], cre[16], cim[16], ar = 0.f, ai = 0.f, hr = 0.f, hi = 0.f;
    if (!loader) {
        const int g = gq * 4 + wave;
        const float* sp = (const float*)(ws + WS_S5P) + ((size_t)((l * 2 + d) * 16 + g) * 64 + lane) * 34;
        ar = sp[0]; ai = sp[1];
#pragma unroll
        for (int c = 0; c < 16; ++c) { bre[c] = sp[2 + c]; bim[c] = sp[18 + c];
            cre[c] = P->in[21][((size_t)(l * 16 + g) * 16 + c) * 64 + lane]; cim[c] = P->in[22][((size_t)(l * 16 + g) * 16 + c) * 64 + lane]; }
    }
    if (loader) load(0, 0);
    __syncthreads();
    for (int n = 0; n < NBATCH; ++n) {
        if (loader) { if (n + 1 < NBATCH) load(n + 1, (n + 1) & 1); if (n >= 1) store(n - 1, (n - 1) & 1); }
        else {
            const LAS float* us = (const LAS float*)(lds + S5_US) + (((n & 1) * 4 + wave) * TB) * 16;
            LAS float* ys = (LAS float*)(lds + S5_YS) + (((n & 1) * 4 + wave) * TB) * 16;
            for (int tt = 0; tt < TB; ++tt) {
                float u[16];
#pragma unroll
                for (int i = 0; i < 4; ++i) { const f32x4 t4 = *(const LAS f32x4*)(us + tt * 16 + 4 * i); u[4 * i] = t4.x; u[4 * i + 1] = t4.y; u[4 * i + 2] = t4.z; u[4 * i + 3] = t4.w; }
                float xr = 0.f, xi = 0.f;
#pragma unroll
                for (int c = 0; c < 16; ++c) { xr += bre[c] * u[c]; xi += bim[c] * u[c]; }
                const float nhr = ar * hr - ai * hi + xr, nhi = ar * hi + ai * hr + xi; hr = nhr; hi = nhi;
                float p[16];
#pragma unroll
                for (int c = 0; c < 16; ++c) p[c] = cre[c] * hr - cim[c] * hi;
                const float tot = reduce16(p, lane);
                if ((lane & 3) == 0) { const int c = 8 * ((lane >> 5) & 1) + 4 * ((lane >> 4) & 1) + 2 * ((lane >> 3) & 1) + ((lane >> 2) & 1); ys[tt * 16 + c] = tot; }
            }
        }
        __syncthreads();
    }
    if (loader) store(NBATCH - 1, (NBATCH - 1) & 1);
    __syncthreads();
}

__device__ __forceinline__ void phase_mixscan(const TC tc, KP P, LAS unsigned char* lds, int l) {
    for (int item = tc.bid; item < 256; item += tc.G) {
        const int kind = item >> 6, c = item & 63;
        if (kind == 0) chain_matrix<0>(tc, P, lds, l, c);
        else if (kind == 1) chain_matrix<1>(tc, P, lds, l, c);
        else if (kind == 2) chain_matrix<2>(tc, P, lds, l, c);
        else chain_s5(tc, P, lds, l, c);
    }
}

__device__ __forceinline__ void phase_combine(const TC tc, KP P, int l, int r0) {
    const int tid = tc.tid, lane = tid & 63, wave = tid >> 6;
    const int gw = tc.bid * 8 + wave, NGW = tc.G * 8;
    unsigned char* ws = P->ws;
    const bf16_t* Z = (const bf16_t*)(ws + WS_Z);
    const bf16_t* OF = (const bf16_t*)(ws + WS_OF); const bf16_t* OB = (const bf16_t*)(ws + WS_OB);
    bf16_t* CAT = (bf16_t*)(ws + WS_HB);
    const float* ghg = P->in[10] + l * 64; const float* ggd = P->in[15] + l * 64; const float* dsk = P->in[23] + l * DG;
    const int hc = (lane & 15) * 4;
    const f32x4 g_h = *(const f32x4*)(ghg + hc), g_g = *(const f32x4*)(ggd + hc);
    const f32x4 dv = *(const f32x4*)(dsk + lane * 4);
    for (int r = r0 + gw; r < MALL; r += NGW) {
        const bf16_t* zr = Z + (size_t)r * NZ;
#pragma unroll
        for (int mx = 0; mx < 3; ++mx) {
            const u32x2 a = *(const u32x2*)(OF + (size_t)r * DM + mx * 256 + lane * 4), bb = *(const u32x2*)(OB + (size_t)r * DM + mx * 256 + lane * 4);
            f32x4 o = (f32x4){bflo(a.x) + bflo(bb.x), bfhi(a.x) + bfhi(bb.x), bflo(a.y) + bflo(bb.y), bfhi(a.y) + bfhi(bb.y)};
            float ss = (o.x * o.x + o.y * o.y) + (o.z * o.z + o.w * o.w);
            ss += __shfl_xor(ss, 1); ss += __shfl_xor(ss, 2); ss += __shfl_xor(ss, 4); ss += __shfl_xor(ss, 8);
            const float rn = rsqrtf(ss * (1.0f / 64.0f) + EPS);
            o = o * rn; if (mx == 0) o = o * g_h; if (mx == 2) o = o * g_g;
            const u32x2 gt = *(const u32x2*)(zr + (mx == 0 ? ZC_HG : mx == 1 ? ZC_RG : ZC_GG) + lane * 4);
            u32x2 w; w.x = pk2(o.x * siluf_(bflo(gt.x)), o.y * siluf_(bfhi(gt.x))); w.y = pk2(o.z * siluf_(bflo(gt.y)), o.w * siluf_(bfhi(gt.y)));
            *(u32x2*)(CAT + (size_t)r * DM + mx * 256 + lane * 4) = w;
        }
        { const u32x2 a = *(const u32x2*)(OF + (size_t)r * DM + 768 + lane * 4), bb = *(const u32x2*)(OB + (size_t)r * DM + 768 + lane * 4);
          const u32x2 uu = *(const u32x2*)(zr + ZC_SU + lane * 4);
          const float y0 = bflo(a.x) + bflo(bb.x) + bflo(uu.x) * dv.x, y1 = bfhi(a.x) + bfhi(bb.x) + bfhi(uu.x) * dv.y, y2 = bflo(a.y) + bflo(bb.y) + bflo(uu.y) * dv.z, y3 = bfhi(a.y) + bfhi(bb.y) + bfhi(uu.y) * dv.w;
          u32x2 w; w.x = pk2(gelu_tanh(y0), gelu_tanh(y1)); w.y = pk2(gelu_tanh(y2), gelu_tanh(y3));
          *(u32x2*)(CAT + (size_t)r * DM + 768 + lane * 4) = w; }
    }
}

__device__ __forceinline__ void phase_glu(const TC tc, KP P, LAS unsigned char* lds, int l, int r0) {
    const int tid = tc.tid, lane = tid & 63, wave = tid >> 6;
    const int gw = tc.bid * 8 + wave, NGW = tc.G * 8;
    const int ntile = (MALL - r0) / 16;
    if (tc.bid * 8 >= ntile) return;
    unsigned char* ws = P->ws;
    const bf16_t* wg = (const bf16_t*)(ws + WS_W + (size_t)l * SZ_WL + SZ_WIN + SZ_WOUT + SZ_W1 + SZ_W2);
    for (int i = tid; i < 256 * 32; i += 512) { const int n = i >> 5, c = i & 31; *(LAS u32x4*)(lds + n * 528 + c * 16) = *(const u32x4*)(wg + n * 256 + c * 8); }
    __syncthreads();
    bf16_t* CAT = (bf16_t*)(ws + WS_HB);
    const float* bias = P->in[25] + l * DG;
    const int fr = lane & 15, fq = lane >> 4;
    for (int t = gw; t < ntile; t += NGW) {
        bf16_t* rowp = CAT + (size_t)(r0 + t * 16 + fr) * DM + 768;
        bf16x8 af[8];
#pragma unroll
        for (int ks = 0; ks < 8; ++ks) af[ks] = *(const bf16x8*)(rowp + ks * 32 + fq * 8);
        f32x4 acc[16];
#pragma unroll
        for (int nt = 0; nt < 16; ++nt) acc[nt] = (f32x4){0.f, 0.f, 0.f, 0.f};
#pragma unroll
        for (int ks = 0; ks < 8; ++ks)
#pragma unroll
            for (int nt = 0; nt < 16; ++nt) { const bf16x8 wf = *(const LAS bf16x8*)(lds + (nt * 16 + fr) * 528 + (ks * 32 + fq * 8) * 2);
                acc[nt] = __builtin_amdgcn_mfma_f32_16x16x32_bf16(wf, af[ks], acc[nt], 0, 0, 0); if ((nt & 7) == 7) asm volatile("" ::: "memory"); }
#pragma unroll
        for (int nt = 0; nt < 16; ++nt) { const int c = nt * 16 + 4 * fq; asm volatile("" ::: "memory"); const f32x4 bv = *(const f32x4*)(bias + c); const u32x2 y = *(const u32x2*)(rowp + c);
            u32x2 w; w.x = pk2(bflo(y.x) * sigmoidf_(acc[nt][0] + bv[0]), bfhi(y.x) * sigmoidf_(acc[nt][1] + bv[1])); w.y = pk2(bflo(y.y) * sigmoidf_(acc[nt][2] + bv[2]), bfhi(y.y) * sigmoidf_(acc[nt][3] + bv[3]));
            *(u32x2*)(rowp + c) = w; }
    }
}

__device__ __forceinline__ void phase_final(const TC tc, KP P) {
    const int tid = tc.tid, lane = tid & 63, wave = tid >> 6;
    const int gw = tc.bid * 8 + wave, NGW = tc.G * 8;
    const float* g = P->in[29];
    for (int r = gw; r < MLAT; r += NGW) {
        float* xr = P->out + (size_t)r * DM;
        f32x4 x[4]; float ss = 0.f;
#pragma unroll
        for (int j = 0; j < 4; ++j) { x[j] = ((const f32x4*)xr)[j * 64 + lane]; ss += (x[j].x * x[j].x + x[j].y * x[j].y) + (x[j].z * x[j].z + x[j].w * x[j].w); }
        const float rstd = rsqrtf(wave_sum(ss) * (1.0f / DM) + EPS);
#pragma unroll
        for (int j = 0; j < 4; ++j) ((f32x4*)xr)[j * 64 + lane] = x[j] * rstd * ((const f32x4*)g)[j * 64 + lane];
    }
}

__global__ void __launch_bounds__(512, 2) mega(Params Pk) {
    extern __shared__ __attribute__((aligned(16))) unsigned char lds_raw[];
    LAS unsigned char* lds = (LAS unsigned char*)lds_raw;
    cg::grid_group grid = cg::this_grid();
    for (int ph = Pk.ph_lo; ph < Pk.ph_hi; ++ph) {
        KP P = (KP)__builtin_amdgcn_kernarg_segment_ptr();
        asm volatile("" : "+s"(P));
        TC tc; tc.tid = threadIdx.x; tc.bid = blockIdx.x; tc.G = gridDim.x;
        asm volatile("" : "+v"(tc.tid)); asm volatile("" : "+s"(tc.bid)); asm volatile("" : "+s"(tc.G));
        unsigned char* ws = P->ws;
#ifndef PHMASK
#define PHMASK 0xFFFF
#endif
        if (ph == 0) { if (PHMASK & 1) phase_prologue(tc, P, lds); }
        else if (ph == NPHASE - 1) { if (PHMASK & 2) phase_final(tc, P); }
        else {
            const int l = (ph - 1) / 10, sp = (ph - 1) % 10;
            const int pm_off = (l == DEPTH - 1) ? 8 : 0, r0 = pm_off * 256, Mrows = MALL - r0;
#define WL(off) ((const bf16_t*)(ws + WS_W + (size_t)l * SZ_WL + (off)))
#define HB_ ((bf16_t*)(ws + WS_HB))
#define XC_ ((float*)(ws + WS_XC))
#define MODL ((const float*)(ws + WS_MOD) + (size_t)l * 9 * 6144)
            switch (sp) {
            case 0: if (PHMASK & (1 << 2)) phase_norm(tc, P, lds, l, 0, (l == 0) ? P->in[0] : (const float*)P->out, (l == 0) ? P->in[2] : (const float*)XC_, 0, true); break;
            case 1: if (PHMASK & (1 << 3)) { pg8::Gemm g{HB_, WL(0), MALL, NZ, DM, DM}; pg8::StaticOrder S; S.init(MALL, NZ, tc.G, tc.bid); pg8::EpiBf<0> E{(bf16_t*)(ws + WS_Z), NZ}; pg8::gemm_phase(tc, lds, g, S, E); } break;
            case 2: if (PHMASK & (1 << 4)) phase_mixpre(tc, P, l); break;
            case 3: if (PHMASK & (1 << 5)) phase_mixscan(tc, P, lds, l); break;
            case 4: if (PHMASK & (1 << 6)) phase_combine(tc, P, l, r0); break;
            case 5: if (PHMASK & (1 << 7)) phase_glu(tc, P, lds, l, r0); break;
            case 6: if (PHMASK & (1 << 8)) { pg8::Gemm g{HB_ + (size_t)r0 * DM, WL(SZ_WIN), Mrows, DM, DM, DM}; pg8::StaticOrder S; S.init(Mrows, DM, tc.G, tc.bid);
                      pg8::EpiRes E{(l == 0) ? P->in[0] : (const float*)P->out, (l == 0) ? P->in[2] : (const float*)XC_, P->out, XC_, MODL + 2 * DM, pm_off}; pg8::gemm_phase(tc, lds, g, S, E); } break;
            case 7: if (PHMASK & (1 << 9)) phase_norm(tc, P, lds, l, 1, P->out, XC_, r0, false); break;
            case 8: if (PHMASK & (1 << 10)) { pg8::Gemm g{HB_ + (size_t)r0 * DM, WL(SZ_WIN + SZ_WOUT), Mrows, DFF, DM, DM}; pg8::StaticOrder S; S.init(Mrows, DFF, tc.G, tc.bid); pg8::EpiBf<1> E{(bf16_t*)(ws + WS_U) + (size_t)r0 * DFF, DFF}; pg8::gemm_phase(tc, lds, g, S, E); } break;
            case 9: if (PHMASK & (1 << 11)) { pg8::Gemm g{(const bf16_t*)(ws + WS_U) + (size_t)r0 * DFF, WL(SZ_WIN + SZ_WOUT + SZ_W1), Mrows, DM, DFF, DFF}; pg8::StaticOrder S; S.init(Mrows, DM, tc.G, tc.bid);
                      pg8::EpiRes E{P->out, XC_, P->out, XC_, MODL + 5 * DM, pm_off}; pg8::gemm_phase(tc, lds, g, S, E); } break;
            }
        }
        if (ph + 1 < Pk.ph_hi) grid.sync();
    }
}

extern "C" void kernel_launch(void* const* d_in, const int* in_sizes, int n_in, void* d_out, int out_size, void* d_ws, size_t ws_size, hipStream_t stream) {
    static int grid = 0;
    if (grid == 0) {
        if (n_in != 30 || in_sizes[0] != MLAT * DM || out_size != MLAT * DM || ws_size < WS_END) {
            fprintf(stderr, "kernel_launch: unexpected shapes: n_in %d in0 %d out %d ws %zu (need %zu)\n", n_in, n_in > 0 ? in_sizes[0] : -1, out_size, ws_size, (size_t)WS_END); grid = -1; return; }
        int dev = 0, cus = 0, per_cu = 0;
        hipGetDevice(&dev); hipDeviceGetAttribute(&cus, hipDeviceAttributeMultiprocessorCount, dev);
        if (hipFuncSetAttribute((const void*)mega, hipFuncAttributeMaxDynamicSharedMemorySize, LDS_BYTES) != hipSuccess) { fprintf(stderr, "kernel_launch: hipFuncSetAttribute failed\n"); grid = -1; return; }
        if (hipOccupancyMaxActiveBlocksPerMultiprocessor(&per_cu, (const void*)mega, 512, LDS_BYTES) != hipSuccess || per_cu < 1) { fprintf(stderr, "kernel_launch: occupancy query failed (%d)\n", per_cu); (void)hipGetLastError(); per_cu = 1; }
        grid = cus * 1;
        if (per_cu < 1) grid = -1;
    }
    if (grid < 0) return;
    Params p{};
    for (int i = 0; i < 30; ++i) p.in[i] = (const float*)d_in[i];
    p.out = (float*)d_out; p.ws = (unsigned char*)d_ws;
#if MK_MULTI
    for (int ph = 0; ph < NPHASE; ++ph) { p.ph_lo = ph; p.ph_hi = ph + 1; hipLaunchKernelGGL(mega, dim3(grid), dim3(512), LDS_BYTES, stream, p); }
#else
    p.ph_lo = 0; p.ph_hi = NPHASE;
    void* args[] = {&p};
    hipError_t e = hipLaunchCooperativeKernel((const void*)mega, dim3(grid), dim3(512), args, LDS_BYTES, stream);
    if (e != hipSuccess) fprintf(stderr, "cooperative launch failed: %s (grid %d)\n", hipGetErrorString(e), grid);
#endif
}
```

```cpp
#include <hip/hip_runtime.h>
#include <hip/hip_cooperative_groups.h>
#include <cstdio>
#include <cstdint>
namespace cg = cooperative_groups;

#ifndef MK_MULTI
#define MK_MULTI 0
#endif

#define LAS __attribute__((address_space(3)))
typedef unsigned short bf16_t;
typedef short bf16x8 __attribute__((ext_vector_type(8)));
typedef float f32x4 __attribute__((ext_vector_type(4)));
typedef float f32x2 __attribute__((ext_vector_type(2)));
typedef unsigned u32x4 __attribute__((ext_vector_type(4)));
typedef unsigned u32x2 __attribute__((ext_vector_type(2)));

constexpr int NB = 8, TLAT = 4096, TCTX = 256, DM = 1024, DEPTH = 2, DG = 256, DIN = 3600, NZ = 3584, DFF = 4096;
constexpr int MCTX = NB * TCTX, MLAT = NB * TLAT, MALL = MCTX + MLAT;
constexpr int TSEQ = TCTX + TLAT;
constexpr float EPS = 1e-6f;
constexpr int ZC_HQ = 0, ZC_HI = 256, ZC_HG = 512, ZC_HF = 768, ZC_RQ = 1280, ZC_RK = 1536, ZC_RV = 1792, ZC_RG = 2048, ZC_GQKV = 2304, ZC_GG = 3072, ZC_SU = 3328;

constexpr size_t SZ_WIN = (size_t)NZ * DM * 2, SZ_WOUT = (size_t)DM * DM * 2, SZ_W1 = (size_t)DFF * DM * 2, SZ_W2 = (size_t)DM * DFF * 2, SZ_GLU = (size_t)DG * DG * 2, SZ_WAB = 16 * DM * 4;
constexpr size_t SZ_WL = SZ_WIN + SZ_WOUT + SZ_W1 + SZ_W2 + SZ_GLU + SZ_WAB;
constexpr size_t WS_W = 0;
constexpr size_t WS_MOD = WS_W + 2 * SZ_WL;
constexpr size_t WS_ROPE = WS_MOD + (size_t)2 * 9 * 6144 * 4;
constexpr size_t WS_LB = WS_ROPE + (size_t)TSEQ * 32 * 2 * 4;
constexpr size_t WS_S5P = WS_LB + 4096;
constexpr size_t WS_XC = WS_S5P + (size_t)2 * 2 * 16 * 64 * 34 * 4;
constexpr size_t WS_AB = WS_XC + (size_t)MCTX * DM * 4;
constexpr size_t WS_HB = WS_AB + (size_t)MALL * 16 * 4;
constexpr size_t WS_Z = WS_HB + (size_t)MALL * DM * 2;
constexpr size_t WS_OF = WS_Z + (size_t)MALL * NZ * 2;
constexpr size_t WS_OB = WS_OF + (size_t)MALL * DM * 2;
constexpr size_t WS_END = WS_OB + (size_t)MALL * DM * 2;
constexpr size_t WS_CTL = WS_END;
constexpr size_t CTL_BYTES = 16384;
constexpr size_t WS_TOTAL = WS_CTL + CTL_BYTES;
constexpr size_t WS_U = WS_Z;
static_assert(WS_U + (size_t)MALL * DFF * 2 <= WS_END, "U overlay");
static_assert(WS_MOD % 256 == 0 && WS_ROPE % 256 == 0 && WS_S5P % 256 == 0 && WS_XC % 256 == 0 && WS_AB % 256 == 0 && WS_HB % 256 == 0 && WS_Z % 256 == 0 && WS_OF % 256 == 0, "align");

constexpr int LDS_BYTES = 147456;
constexpr int NPHASE = 22;

struct Params {
    const float* in[30];
    float* out;
    unsigned char* ws;
    int ph_lo, ph_hi;
};
typedef const __attribute__((address_space(4))) Params* KP;
struct TC { int tid, bid, G; };

__device__ __forceinline__ unsigned f2bf(float f) { unsigned u = __builtin_bit_cast(unsigned, f); return (u + 0x7fffu + ((u >> 16) & 1u)) >> 16; }
__device__ __forceinline__ unsigned pk2(float lo, float hi) { return f2bf(lo) | (f2bf(hi) << 16); }
__device__ __forceinline__ float bflo(unsigned w) { return __builtin_bit_cast(float, w << 16); }
__device__ __forceinline__ float bfhi(unsigned w) { return __builtin_bit_cast(float, w & 0xffff0000u); }
__device__ __forceinline__ float wave_sum(float v) {
#pragma unroll
    for (int o = 1; o < 64; o <<= 1) v += __shfl_xor(v, o);
    return v;
}
__device__ __forceinline__ float quad_sum(float x) {
    x += __builtin_bit_cast(float, __builtin_amdgcn_mov_dpp(__builtin_bit_cast(int, x), 0xB1, 0xf, 0xf, true));
    x += __builtin_bit_cast(float, __builtin_amdgcn_mov_dpp(__builtin_bit_cast(int, x), 0x4E, 0xf, 0xf, true));
    return x;
}
__device__ __forceinline__ float sigmoidf_(float x) { return __builtin_amdgcn_rcpf(1.0f + __builtin_amdgcn_exp2f(-1.4426950408889634f * x)); }
__device__ __forceinline__ float siluf_(float x) { return x / (1.0f + __expf(-x)); }
__device__ __forceinline__ float gelu_tanh(float x) { const float u = 0.7978845608028654f * (x + 0.044715f * x * x * x); return 0.5f * x * (1.0f + tanhf(u)); }
__device__ __forceinline__ float reduce16(float (&p)[16], int lane) {
    bool b = (lane & 32) != 0;
#pragma unroll
    for (int i = 0; i < 8; ++i) { const float keep = b ? p[i + 8] : p[i], send = b ? p[i] : p[i + 8]; p[i] = keep + __shfl_xor(send, 32); }
    b = (lane & 16) != 0;
#pragma unroll
    for (int i = 0; i < 4; ++i) { const float keep = b ? p[i + 4] : p[i], send = b ? p[i] : p[i + 4]; p[i] = keep + __shfl_xor(send, 16); }
    b = (lane & 8) != 0;
#pragma unroll
    for (int i = 0; i < 2; ++i) { const float keep = b ? p[i + 2] : p[i], send = b ? p[i] : p[i + 2]; p[i] = keep + __shfl_xor(send, 8); }
    b = (lane & 4) != 0;
    { const float keep = b ? p[1] : p[0], send = b ? p[0] : p[1]; p[0] = keep + __shfl_xor(send, 4); }
    p[0] += __shfl_xor(p[0], 2); p[0] += __shfl_xor(p[0], 1);
    return p[0];
}
__device__ __forceinline__ int seq_row(int b, int d, int j) {
    if (j < TCTX) return b * TCTX + (d ? (TCTX - 1 - j) : j);
    const int t = j - TCTX; return MCTX + b * TLAT + (d ? (TLAT - 1 - t) : t);
}

namespace pg8 {
constexpr int BM = 256, BK = 64, HALF = 128, HTB = HALF * BK * 2, STAGE_BYTES = 8 * HTB, NXCD = 8, WGM = 8;
__host__ __device__ __forceinline__ int lds_byte(int r, int c) { const int st = (r >> 4) * 2 + (c >> 5), rr = r & 15, cc = c & 31, ob = rr * 64 + cc * 2; return st * 1024 + (ob ^ (((ob >> 9) & 1) << 5)); }
__host__ __device__ __forceinline__ void stage_rc(int b, int& R, int& C) { const int st = b / 1024, sb = b % 1024, swz = sb ^ (((sb >> 9) & 1) << 5); R = (st >> 1) * 16 + swz / 64; C = (st & 1) * 32 + (swz % 64) / 2; }
__host__ __device__ __forceinline__ int perm32(int rho) { const int n = rho >> 4, i = rho & 15; return 8 * (i >> 2) + 4 * n + (i & 3); }
struct Unit { int pm, pn; };
struct Gemm { const bf16_t* A; const bf16_t* Bt; int M, N, K, lda; };
struct StaticOrder {
    int nM, nN, nwg, G, c;
    __device__ void init(int M, int N, int G_, int c_) { nM = M / BM; nN = N / BM; nwg = nM * nN; G = G_; c = c_; }
    __device__ bool next(int i, Unit& u) const {
        const long L = (long)i * G + c; if (L >= nwg) return false;
        int wgid = (int)L; { const int q = nwg / NXCD, r = nwg % NXCD, xcd = wgid % NXCD, off = wgid / NXCD; wgid = (xcd < r ? xcd * (q + 1) : r * (q + 1) + (xcd - r) * q) + off; }
        const int nig = WGM * nN, gid = wgid / nig, fm = gid * WGM, gsz = (nM - fm) < WGM ? (nM - fm) : WGM;
        u.pm = fm + ((wgid % nig) % gsz); u.pn = (wgid % nig) / gsz; return true;
    }
};
template <class Epi>
__device__ __forceinline__ void gemm_phase(const TC tc, LAS unsigned char* lds, const Gemm g, const StaticOrder& S, const Epi& E) {
    const int tid = tc.tid, wid = __builtin_amdgcn_readfirstlane(tid >> 6), lane = tid & 63, wr = wid >> 2, wc = wid & 3, fr = lane & 15, fq = lane >> 4;
    const int K = g.K, nt = K / BK, lda = g.lda;
    unsigned voffA[2], voffB[2];
#pragma unroll
    for (int i = 0; i < 2; ++i) { int R, C; stage_rc(tid * 16 + i * 8192, R, C); const int Rb = Epi::PERM ? ((R & ~31) + perm32(R & 31)) : R;
        voffA[i] = (unsigned)(R * lda + C) * 2u; voffB[i] = (unsigned)(Rb * K + C) * 2u; }
    const size_t kstep = (size_t)(BK * 2);
    const size_t hstepA = (size_t)HALF * lda * 2, hstepB = (size_t)HALF * K * 2;
    const size_t tstepA = 2 * hstepA, tstepB = 2 * hstepB;
    const unsigned ldsw = (unsigned)wid * 1024u;
    const int aoff = lds_byte(wr * 64 + fr, fq * 8), boff = lds_byte(wc * 32 + fr, fq * 8);
#define PG8_SA(b, h) (((b) * 2 + (h)) * HTB)
#define PG8_SB(b, h) ((4 + (b) * 2 + (h)) * HTB)
#define PG8_STAGE(bufoff, gbase, voff) do { _Pragma("unroll") for (int _i = 0; _i < 2; ++_i) \
        __builtin_amdgcn_global_load_lds((const unsigned*)((const char*)(gbase) + (voff)[_i]), (LAS unsigned*)(lds + (bufoff) + ldsw + _i * 8192), 16, 0, 0); } while (0)
#define PG8_LDA(dst, b, h) do { _Pragma("unroll") for (int m = 0; m < 4; ++m) _Pragma("unroll") for (int k = 0; k < 2; ++k) dst[m][k] = *(const LAS bf16x8*)(lds + PG8_SA(b, h) + aoff + m * 2048 + k * 1024); } while (0)
#define PG8_LDB(dst, b, h) do { _Pragma("unroll") for (int n = 0; n < 2; ++n) _Pragma("unroll") for (int k = 0; k < 2; ++k) dst[n][k] = *(const LAS bf16x8*)(lds + PG8_SB(b, h) + boff + n * 2048 + k * 1024); } while (0)
#define PG8_MMA(ai, bj, At, Bt) do { __builtin_amdgcn_s_setprio(1); _Pragma("unroll") for (int m = 0; m < 4; ++m) _Pragma("unroll") for (int n = 0; n < 2; ++n) _Pragma("unroll") for (int k = 0; k < 2; ++k) \
        acc[ai][bj][m][n] = __builtin_amdgcn_mfma_f32_16x16x32_bf16(Bt[n][k], At[m][k], acc[ai][bj][m][n], 0, 0, 0); __builtin_amdgcn_s_setprio(0); } while (0)
#define PG8_WAIT_V(n) asm volatile("s_waitcnt vmcnt(" #n ")" ::: "memory")
#define PG8_WAIT_L(n) asm volatile("s_waitcnt lgkmcnt(" #n ")" ::: "memory")
#define PG8_BAR __builtin_amdgcn_s_barrier()
#define PG8_SCHED __builtin_amdgcn_sched_barrier(0)
    Unit cur, nxt; int ui = 0;
    if (!S.next(0, cur)) return;
    f32x4 acc[2][2][4][2];
#pragma unroll
    for (int a = 0; a < 2; ++a)
#pragma unroll
        for (int b = 0; b < 2; ++b)
#pragma unroll
            for (int m = 0; m < 4; ++m)
#pragma unroll
                for (int n = 0; n < 2; ++n) acc[a][b][m][n] = (f32x4){0.f, 0.f, 0.f, 0.f};
    bf16x8 At[4][2], B0[2][2], B1[2][2];
    const char* cA = (const char*)g.A + (size_t)cur.pm * tstepA; const char* cB = (const char*)g.Bt + (size_t)cur.pn * tstepB;
    PG8_STAGE(PG8_SB(0, 0), cB, voffB); PG8_STAGE(PG8_SB(0, 1), cB + hstepB, voffB); PG8_STAGE(PG8_SA(0, 0), cA, voffA); PG8_STAGE(PG8_SA(0, 1), cA + hstepA, voffA);
    if (wr == 1) PG8_BAR;
    PG8_WAIT_V(2); PG8_BAR;
    PG8_STAGE(PG8_SB(1, 0), cB + kstep, voffB); PG8_STAGE(PG8_SA(1, 0), cA + kstep, voffA); PG8_STAGE(PG8_SB(1, 1), cB + hstepB + kstep, voffB);
    PG8_WAIT_V(6); PG8_BAR;
    for (;;) {
        const bool has_next = S.next(ui + 1, nxt);
        const char* nA = has_next ? (const char*)g.A + (size_t)nxt.pm * tstepA : cA; const char* nB = has_next ? (const char*)g.Bt + (size_t)nxt.pn * tstepB : cB;
        for (int t = 0; t < nt; t += 2) {
            const bool last = (t == nt - 2);
            const char* a1 = cA + (size_t)(t + 1) * kstep;
            const char* a2 = last ? nA : cA + (size_t)(t + 2) * kstep; const char* b2 = last ? nB : cB + (size_t)(t + 2) * kstep;
            const char* a3 = a2 + kstep; const char* b3 = b2 + kstep;
            PG8_LDB(B0, 0, 0); PG8_LDB(B1, 0, 1); PG8_SCHED; PG8_LDA(At, 0, 0); PG8_STAGE(PG8_SA(1, 1), a1 + hstepA, voffA);
            PG8_WAIT_V(8); PG8_WAIT_L(0); PG8_BAR; PG8_MMA(0, 0, At, B0); PG8_MMA(0, 1, At, B1); PG8_BAR; PG8_SCHED;
            PG8_LDA(At, 0, 1); PG8_STAGE(PG8_SB(0, 0), b2, voffB); PG8_STAGE(PG8_SB(0, 1), b2 + hstepB, voffB); PG8_STAGE(PG8_SA(0, 0), a2, voffA);
            PG8_WAIT_V(8); PG8_WAIT_L(0); PG8_BAR; PG8_MMA(1, 0, At, B0); PG8_MMA(1, 1, At, B1); PG8_BAR; PG8_SCHED;
            PG8_LDB(B0, 1, 0); PG8_LDB(B1, 1, 1); PG8_SCHED; PG8_LDA(At, 1, 0); PG8_STAGE(PG8_SA(0, 1), a2 + hstepA, voffA);
            PG8_WAIT_V(8); PG8_WAIT_L(0); PG8_BAR; PG8_MMA(0, 0, At, B0); PG8_MMA(0, 1, At, B1); PG8_BAR; PG8_SCHED;
            PG8_LDA(At, 1, 1); PG8_STAGE(PG8_SB(1, 0), b3, voffB); PG8_STAGE(PG8_SB(1, 1), b3 + hstepB, voffB); PG8_STAGE(PG8_SA(1, 0), a3, voffA);
            PG8_WAIT_V(8); PG8_WAIT_L(0); PG8_BAR; PG8_MMA(1, 0, At, B0); PG8_MMA(1, 1, At, B1); PG8_BAR; PG8_SCHED;
        }
        if (wr == 0) PG8_BAR;
        E(acc, cur, wr, wc, fr, fq);
        if (!has_next) break;
#pragma unroll
        for (int a = 0; a < 2; ++a)
#pragma unroll
            for (int b = 0; b < 2; ++b)
#pragma unroll
                for (int m = 0; m < 4; ++m)
#pragma unroll
                    for (int n = 0; n < 2; ++n) acc[a][b][m][n] = (f32x4){0.f, 0.f, 0.f, 0.f};
        cur = nxt; cA = nA; cB = nB; ++ui;
        if (wr == 1) PG8_BAR;
    }
    PG8_WAIT_V(0);
    PG8_BAR;
#undef PG8_SA
#undef PG8_SB
#undef PG8_STAGE
#undef PG8_LDA
#undef PG8_LDB
#undef PG8_MMA
#undef PG8_WAIT_V
#undef PG8_WAIT_L
#undef PG8_BAR
#undef PG8_SCHED
}

template <int ACT> struct EpiBf {
    static constexpr bool PERM = true;
    bf16_t* O; int ldc;
    __device__ __forceinline__ void operator()(const f32x4 (&acc)[2][2][4][2], const Unit& u, int wr, int wc, int fr, int fq) const {
        const int row0 = u.pm * BM + wr * 64 + fr, col0 = u.pn * BM + wc * 32 + 8 * fq;
#pragma unroll
        for (int ai = 0; ai < 2; ++ai)
#pragma unroll
            for (int m = 0; m < 4; ++m) { bf16_t* rowp = O + (size_t)(row0 + ai * HALF + m * 16) * ldc + col0;
#pragma unroll
                for (int bj = 0; bj < 2; ++bj) { f32x4 v0 = acc[ai][bj][m][0], v1 = acc[ai][bj][m][1];
                    if (ACT == 1) {
#pragma unroll
                        for (int e = 0; e < 4; ++e) { const float a = fmaxf(v0[e], 0.f), b = fmaxf(v1[e], 0.f); v0[e] = a * a; v1[e] = b * b; } }
                    u32x4 w; w.x = pk2(v0[0], v0[1]); w.y = pk2(v0[2], v0[3]); w.z = pk2(v1[0], v1[1]); w.w = pk2(v1[2], v1[3]);
                    *(u32x4*)(rowp + bj * HALF) = w; } }
    }
};
struct EpiRes {
    static constexpr bool PERM = false;
    const float* in_lat; const float* in_ctx; float* out_lat; float* out_ctx; const float* gate; int pm_off;
    __device__ __forceinline__ void operator()(const f32x4 (&acc)[2][2][4][2], const Unit& u, int wr, int wc, int fr, int fq) const {
        const int gpm = u.pm + pm_off;
        const float* rin; float* rout; int v;
        if (gpm < 8) { rin = in_ctx + (size_t)gpm * 256 * DM; rout = out_ctx + (size_t)gpm * 256 * DM; v = 8; }
        else { rin = in_lat + (size_t)(gpm - 8) * 256 * DM; rout = out_lat + (size_t)(gpm - 8) * 256 * DM; v = (gpm - 8) >> 4; }
        const int col0 = u.pn * BM + wc * 32 + 4 * fq;
        const float* gp = gate + (size_t)v * 6144 + col0;
        f32x4 gv[2][2];
#pragma unroll
        for (int bj = 0; bj < 2; ++bj)
#pragma unroll
            for (int n = 0; n < 2; ++n) gv[bj][n] = *(const f32x4*)(gp + bj * HALF + n * 16);
#pragma unroll
        for (int ai = 0; ai < 2; ++ai)
#pragma unroll
            for (int m = 0; m < 4; ++m) { const size_t off = (size_t)(ai * HALF + wr * 64 + m * 16 + fr) * DM + col0;
#pragma unroll
                for (int bj = 0; bj < 2; ++bj)
#pragma unroll
                    for (int n = 0; n < 2; ++n) { const f32x4 x = *(const f32x4*)(rin + off + bj * HALF + n * 16); *(f32x4*)(rout + off + bj * HALF + n * 16) = x + gv[bj][n] * acc[ai][bj][m][n]; }
                asm volatile("" ::: "memory"); }
    }
};
}

__device__ __forceinline__ void transpose_item(const float* W, int ldw, int c0, int K, bf16_t* WT, int nblk, LAS float* scr, int item, int lane) {
    const int kb = item / nblk, nb = item % nblk, k0 = 64 * kb, n0 = 32 * nb;
#pragma unroll 8
    for (int i = 0; i < 32; ++i) { const int kk = 2 * i + (lane >> 5); scr[kk * 33 + (lane & 31)] = W[(size_t)(k0 + kk) * ldw + c0 + n0 + (lane & 31)]; }
    asm volatile("s_waitcnt lgkmcnt(0)" ::: "memory");
    const int c = lane & 7;
#pragma unroll
    for (int j = 0; j < 4; ++j) { const int n = (lane >> 3) + 8 * j; const LAS float* s = scr + (8 * c) * 33 + n;
        u32x4 o; o.x = pk2(s[0 * 33], s[1 * 33]); o.y = pk2(s[2 * 33], s[3 * 33]); o.z = pk2(s[4 * 33], s[5 * 33]); o.w = pk2(s[6 * 33], s[7 * 33]);
        *(u32x4*)(WT + (size_t)(n0 + n) * K + k0 + 8 * c) = o; }
    asm volatile("s_waitcnt lgkmcnt(0)" ::: "memory");
}

__device__ __forceinline__ void phase_prologue(const TC tc, KP P, LAS unsigned char* lds) {
    const int tid = tc.tid, lane = tid & 63, wave = tid >> 6;
    const int G = tc.G, gw = tc.bid * 8 + wave, NGW = G * 8;
    unsigned char* ws = P->ws;
    {
        LAS float* scr = (LAS float*)(lds + wave * 8704);
        constexpr int I_IN_A = 16 * 104, I_IN_B = 16 * 8, I_OUT = 16 * 32, I_1 = 16 * 128, I_2 = 64 * 32, I_G = 4 * 8;
        constexpr int I_L = I_IN_A + I_IN_B + I_OUT + I_1 + I_2 + I_G;
        for (int it = gw; it < 2 * I_L; it += NGW) {
            const int l = it / I_L; int r = it % I_L;
            unsigned char* wl = ws + WS_W + (size_t)l * SZ_WL;
            bf16_t* win = (bf16_t*)wl; bf16_t* wout = (bf16_t*)(wl + SZ_WIN); bf16_t* w1 = (bf16_t*)(wl + SZ_WIN + SZ_WOUT); bf16_t* w2 = (bf16_t*)(wl + SZ_WIN + SZ_WOUT + SZ_W1);
            bf16_t* wg = (bf16_t*)(wl + SZ_WIN + SZ_WOUT + SZ_W1 + SZ_W2);
            if (r < I_IN_A) { transpose_item(P->in[8] + (size_t)l * DM * DIN, DIN, 0, DM, win, 104, scr, r, lane); continue; } r -= I_IN_A;
            if (r < I_IN_B) { transpose_item(P->in[8] + (size_t)l * DM * DIN, DIN, 3344, DM, win + (size_t)3328 * DM, 8, scr, r, lane); continue; } r -= I_IN_B;
            if (r < I_OUT) { transpose_item(P->in[26] + (size_t)l * DM * DM, DM, 0, DM, wout, 32, scr, r, lane); continue; } r -= I_OUT;
            if (r < I_1) { transpose_item(P->in[27] + (size_t)l * DM * DFF, DFF, 0, DM, w1, 128, scr, r, lane); continue; } r -= I_1;
            if (r < I_2) { transpose_item(P->in[28] + (size_t)l * DFF * DM, DM, 0, DFF, w2, 32, scr, r, lane); continue; } r -= I_2;
            transpose_item(P->in[24] + (size_t)l * DG * DG, DG, 0, DG, wg, 8, scr, r, lane);
        }
    }
    const int gt = tc.bid * 512 + tid, NGT = G * 512;
    for (int i = gt; i < 2 * 16 * DM; i += NGT) { const int l = i / (16 * DM), c = (i / DM) % 16, k = i % DM;
        ((float*)(ws + WS_W + (size_t)l * SZ_WL + SZ_WL - SZ_WAB))[c * DM + k] = P->in[8][(size_t)l * DM * DIN + (size_t)k * DIN + 3328 + c]; }
    for (int i = gt; i < TSEQ * 32; i += NGT) { const int pos = i >> 5, f = i & 31;
        const float inv = powf(10000.0f, -(float)f / 32.0f); const float ang = (float)pos * inv; float s, c; sincosf(ang, &s, &c);
        ((f32x2*)(ws + WS_ROPE))[i] = (f32x2){c, s}; }
    for (int i = gt; i < 2 * DG; i += NGT) { const float a = P->in[9][i], b = P->in[9][2 * DG + i]; const float mx = fmaxf(a, b), ea = expf(a - mx), eb = expf(b - mx);
        float* lb = (float*)(ws + WS_LB); lb[i] = 0.f; lb[2 * DG + i] = eb / (ea + eb); }
    for (int i = gt; i < 2 * 2 * 16 * 64; i += NGT) { const int p = i & 63, g = (i >> 6) & 15, d = (i >> 10) & 1, l = i >> 11;
        const float lr = P->in[16][i], li = P->in[17][i]; const float dt = expf(P->in[18][(l * 2 + d) * 16 + g]);
        const float mag = expf(lr * dt); float sn, cs; sincosf(li * dt, &sn, &cs); const float ar = mag * cs, ai = mag * sn;
        const float den = lr * lr + li * li, nr = ar - 1.0f, ni = ai; const float fr = (nr * lr + ni * li) / den, fi = (ni * lr - nr * li) / den;
        float* o = (float*)(ws + WS_S5P) + (size_t)i * 34; o[0] = ar; o[1] = ai;
        const float* bre = P->in[19] + ((size_t)(l * 16 + g) * 64 + p) * 16; const float* bim = P->in[20] + ((size_t)(l * 16 + g) * 64 + p) * 16;
        for (int c = 0; c < 16; ++c) { o[2 + c] = fr * bre[c] - fi * bim[c]; o[18 + c] = fr * bim[c] + fi * bre[c]; } }
    __syncthreads();
    {
        LAS float* sc = (LAS float*)lds;
        LAS float* red = (LAS float*)(lds + 36864);
        for (int i = tid; i < 9 * DM; i += 512) { const int v = i >> 10, k = i & 1023; const float x = v < 8 ? P->in[1][v * DM + k] : P->in[3][k]; sc[i] = siluf_(x); }
        __syncthreads();
        for (int item = tc.bid; item < 2 * 96; item += G) {
            const int l = item / 96, cg0 = (item % 96) * 64;
            const int c4 = (tid & 15) * 4, kl = tid >> 4;
            const float* W = P->in[4] + (size_t)l * DM * 6144 + cg0 + c4;
            f32x4 a[9];
#pragma unroll
            for (int v = 0; v < 9; ++v) a[v] = (f32x4){0.f, 0.f, 0.f, 0.f};
            for (int k = kl; k < DM; k += 32) { const f32x4 w = *(const f32x4*)(W + (size_t)k * 6144);
#pragma unroll
                for (int v = 0; v < 9; ++v) a[v] += w * sc[v * DM + k]; }
#pragma unroll
            for (int v = 0; v < 9; ++v) *(LAS f32x4*)(red + kl * 576 + v * 64 + c4) = a[v];
            __syncthreads();
            for (int o = tid; o < 576; o += 512) { float s = 0.f; for (int q = 0; q < 32; ++q) s += red[q * 576 + o];
                const int v = o >> 6, c = cg0 + (o & 63);
                ((float*)(ws + WS_MOD))[((size_t)l * 9 + v) * 6144 + c] = s + P->in[5][l * 6144 + c]; }
            __syncthreads();
        }
    }
}

__device__ __forceinline__ void phase_norm(const TC tc, KP P, LAS unsigned char* lds, int l, int which, const float* src_lat, const float* src_ctx, int r0, bool do_ab) {
    const int tid = tc.tid, lane = tid & 63, wave = tid >> 6;
    const int gw = tc.bid * 8 + wave, NGW = tc.G * 8;
    unsigned char* ws = P->ws;
    LAS float* wab = (LAS float*)lds;
    if (do_ab) { const float* src = (const float*)(ws + WS_W + (size_t)l * SZ_WL + SZ_WL - SZ_WAB);
        for (int i = tid; i < 16 * DM / 4; i += 512) ((LAS f32x4*)wab)[i] = ((const f32x4*)src)[i];
        __syncthreads(); }
    const float* gvec = P->in[which ? 7 : 6] + l * DM;
    const float* mod = (const float*)(ws + WS_MOD) + (size_t)l * 9 * 6144;
    bf16_t* H = (bf16_t*)(ws + WS_HB);
    float* AB = (float*)(ws + WS_AB);
    for (int r = r0 + gw; r < MALL; r += NGW) {
        const float* xrow; int v;
        if (r < MCTX) { xrow = src_ctx + (size_t)r * DM; v = 8; } else { xrow = src_lat + (size_t)(r - MCTX) * DM; v = (r - MCTX) >> 12; }
        const float* sh = mod + (size_t)v * 6144 + (which ? 3 : 0) * DM; const float* scl = mod + (size_t)v * 6144 + (which ? 4 : 1) * DM;
        f32x4 x[4]; float ss = 0.f;
#pragma unroll
        for (int j = 0; j < 4; ++j) { x[j] = ((const f32x4*)xrow)[j * 64 + lane]; ss += (x[j].x * x[j].x + x[j].y * x[j].y) + (x[j].z * x[j].z + x[j].w * x[j].w); }
        const float rstd = rsqrtf(wave_sum(ss) * (1.0f / DM) + EPS);
#pragma unroll
        for (int j = 0; j < 4; ++j) { const f32x4 g = ((const f32x4*)gvec)[j * 64 + lane], s1 = ((const f32x4*)scl)[j * 64 + lane], s0 = ((const f32x4*)sh)[j * 64 + lane];
            x[j] = x[j] * rstd * g * (1.0f + s1) + s0;
            u32x2 w; w.x = pk2(x[j].x, x[j].y); w.y = pk2(x[j].z, x[j].w);
            ((u32x2*)(H + (size_t)r * DM))[j * 64 + lane] = w; }
        if (do_ab) {
#pragma unroll 1
            for (int cq = 0; cq < 4; ++cq) {
                float p[4];
#pragma unroll
                for (int c = 0; c < 4; ++c) { float a = 0.f;
#pragma unroll
                    for (int j = 0; j < 4; ++j) { const f32x4 w = *(const LAS f32x4*)(wab + (cq * 4 + c) * DM + (j * 64 + lane) * 4); a += (x[j].x * w.x + x[j].y * w.y) + (x[j].z * w.z + x[j].w * w.w); }
                    p[c] = a; }
                bool bb = (lane & 32) != 0;
                { const float k0 = bb ? p[2] : p[0], s0 = bb ? p[0] : p[2], k1 = bb ? p[3] : p[1], s1 = bb ? p[1] : p[3]; p[0] = k0 + __shfl_xor(s0, 32); p[1] = k1 + __shfl_xor(s1, 32); }
                bb = (lane & 16) != 0;
                { const float k0 = bb ? p[1] : p[0], s0 = bb ? p[0] : p[1]; p[0] = k0 + __shfl_xor(s0, 16); }
                float tot = p[0];
                tot += __shfl_xor(tot, 8); tot += __shfl_xor(tot, 4); tot += __shfl_xor(tot, 2); tot += __shfl_xor(tot, 1);
                if ((lane & 15) == 0) { const int c = cq * 4 + 2 * ((lane >> 5) & 1) + ((lane >> 4) & 1);
                    float o;
                    if (c < 8) { const int d = c >> 2, h = c & 3; const float xx = tot + P->in[14][(l * 2 + d) * 4 + h]; const float sp = xx > 20.f ? xx : log1pf(expf(xx));
                        o = -expf(P->in[13][(l * 2 + d) * 4 + h]) * sp; }
                    else o = 1.0f / (1.0f + expf(-tot));
                    AB[(size_t)r * 16 + c] = o; }
            }
        }
    }
}

__device__ __forceinline__ void phase_mixpre(const TC tc, KP P, int l) {
    const int tid = tc.tid, lane = tid & 63, wave = tid >> 6;
    const int gw = tc.bid * 8 + wave, NGW = tc.G * 8;
    unsigned char* ws = P->ws;
    bf16_t* Z = (bf16_t*)(ws + WS_Z);
    bf16_t* QC = (bf16_t*)(ws + WS_HB);
    const float* lb = (const float*)(ws + WS_LB) + l * 2 * DG;
    const f32x2* rope = (const f32x2*)(ws + WS_ROPE);
    const float* cw = P->in[12] + (size_t)l * 9 * 768;
    for (int r = gw; r < MALL; r += NGW) {
        bf16_t* zr = Z + (size_t)r * NZ;
        int pos, b, s; bool isctx = r < MCTX;
        if (isctx) { b = r >> 8; s = r & 255; pos = s; } else { b = (r - MCTX) >> 12; s = (r - MCTX) & 4095; pos = TCTX + s; }
        { u32x2 w = ((u32x2*)(zr + ZC_HQ))[lane];
          w.x = pk2(siluf_(bflo(w.x)) * 0.125f, siluf_(bfhi(w.x)) * 0.125f); w.y = pk2(siluf_(bflo(w.y)) * 0.125f, siluf_(bfhi(w.y)) * 0.125f);
          ((u32x2*)(zr + ZC_HQ))[lane] = w; }
        { u32x4 w = ((u32x4*)(zr + ZC_HF))[lane]; const int c0 = lane * 8; unsigned* pw = (unsigned*)&w;
#pragma unroll
          for (int e = 0; e < 4; ++e) { const int c = c0 + 2 * e;
              const float f0 = bflo(pw[e]), f1 = bfhi(pw[e]);
              const float l0 = fmaxf(lb[c], 1e-30f), l1 = fmaxf(lb[c + 1], 1e-30f);
              const float s0 = 1.0f / (1.0f + expf(-f0)), s1 = 1.0f / (1.0f + expf(-f1));
              pw[e] = pk2(logf(l0 * (1.0f - s0) + s0), logf(l1 * (1.0f - s1) + s1)); }
          ((u32x4*)(zr + ZC_HF))[lane] = w; }
        {
#pragma unroll
          for (int qk = 0; qk < 2; ++qk) { bf16_t* base = zr + (qk ? ZC_RK : ZC_RQ) + (lane >> 4) * 64 + (lane & 15) * 2;
              const unsigned w1 = *(const unsigned*)base, w2 = *(const unsigned*)(base + 32);
              const f32x2 cs0 = rope[pos * 32 + (lane & 15) * 2], cs1 = rope[pos * 32 + (lane & 15) * 2 + 1];
              const float sc = qk ? 0.125f : 1.0f;
              const float a0 = bflo(w1), a1 = bfhi(w1), b0 = bflo(w2), b1 = bfhi(w2);
              *(unsigned*)base = pk2((a0 * cs0.x - b0 * cs0.y) * sc, (a1 * cs1.x - b1 * cs1.y) * sc);
              *(unsigned*)(base + 32) = pk2((a0 * cs0.y + b0 * cs0.x) * sc, (a1 * cs1.y + b1 * cs1.x) * sc); } }
        {
            float acc[3][4];
#pragma unroll
            for (int g = 0; g < 3; ++g)
#pragma unroll
                for (int e = 0; e < 4; ++e) acc[g][e] = 0.f;
            const int gx = isctx ? s : (s & 63), gy = isctx ? 0 : (s >> 6), W = isctx ? TCTX : 64, Hh = isctx ? 1 : 64;
#pragma unroll
            for (int dy = 0; dy < 3; ++dy) { const int yy = gy + dy - 1; if (yy < 0 || yy >= Hh) continue;
#pragma unroll
                for (int dx = 0; dx < 3; ++dx) { const int xx = gx + dx - 1; if (xx < 0 || xx >= W) continue;
                    const int rr = r + (dy - 1) * 64 + (dx - 1);
                    const bf16_t* zn = Z + (size_t)rr * NZ + ZC_GQKV + lane * 4; const float* wp = cw + (dy * 3 + dx) * 768 + lane * 4;
#pragma unroll
                    for (int g = 0; g < 3; ++g) { const u32x2 w = *(const u32x2*)(zn + g * 256); const f32x4 k = *(const f32x4*)(wp + g * 256);
                        acc[g][0] += bflo(w.x) * k.x; acc[g][1] += bfhi(w.x) * k.y; acc[g][2] += bflo(w.y) * k.z; acc[g][3] += bfhi(w.y) * k.w; } } }
#pragma unroll
            for (int g = 0; g < 3; ++g) {
#pragma unroll
                for (int e = 0; e < 4; ++e) acc[g][e] = siluf_(acc[g][e]);
                if (g < 2) { float ss = (acc[g][0] * acc[g][0] + acc[g][1] * acc[g][1]) + (acc[g][2] * acc[g][2] + acc[g][3] * acc[g][3]);
                    ss += __shfl_xor(ss, 1); ss += __shfl_xor(ss, 2); ss += __shfl_xor(ss, 4); ss += __shfl_xor(ss, 8);
                    const float rn = rsqrtf(ss + EPS) * (g == 0 ? 0.125f : 1.0f);
#pragma unroll
                    for (int e = 0; e < 4; ++e) acc[g][e] *= rn; }
                u32x2 w; w.x = pk2(acc[g][0], acc[g][1]); w.y = pk2(acc[g][2], acc[g][3]);
                *(u32x2*)(QC + (size_t)r * 768 + g * 256 + lane * 4) = w; }
        }
    }
}

constexpr int TB = 32, NBATCH = TSEQ / TB;
constexpr int CH_ARR = TB * 64 * 4;
constexpr int CH_BUF = 4 * CH_ARR + 256;
constexpr int CH_OS = 2 * CH_BUF;
static_assert(CH_OS + 2 * CH_ARR <= LDS_BYTES, "chain LDS");

template <int KIND>
__device__ __forceinline__ void chain_matrix(const TC tc, KP P, LAS unsigned char* lds, int l, int chain) {
    const int tid = tc.tid, lane = tid & 63, wave = tid >> 6;
    const int b = chain >> 3, h = (chain >> 1) & 3, d = chain & 1;
    unsigned char* ws = P->ws;
    const bf16_t* Z = (const bf16_t*)(ws + WS_Z);
    const bf16_t* QC = (const bf16_t*)(ws + WS_HB);
    const float* AB = (const float*)(ws + WS_AB);
    bf16_t* O = (bf16_t*)(ws + (d ? WS_OB : WS_OF));
    const int ocol = KIND * 256 + h * 64;
    const bool loader = wave >= 4;
    const int lt = tid - 256, ltok = lt >> 3, lseg = lt & 7;
    float gam = 0.f;
    if (KIND == 1) gam = 1.0f / (1.0f + expf(-P->in[11][(l * 2 + d) * 4 + h]));
    auto load = [&](int n, int bi) {
        const int row = seq_row(b, d, n * TB + ltok);
        LAS float* base = (LAS float*)(lds + bi * CH_BUF) + ltok * 64 + lseg * 8;
        u32x4 q, k, v;
        if (KIND == 0) { const bf16_t* zr = Z + (size_t)row * NZ + h * 64 + lseg * 8; q = *(const u32x4*)(zr + ZC_HQ); k = *(const u32x4*)(zr + ZC_HF + d * 256); v = *(const u32x4*)(zr + ZC_HI); }
        else if (KIND == 1) { const bf16_t* zr = Z + (size_t)row * NZ + h * 64 + lseg * 8; q = *(const u32x4*)(zr + ZC_RQ); k = *(const u32x4*)(zr + ZC_RK); v = *(const u32x4*)(zr + ZC_RV); }
        else { const bf16_t* qr = QC + (size_t)row * 768 + h * 64 + lseg * 8; q = *(const u32x4*)qr; k = *(const u32x4*)(qr + 256); v = *(const u32x4*)(qr + 512);
            if (lseg == 0) { LAS float* sc = (LAS float*)(lds + bi * CH_BUF + 4 * CH_ARR); sc[ltok * 2] = expf(AB[(size_t)row * 16 + d * 4 + h]); sc[ltok * 2 + 1] = AB[(size_t)row * 16 + 8 + d * 4 + h]; } }
        const unsigned* pq = (const unsigned*)&q; const unsigned* pk = (const unsigned*)&k; const unsigned* pv = (const unsigned*)&v;
#pragma unroll
        for (int e = 0; e < 4; ++e) {
            base[2 * e] = bflo(pq[e]); base[2 * e + 1] = bfhi(pq[e]);
            base[3 * TB * 64 + 2 * e] = bflo(pv[e]); base[3 * TB * 64 + 2 * e + 1] = bfhi(pv[e]);
            if (KIND == 0) { const float l0 = bflo(pk[e]), l1 = bfhi(pk[e]); const float f0 = expf(l0), f1 = expf(l1);
                base[TB * 64 + 2 * e] = f0; base[TB * 64 + 2 * e + 1] = f1; base[2 * TB * 64 + 2 * e] = -expm1f(l0); base[2 * TB * 64 + 2 * e + 1] = -expm1f(l1); }
            else { base[TB * 64 + 2 * e] = bflo(pk[e]); base[TB * 64 + 2 * e + 1] = bfhi(pk[e]); }
        }
    };
    auto store = [&](int n, int bi) {
        const int row = seq_row(b, d, n * TB + ltok);
        const LAS float* os = (const LAS float*)(lds + CH_OS + bi * CH_ARR) + ltok * 64 + lseg * 8;
        u32x4 w; w.x = pk2(os[0], os[1]); w.y = pk2(os[2], os[3]); w.z = pk2(os[4], os[5]); w.w = pk2(os[6], os[7]);
        *(u32x4*)(O + (size_t)row * DM + ocol + lseg * 8) = w;
    };
    float S[16];
#pragma unroll
    for (int i = 0; i < 16; ++i) S[i] = 0.f;
    const int vl = lane >> 2, kg = lane & 3, vcol = (wave & 3) * 16 + vl;
    if (loader) load(0, 0);
    __syncthreads();
    for (int n = 0; n < NBATCH; ++n) {
        if (loader) { if (n + 1 < NBATCH) load(n + 1, (n + 1) & 1); if (n >= 1) store(n - 1, (n - 1) & 1); }
        else {
            const LAS float* A0 = (const LAS float*)(lds + (n & 1) * CH_BUF);
            const LAS float* sc = (const LAS float*)(lds + (n & 1) * CH_BUF + 4 * CH_ARR);
            LAS float* os = (LAS float*)(lds + CH_OS + (n & 1) * CH_ARR);
#pragma unroll 2
            for (int tt = 0; tt < TB; ++tt) {
                const LAS float* a = A0 + tt * 64 + kg * 16;
                float q[16], k[16];
#pragma unroll
                for (int i = 0; i < 4; ++i) { const f32x4 t4 = *(const LAS f32x4*)(a + 4 * i); q[4 * i] = t4.x; q[4 * i + 1] = t4.y; q[4 * i + 2] = t4.z; q[4 * i + 3] = t4.w; }
#pragma unroll
                for (int i = 0; i < 4; ++i) { const f32x4 t4 = *(const LAS f32x4*)(a + TB * 64 + 4 * i); k[4 * i] = t4.x; k[4 * i + 1] = t4.y; k[4 * i + 2] = t4.z; k[4 * i + 3] = t4.w; }
                const float vv = A0[3 * TB * 64 + tt * 64 + vcol];
                float o = 0.f;
                if (KIND == 0) {
                    float kk[16];
#pragma unroll
                    for (int i = 0; i < 4; ++i) { const f32x4 t4 = *(const LAS f32x4*)(a + 2 * TB * 64 + 4 * i); kk[4 * i] = t4.x; kk[4 * i + 1] = t4.y; kk[4 * i + 2] = t4.z; kk[4 * i + 3] = t4.w; }
#pragma unroll
                    for (int i = 0; i < 16; ++i) { S[i] = k[i] * S[i] + kk[i] * vv; o += q[i] * S[i]; }
                } else if (KIND == 1) {
#pragma unroll
                    for (int i = 0; i < 16; ++i) { S[i] = gam * S[i] + k[i] * vv; o += q[i] * S[i]; }
                } else {
                    const float alpha = sc[tt * 2], beta = sc[tt * 2 + 1];
                    float r = 0.f;
#pragma unroll
                    for (int i = 0; i < 16; ++i) r += k[i] * S[i];
                    r = quad_sum(r);
                    const float c = beta * (vv - alpha * r);
#pragma unroll
                    for (int i = 0; i < 16; ++i) { S[i] = alpha * S[i] + k[i] * c; o += q[i] * S[i]; }
                }
                o = quad_sum(o);
                if (kg == 0) os[tt * 64 + vcol] = o;
            }
        }
        __syncthreads();
    }
    if (loader) store(NBATCH - 1, (NBATCH - 1) & 1);
    __syncthreads();
}

constexpr int S5_US = 0, S5_YS = 2 * 4 * TB * 16 * 4;
__device__ __forceinline__ void chain_s5(const TC tc, KP P, LAS unsigned char* lds, int l, int item) {
    const int tid = tc.tid, lane = tid & 63, wave = tid >> 6;
    const int b = item >> 3, d = (item >> 2) & 1, gq = item & 3;
    unsigned char* ws = P->ws;
    const bf16_t* Z = (const bf16_t*)(ws + WS_Z);
    bf16_t* O = (bf16_t*)(ws + (d ? WS_OB : WS_OF));
    const bool loader = wave >= 4;
    const int lt = tid - 256, lch = lt >> 6, ltok = (lt >> 1) & 31, lhalf = lt & 1;
    auto load = [&](int n, int bi) {
        const int row = seq_row(b, d, n * TB + ltok);
        const u32x4 u = *(const u32x4*)(Z + (size_t)row * NZ + ZC_SU + gq * 64 + lch * 16 + lhalf * 8);
        LAS float* us = (LAS float*)(lds + S5_US) + ((bi * 4 + lch) * TB + ltok) * 16 + lhalf * 8; const unsigned* pu = (const unsigned*)&u;
#pragma unroll
        for (int e = 0; e < 4; ++e) { us[2 * e] = bflo(pu[e]); us[2 * e + 1] = bfhi(pu[e]); }
    };
    auto store = [&](int n, int bi) {
        const int row = seq_row(b, d, n * TB + ltok);
        const LAS float* ys = (const LAS float*)(lds + S5_YS) + ((bi * 4 + lch) * TB + ltok) * 16 + lhalf * 8;
        u32x4 w; w.x = pk2(ys[0], ys[1]); w.y = pk2(ys[2], ys[3]); w.z = pk2(ys[4], ys[5]); w.w = pk2(ys[6], ys[7]);
        *(u32x4*)(O + (size_t)row * DM + 768 + gq * 64 + lch * 16 + lhalf * 8) = w;
    };
    float bre[16], bim[16], cre[16], cim[16], ar = 0.f, ai = 0.f, hr = 0.f, hi = 0.f;
    if (!loader) {
        const int g = gq * 4 + wave;
        const float* sp = (const float*)(ws + WS_S5P) + ((size_t)((l * 2 + d) * 16 + g) * 64 + lane) * 34;
        ar = sp[0]; ai = sp[1];
#pragma unroll
        for (int c = 0; c < 16; ++c) { bre[c] = sp[2 + c]; bim[c] = sp[18 + c];
            cre[c] = P->in[21][((size_t)(l * 16 + g) * 16 + c) * 64 + lane]; cim[c] = P->in[22][((size_t)(l * 16 + g) * 16 + c) * 64 + lane]; }
    }
    if (loader) load(0, 0);
    __syncthreads();
    for (int n = 0; n < NBATCH; ++n) {
        if (loader) { if (n + 1 < NBATCH) load(n + 1, (n + 1) & 1); if (n >= 1) store(n - 1, (n - 1) & 1); }
        else {
            const LAS float* us = (const LAS float*)(lds + S5_US) + (((n & 1) * 4 + wave) * TB) * 16;
            LAS float* ys = (LAS float*)(lds + S5_YS) + (((n & 1) * 4 + wave) * TB) * 16;
            for (int tt = 0; tt < TB; ++tt) {
                float u[16];
#pragma unroll
                for (int i = 0; i < 4; ++i) { const f32x4 t4 = *(const LAS f32x4*)(us + tt * 16 + 4 * i); u[4 * i] = t4.x; u[4 * i + 1] = t4.y; u[4 * i + 2] = t4.z; u[4 * i + 3] = t4.w; }
                float xr = 0.f, xi = 0.f;
#pragma unroll
                for (int c = 0; c < 16; ++c) { xr += bre[c] * u[c]; xi += bim[c] * u[c]; }
                const float nhr = ar * hr - ai * hi + xr, nhi = ar * hi + ai * hr + xi; hr = nhr; hi = nhi;
                float p[16];
#pragma unroll
                for (int c = 0; c < 16; ++c) p[c] = cre[c] * hr - cim[c] * hi;
                const float tot = reduce16(p, lane);
                if ((lane & 3) == 0) { const int c = 8 * ((lane >> 5) & 1) + 4 * ((lane >> 4) & 1) + 2 * ((lane >> 3) & 1) + ((lane >> 2) & 1); ys[tt * 16 + c] = tot; }
            }
        }
        __syncthreads();
    }
    if (loader) store(NBATCH - 1, (NBATCH - 1) & 1);
    __syncthreads();
}

__device__ __forceinline__ void phase_mixscan(const TC tc, KP P, LAS unsigned char* lds, int l) {
    for (int item = tc.bid; item < 256; item += tc.G) {
        const int kind = item >> 6, c = item & 63;
        if (kind == 0) chain_matrix<0>(tc, P, lds, l, c);
        else if (kind == 1) chain_matrix<1>(tc, P, lds, l, c);
        else if (kind == 2) chain_matrix<2>(tc, P, lds, l, c);
        else chain_s5(tc, P, lds, l, c);
    }
}

__device__ __forceinline__ void phase_combine(const TC tc, KP P, int l, int r0) {
    const int tid = tc.tid, lane = tid & 63, wave = tid >> 6;
    const int gw = tc.bid * 8 + wave, NGW = tc.G * 8;
    unsigned char* ws = P->ws;
    const bf16_t* Z = (const bf16_t*)(ws + WS_Z);
    const bf16_t* OF = (const bf16_t*)(ws + WS_OF); const bf16_t* OB = (const bf16_t*)(ws + WS_OB);
    bf16_t* CAT = (bf16_t*)(ws + WS_HB);
    const float* ghg = P->in[10] + l * 64; const float* ggd = P->in[15] + l * 64; const float* dsk = P->in[23] + l * DG;
    const int hc = (lane & 15) * 4;
    const f32x4 g_h = *(const f32x4*)(ghg + hc), g_g = *(const f32x4*)(ggd + hc);
    const f32x4 dv = *(const f32x4*)(dsk + lane * 4);
    for (int r = r0 + gw; r < MALL; r += NGW) {
        const bf16_t* zr = Z + (size_t)r * NZ;
#pragma unroll
        for (int mx = 0; mx < 3; ++mx) {
            const u32x2 a = *(const u32x2*)(OF + (size_t)r * DM + mx * 256 + lane * 4), bb = *(const u32x2*)(OB + (size_t)r * DM + mx * 256 + lane * 4);
            f32x4 o = (f32x4){bflo(a.x) + bflo(bb.x), bfhi(a.x) + bfhi(bb.x), bflo(a.y) + bflo(bb.y), bfhi(a.y) + bfhi(bb.y)};
            float ss = (o.x * o.x + o.y * o.y) + (o.z * o.z + o.w * o.w);
            ss += __shfl_xor(ss, 1); ss += __shfl_xor(ss, 2); ss += __shfl_xor(ss, 4); ss += __shfl_xor(ss, 8);
            const float rn = rsqrtf(ss * (1.0f / 64.0f) + EPS);
            o = o * rn; if (mx == 0) o = o * g_h; if (mx == 2) o = o * g_g;
            const u32x2 gt = *(const u32x2*)(zr + (mx == 0 ? ZC_HG : mx == 1 ? ZC_RG : ZC_GG) + lane * 4);
            u32x2 w; w.x = pk2(o.x * siluf_(bflo(gt.x)), o.y * siluf_(bfhi(gt.x))); w.y = pk2(o.z * siluf_(bflo(gt.y)), o.w * siluf_(bfhi(gt.y)));
            *(u32x2*)(CAT + (size_t)r * DM + mx * 256 + lane * 4) = w;
        }
        { const u32x2 a = *(const u32x2*)(OF + (size_t)r * DM + 768 + lane * 4), bb = *(const u32x2*)(OB + (size_t)r * DM + 768 + lane * 4);
          const u32x2 uu = *(const u32x2*)(zr + ZC_SU + lane * 4);
          const float y0 = bflo(a.x) + bflo(bb.x) + bflo(uu.x) * dv.x, y1 = bfhi(a.x) + bfhi(bb.x) + bfhi(uu.x) * dv.y, y2 = bflo(a.y) + bflo(bb.y) + bflo(uu.y) * dv.z, y3 = bfhi(a.y) + bfhi(bb.y) + bfhi(uu.y) * dv.w;
          u32x2 w; w.x = pk2(gelu_tanh(y0), gelu_tanh(y1)); w.y = pk2(gelu_tanh(y2), gelu_tanh(y3));
          *(u32x2*)(CAT + (size_t)r * DM + 768 + lane * 4) = w; }
    }
}

__device__ __forceinline__ void phase_glu(const TC tc, KP P, LAS unsigned char* lds, int l, int r0) {
    const int tid = tc.tid, lane = tid & 63, wave = tid >> 6;
    const int gw = tc.bid * 8 + wave, NGW = tc.G * 8;
    const int ntile = (MALL - r0) / 16;
    if (tc.bid * 8 >= ntile) return;
    unsigned char* ws = P->ws;
    const bf16_t* wg = (const bf16_t*)(ws + WS_W + (size_t)l * SZ_WL + SZ_WIN + SZ_WOUT + SZ_W1 + SZ_W2);
    for (int i = tid; i < 256 * 32; i += 512) { const int n = i >> 5, c = i & 31; *(LAS u32x4*)(lds + n * 528 + c * 16) = *(const u32x4*)(wg + n * 256 + c * 8); }
    __syncthreads();
    bf16_t* CAT = (bf16_t*)(ws + WS_HB);
    const float* bias = P->in[25] + l * DG;
    const int fr = lane & 15, fq = lane >> 4;
    for (int t = gw; t < ntile; t += NGW) {
        bf16_t* rowp = CAT + (size_t)(r0 + t * 16 + fr) * DM + 768;
        bf16x8 af[8];
#pragma unroll
        for (int ks = 0; ks < 8; ++ks) af[ks] = *(const bf16x8*)(rowp + ks * 32 + fq * 8);
        f32x4 acc[16];
#pragma unroll
        for (int nt = 0; nt < 16; ++nt) acc[nt] = (f32x4){0.f, 0.f, 0.f, 0.f};
#pragma unroll
        for (int ks = 0; ks < 8; ++ks)
#pragma unroll
            for (int nt = 0; nt < 16; ++nt) { const bf16x8 wf = *(const LAS bf16x8*)(lds + (nt * 16 + fr) * 528 + (ks * 32 + fq * 8) * 2);
                acc[nt] = __builtin_amdgcn_mfma_f32_16x16x32_bf16(wf, af[ks], acc[nt], 0, 0, 0); if ((nt & 7) == 7) asm volatile("" ::: "memory"); }
#pragma unroll
        for (int nt = 0; nt < 16; ++nt) { const int c = nt * 16 + 4 * fq; asm volatile("" ::: "memory"); const f32x4 bv = *(const f32x4*)(bias + c); const u32x2 y = *(const u32x2*)(rowp + c);
            u32x2 w; w.x = pk2(bflo(y.x) * sigmoidf_(acc[nt][0] + bv[0]), bfhi(y.x) * sigmoidf_(acc[nt][1] + bv[1])); w.y = pk2(bflo(y.y) * sigmoidf_(acc[nt][2] + bv[2]), bfhi(y.y) * sigmoidf_(acc[nt][3] + bv[3]));
            *(u32x2*)(rowp + c) = w; }
    }
}

__device__ __forceinline__ void phase_final(const TC tc, KP P) {
    const int tid = tc.tid, lane = tid & 63, wave = tid >> 6;
    const int gw = tc.bid * 8 + wave, NGW = tc.G * 8;
    const float* g = P->in[29];
    for (int r = gw; r < MLAT; r += NGW) {
        float* xr = P->out + (size_t)r * DM;
        f32x4 x[4]; float ss = 0.f;
#pragma unroll
        for (int j = 0; j < 4; ++j) { x[j] = ((const f32x4*)xr)[j * 64 + lane]; ss += (x[j].x * x[j].x + x[j].y * x[j].y) + (x[j].z * x[j].z + x[j].w * x[j].w); }
        const float rstd = rsqrtf(wave_sum(ss) * (1.0f / DM) + EPS);
#pragma unroll
        for (int j = 0; j < 4; ++j) ((f32x4*)xr)[j * 64 + lane] = x[j] * rstd * ((const f32x4*)g)[j * 64 + lane];
    }
}


#define XB_TMO      128
#define XB_XCNT(j)  (256  + 64 * (j))
#define XB_XSUB(j)  (1280 + 64 * (j))
#define XB_XGEN(j)  (2304 + 64 * (j))
#define XB_TOP      3328
#define XB_TOPGEN   3392
#define XCD_BAR_WORDS 3456
#define XB_SPIN_CAP (1u << 22)
__device__ __forceinline__ unsigned xb_ld(unsigned* p)              { return __hip_atomic_load(p, __ATOMIC_RELAXED, __HIP_MEMORY_SCOPE_AGENT); }
__device__ __forceinline__ unsigned xb_add(unsigned* p, unsigned v) { return __hip_atomic_fetch_add(p, v, __ATOMIC_RELAXED, __HIP_MEMORY_SCOPE_AGENT); }
__device__ __forceinline__ unsigned xb_xcc_id() { return (unsigned)__builtin_amdgcn_s_getreg((3 << 11) | 20) & 0xFu; }
#define XB_SPIN(cond, bar) do { unsigned _sp = 0; while (cond) { __builtin_amdgcn_s_sleep(1); \
    if ((++_sp & 255u) == 0u) { if (xb_ld(&(bar)[XB_TMO])) break; if (_sp > XB_SPIN_CAP) { atomicAdd(&(bar)[XB_TMO], 1u); break; } } } } while (0)
__device__ __forceinline__ void xcd_barrier_complete(unsigned* bar, unsigned x, unsigned G, unsigned& nloc, unsigned& nx) {
    unsigned sum, cnt, mine, sp = 0u;
    for (;;) {
        sum = 0u; cnt = 0u; mine = 0u;
#pragma unroll
        for (unsigned j = 0; j < 16; ++j) { const unsigned c = xb_ld(&bar[XB_XCNT(j)]); sum += c; cnt += (c > 0u) ? 1u : 0u; mine = (j == x) ? c : mine; }
        if (sum == G) break;
        __builtin_amdgcn_s_sleep(1);
        if ((++sp & 255u) == 0u) { if (xb_ld(&bar[XB_TMO])) break; if (sp > XB_SPIN_CAP) { atomicAdd(&bar[XB_TMO], 1u); break; } }
    }
    nloc = mine > 0u ? mine : 1u; nx = cnt > 0u ? cnt : 1u;
}
__device__ __forceinline__ void xcd_barrier(unsigned* bar, volatile LAS unsigned* st, int tid, unsigned G) {
    asm volatile("s_waitcnt vmcnt(0)" ::: "memory");
    __syncthreads();
    if (tid == 0) {
        __builtin_amdgcn_s_waitcnt(0);
        const unsigned x = xb_xcc_id();
        unsigned nloc = st[0], nx = st[1];
        if (nloc == 0u) { xcd_barrier_complete(bar, x, G, nloc, nx); st[0] = nloc; st[1] = nx; }
        const unsigned old = xb_add(&bar[XB_XSUB(x)], 1u);
        const unsigned gen = old / nloc;
        if (old + 1u == (gen + 1u) * nloc) {
            __builtin_amdgcn_fence(__ATOMIC_RELEASE, "agent");
            asm volatile("s_waitcnt vmcnt(0)" ::: "memory");
            const unsigned og = xb_add(&bar[XB_TOP], 1u);
            const unsigned tg = og / nx;
            if (og + 1u == (tg + 1u) * nx) xb_add(&bar[XB_TOPGEN], 1u);
            else XB_SPIN(xb_ld(&bar[XB_TOPGEN]) == tg, bar);
            __builtin_amdgcn_fence(__ATOMIC_ACQUIRE, "agent");
            xb_add(&bar[XB_XGEN(x)], 1u);
            asm volatile("s_waitcnt vmcnt(0)" ::: "memory");
        } else {
            XB_SPIN(xb_ld(&bar[XB_XGEN(x)]) == gen, bar);
            __builtin_amdgcn_fence(__ATOMIC_ACQUIRE, "agent");
            asm volatile("s_waitcnt vmcnt(0)" ::: "memory");
        }
    }
    __syncthreads();
}

__global__ void __launch_bounds__(512, 2) mega(Params Pk) {
    extern __shared__ __attribute__((aligned(16))) unsigned char lds_raw[];
    LAS unsigned char* lds = (LAS unsigned char*)lds_raw;
    cg::grid_group grid = cg::this_grid();
    volatile LAS unsigned* bst = (volatile LAS unsigned*)(lds + LDS_BYTES - 64);
    if (threadIdx.x < 16) bst[threadIdx.x] = 0u;
    __syncthreads();
    if (threadIdx.x == 0) (void)xb_add((unsigned*)(Pk.ws + WS_CTL) + XB_XCNT(xb_xcc_id()), 1u);
#ifndef PROBE_DUP
#define PROBE_DUP 0
#endif
    for (int phx = Pk.ph_lo * 2; phx < Pk.ph_hi * 2; ++phx) {
        const int ph = phx >> 1;
        if (phx & 1) { if (!(PROBE_DUP && ph >= 1 && ph < NPHASE - 1 && ((PROBE_DUP >> ((ph - 1) % 10)) & 1))) continue; xcd_barrier((unsigned*)(Pk.ws + WS_CTL), bst, threadIdx.x, gridDim.x); }
        KP P = (KP)__builtin_amdgcn_kernarg_segment_ptr();
        asm volatile("" : "+s"(P));
        TC tc; tc.tid = threadIdx.x; tc.bid = blockIdx.x; tc.G = gridDim.x;
        asm volatile("" : "+v"(tc.tid)); asm volatile("" : "+s"(tc.bid)); asm volatile("" : "+s"(tc.G));
        unsigned char* ws = P->ws;
#ifndef PHMASK
#define PHMASK 0xFFFF
#endif
        if (ph == 0) { if (PHMASK & 1) phase_prologue(tc, P, lds); }
        else if (ph == NPHASE - 1) { if (PHMASK & 2) phase_final(tc, P); }
        else {
            const int l = (ph - 1) / 10, sp = (ph - 1) % 10;
            const int pm_off = (l == DEPTH - 1) ? 8 : 0, r0 = pm_off * 256, Mrows = MALL - r0;
#define WL(off) ((const bf16_t*)(ws + WS_W + (size_t)l * SZ_WL + (off)))
#define HB_ ((bf16_t*)(ws + WS_HB))
#define XC_ ((float*)(ws + WS_XC))
#define MODL ((const float*)(ws + WS_MOD) + (size_t)l * 9 * 6144)
            switch (sp) {
            case 0: if (PHMASK & (1 << 2)) phase_norm(tc, P, lds, l, 0, (l == 0) ? P->in[0] : (const float*)P->out, (l == 0) ? P->in[2] : (const float*)XC_, 0, true); break;
            case 1: if (PHMASK & (1 << 3)) { pg8::Gemm g{HB_, WL(0), MALL, NZ, DM, DM}; pg8::StaticOrder S; S.init(MALL, NZ, tc.G, tc.bid); pg8::EpiBf<0> E{(bf16_t*)(ws + WS_Z), NZ}; pg8::gemm_phase(tc, lds, g, S, E); } break;
            case 2: if (PHMASK & (1 << 4)) phase_mixpre(tc, P, l); break;
            case 3: if (PHMASK & (1 << 5)) phase_mixscan(tc, P, lds, l); break;
            case 4: if (PHMASK & (1 << 6)) phase_combine(tc, P, l, r0); break;
            case 5: if (PHMASK & (1 << 7)) phase_glu(tc, P, lds, l, r0); break;
            case 6: if (PHMASK & (1 << 8)) { pg8::Gemm g{HB_ + (size_t)r0 * DM, WL(SZ_WIN), Mrows, DM, DM, DM}; pg8::StaticOrder S; S.init(Mrows, DM, tc.G, tc.bid);
                      pg8::EpiRes E{(l == 0) ? P->in[0] : (const float*)P->out, (l == 0) ? P->in[2] : (const float*)XC_, P->out, XC_, MODL + 2 * DM, pm_off}; pg8::gemm_phase(tc, lds, g, S, E); } break;
            case 7: if (PHMASK & (1 << 9)) phase_norm(tc, P, lds, l, 1, P->out, XC_, r0, false); break;
            case 8: if (PHMASK & (1 << 10)) { pg8::Gemm g{HB_ + (size_t)r0 * DM, WL(SZ_WIN + SZ_WOUT), Mrows, DFF, DM, DM}; pg8::StaticOrder S; S.init(Mrows, DFF, tc.G, tc.bid); pg8::EpiBf<1> E{(bf16_t*)(ws + WS_U) + (size_t)r0 * DFF, DFF}; pg8::gemm_phase(tc, lds, g, S, E); } break;
            case 9: if (PHMASK & (1 << 11)) { pg8::Gemm g{(const bf16_t*)(ws + WS_U) + (size_t)r0 * DFF, WL(SZ_WIN + SZ_WOUT + SZ_W1), Mrows, DM, DFF, DFF}; pg8::StaticOrder S; S.init(Mrows, DM, tc.G, tc.bid);
                      pg8::EpiRes E{P->out, XC_, P->out, XC_, MODL + 5 * DM, pm_off}; pg8::gemm_phase(tc, lds, g, S, E); } break;
            }
        }
        if (ph + 1 < Pk.ph_hi) { if (ph == Pk.ph_lo) grid.sync(); else xcd_barrier((unsigned*)(P->ws + WS_CTL), bst, tc.tid, (unsigned)tc.G); }
    }
}

extern "C" void kernel_launch(void* const* d_in, const int* in_sizes, int n_in, void* d_out, int out_size, void* d_ws, size_t ws_size, hipStream_t stream) {
    static int grid = 0;
    if (grid == 0) {
        if (n_in != 30 || in_sizes[0] != MLAT * DM || out_size != MLAT * DM || ws_size < WS_TOTAL) {
            fprintf(stderr, "kernel_launch: unexpected shapes: n_in %d in0 %d out %d ws %zu (need %zu)\n", n_in, n_in > 0 ? in_sizes[0] : -1, out_size, ws_size, (size_t)WS_TOTAL); grid = -1; return; }
        int dev = 0, cus = 0, per_cu = 0;
        hipGetDevice(&dev); hipDeviceGetAttribute(&cus, hipDeviceAttributeMultiprocessorCount, dev);
        if (hipFuncSetAttribute((const void*)mega, hipFuncAttributeMaxDynamicSharedMemorySize, LDS_BYTES) != hipSuccess) { fprintf(stderr, "kernel_launch: hipFuncSetAttribute failed\n"); grid = -1; return; }
        if (hipOccupancyMaxActiveBlocksPerMultiprocessor(&per_cu, (const void*)mega, 512, LDS_BYTES) != hipSuccess || per_cu < 1) { fprintf(stderr, "kernel_launch: occupancy query failed (%d)\n", per_cu); (void)hipGetLastError(); per_cu = 1; }
        grid = cus * 1;
        if (per_cu < 1) grid = -1;
    }
    if (grid < 0) return;
    if (hipMemsetAsync((char*)d_ws + WS_CTL, 0, CTL_BYTES, stream) != hipSuccess) { fprintf(stderr, "kernel_launch: memset failed\n"); return; }
    Params p{};
    for (int i = 0; i < 30; ++i) p.in[i] = (const float*)d_in[i];
    p.out = (float*)d_out; p.ws = (unsigned char*)d_ws;
#if MK_MULTI
    for (int ph = 0; ph < NPHASE; ++ph) { p.ph_lo = ph; p.ph_hi = ph + 1; hipLaunchKernelGGL(mega, dim3(grid), dim3(512), LDS_BYTES, stream, p); }
#else
    p.ph_lo = 0; p.ph_hi = NPHASE;
    void* args[] = {&p};
    hipError_t e = hipLaunchCooperativeKernel((const void*)mega, dim3(grid), dim3(512), args, LDS_BYTES, stream);
    if (e != hipSuccess) fprintf(stderr, "cooperative launch failed: %s (grid %d)\n", hipGetErrorString(e), grid);
#endif
}
```

```cpp
#include <hip/hip_runtime.h>
#include <hip/hip_cooperative_groups.h>
#include <cstdio>
#include <cstdint>
namespace cg = cooperative_groups;

#ifndef MK_MULTI
#define MK_MULTI 0
#endif

#define LAS __attribute__((address_space(3)))
typedef unsigned short bf16_t;
typedef short bf16x8 __attribute__((ext_vector_type(8)));
typedef float f32x4 __attribute__((ext_vector_type(4)));
typedef float f32x2 __attribute__((ext_vector_type(2)));
typedef unsigned u32x4 __attribute__((ext_vector_type(4)));
typedef unsigned u32x2 __attribute__((ext_vector_type(2)));

constexpr int NB = 8, TLAT = 4096, TCTX = 256, DM = 1024, DEPTH = 2, DG = 256, DIN = 3600, NZ = 3584, DFF = 4096;
constexpr int MCTX = NB * TCTX, MLAT = NB * TLAT, MALL = MCTX + MLAT;
constexpr int TSEQ = TCTX + TLAT;
constexpr float EPS = 1e-6f;
constexpr int ZC_HQ = 0, ZC_HI = 256, ZC_HG = 512, ZC_HF = 768, ZC_RQ = 1280, ZC_RK = 1536, ZC_RV = 1792, ZC_RG = 2048, ZC_GQKV = 2304, ZC_GG = 3072, ZC_SU = 3328;

constexpr size_t SZ_WIN = (size_t)NZ * DM * 2, SZ_WOUT = (size_t)DM * DM * 2, SZ_W1 = (size_t)DFF * DM * 2, SZ_W2 = (size_t)DM * DFF * 2, SZ_GLU = (size_t)DG * DG * 2, SZ_WAB = 16 * DM * 4;
constexpr size_t SZ_WL = SZ_WIN + SZ_WOUT + SZ_W1 + SZ_W2 + SZ_GLU + SZ_WAB;
constexpr size_t WS_W = 0;
constexpr size_t WS_MOD = WS_W + 2 * SZ_WL;
constexpr size_t WS_ROPE = WS_MOD + (size_t)2 * 9 * 6144 * 4;
constexpr size_t WS_LB = WS_ROPE + (size_t)TSEQ * 32 * 2 * 4;
constexpr size_t WS_S5P = WS_LB + 4096;
constexpr size_t WS_XC = WS_S5P + (size_t)2 * 2 * 16 * 64 * 34 * 4;
constexpr size_t WS_AB = WS_XC + (size_t)MCTX * DM * 4;
constexpr size_t WS_HB = WS_AB + (size_t)MALL * 16 * 4;
constexpr size_t WS_Z = WS_HB + (size_t)MALL * DM * 2;
constexpr size_t WS_OF = WS_Z + (size_t)MALL * NZ * 2;
constexpr size_t WS_OB = WS_OF + (size_t)MALL * DM * 2;
constexpr size_t WS_END = WS_OB + (size_t)MALL * DM * 2;
constexpr size_t WS_CTL = WS_END;
constexpr size_t CTL_BYTES = 16384;
constexpr size_t WS_TOTAL = WS_CTL + CTL_BYTES;
constexpr size_t WS_U = WS_Z;
static_assert(WS_U + (size_t)MALL * DFF * 2 <= WS_END, "U overlay");
static_assert(WS_MOD % 256 == 0 && WS_ROPE % 256 == 0 && WS_S5P % 256 == 0 && WS_XC % 256 == 0 && WS_AB % 256 == 0 && WS_HB % 256 == 0 && WS_Z % 256 == 0 && WS_OF % 256 == 0, "align");

constexpr int LDS_BYTES = 147456;
constexpr int NSP = 11, NPHASE = 2 + 2 * NSP;

struct Params {
    const float* in[30];
    float* out;
    unsigned char* ws;
    int ph_lo, ph_hi;
};
typedef const __attribute__((address_space(4))) Params* KP;
struct TC { int tid, bid, G; };

__device__ __forceinline__ unsigned f2bf(float f) { unsigned u = __builtin_bit_cast(unsigned, f); return (u + 0x7fffu + ((u >> 16) & 1u)) >> 16; }
__device__ __forceinline__ unsigned pk2(float lo, float hi) { return f2bf(lo) | (f2bf(hi) << 16); }
__device__ __forceinline__ float bflo(unsigned w) { return __builtin_bit_cast(float, w << 16); }
__device__ __forceinline__ float bfhi(unsigned w) { return __builtin_bit_cast(float, w & 0xffff0000u); }
__device__ __forceinline__ float wave_sum(float v) {
#pragma unroll
    for (int o = 1; o < 64; o <<= 1) v += __shfl_xor(v, o);
    return v;
}
__device__ __forceinline__ float quad_sum(float x) {
    x += __builtin_bit_cast(float, __builtin_amdgcn_mov_dpp(__builtin_bit_cast(int, x), 0xB1, 0xf, 0xf, true));
    x += __builtin_bit_cast(float, __builtin_amdgcn_mov_dpp(__builtin_bit_cast(int, x), 0x4E, 0xf, 0xf, true));
    return x;
}
__device__ __forceinline__ float sigmoidf_(float x) { return __builtin_amdgcn_rcpf(1.0f + __builtin_amdgcn_exp2f(-1.4426950408889634f * x)); }
__device__ __forceinline__ float siluf_(float x) { return x / (1.0f + __expf(-x)); }
__device__ __forceinline__ float gelu_tanh(float x) { const float u = 0.7978845608028654f * (x + 0.044715f * x * x * x); return 0.5f * x * (1.0f + tanhf(u)); }
__device__ __forceinline__ float reduce16(float (&p)[16], int lane) {
    bool b = (lane & 32) != 0;
#pragma unroll
    for (int i = 0; i < 8; ++i) { const float keep = b ? p[i + 8] : p[i], send = b ? p[i] : p[i + 8]; p[i] = keep + __shfl_xor(send, 32); }
    b = (lane & 16) != 0;
#pragma unroll
    for (int i = 0; i < 4; ++i) { const float keep = b ? p[i + 4] : p[i], send = b ? p[i] : p[i + 4]; p[i] = keep + __shfl_xor(send, 16); }
    b = (lane & 8) != 0;
#pragma unroll
    for (int i = 0; i < 2; ++i) { const float keep = b ? p[i + 2] : p[i], send = b ? p[i] : p[i + 2]; p[i] = keep + __shfl_xor(send, 8); }
    b = (lane & 4) != 0;
    { const float keep = b ? p[1] : p[0], send = b ? p[0] : p[1]; p[0] = keep + __shfl_xor(send, 4); }
    p[0] += __shfl_xor(p[0], 2); p[0] += __shfl_xor(p[0], 1);
    return p[0];
}
__device__ __forceinline__ int seq_row(int b, int d, int j) {
    if (j < TCTX) return b * TCTX + (d ? (TCTX - 1 - j) : j);
    const int t = j - TCTX; return MCTX + b * TLAT + (d ? (TLAT - 1 - t) : t);
}

namespace pg8 {
constexpr int BM = 256, BK = 64, HALF = 128, HTB = HALF * BK * 2, STAGE_BYTES = 8 * HTB, NXCD = 8, WGM = 8;
__host__ __device__ __forceinline__ int lds_byte(int r, int c) { const int st = (r >> 4) * 2 + (c >> 5), rr = r & 15, cc = c & 31, ob = rr * 64 + cc * 2; return st * 1024 + (ob ^ (((ob >> 9) & 1) << 5)); }
__host__ __device__ __forceinline__ void stage_rc(int b, int& R, int& C) { const int st = b / 1024, sb = b % 1024, swz = sb ^ (((sb >> 9) & 1) << 5); R = (st >> 1) * 16 + swz / 64; C = (st & 1) * 32 + (swz % 64) / 2; }
__host__ __device__ __forceinline__ int perm32(int rho) { const int n = rho >> 4, i = rho & 15; return 8 * (i >> 2) + 4 * n + (i & 3); }
struct Unit { int pm, pn; };
struct Gemm { const bf16_t* A; const bf16_t* Bt; int M, N, K, lda; };
struct StaticOrder {
    int nM, nN, nwg, G, c;
    __device__ void init(int M, int N, int G_, int c_) { nM = M / BM; nN = N / BM; nwg = nM * nN; G = G_; c = c_; }
    __device__ bool next(int i, Unit& u) const {
        const long L = (long)i * G + c; if (L >= nwg) return false;
        int wgid = (int)L; { const int q = nwg / NXCD, r = nwg % NXCD, xcd = wgid % NXCD, off = wgid / NXCD; wgid = (xcd < r ? xcd * (q + 1) : r * (q + 1) + (xcd - r) * q) + off; }
        const int nig = WGM * nN, gid = wgid / nig, fm = gid * WGM, gsz = (nM - fm) < WGM ? (nM - fm) : WGM;
        u.pm = fm + ((wgid % nig) % gsz); u.pn = (wgid % nig) / gsz; return true;
    }
};
template <class Epi>
__device__ __forceinline__ void gemm_phase(const TC tc, LAS unsigned char* lds, const Gemm g, const StaticOrder& S, const Epi& E) {
    const int tid = tc.tid, wid = __builtin_amdgcn_readfirstlane(tid >> 6), lane = tid & 63, wr = wid >> 2, wc = wid & 3, fr = lane & 15, fq = lane >> 4;
    const int K = g.K, nt = K / BK, lda = g.lda;
    unsigned voffA[2], voffB[2];
#pragma unroll
    for (int i = 0; i < 2; ++i) { int R, C; stage_rc(tid * 16 + i * 8192, R, C); const int Rb = Epi::PERM ? ((R & ~31) + perm32(R & 31)) : R;
        voffA[i] = (unsigned)(R * lda + C) * 2u; voffB[i] = (unsigned)(Rb * K + C) * 2u; }
    const size_t kstep = (size_t)(BK * 2);
    const size_t hstepA = (size_t)HALF * lda * 2, hstepB = (size_t)HALF * K * 2;
    const size_t tstepA = 2 * hstepA, tstepB = 2 * hstepB;
    const unsigned ldsw = (unsigned)wid * 1024u;
    const int aoff = lds_byte(wr * 64 + fr, fq * 8), boff = lds_byte(wc * 32 + fr, fq * 8);
#define PG8_SA(b, h) (((b) * 2 + (h)) * HTB)
#define PG8_SB(b, h) ((4 + (b) * 2 + (h)) * HTB)
#define PG8_STAGE(bufoff, gbase, voff) do { _Pragma("unroll") for (int _i = 0; _i < 2; ++_i) \
        __builtin_amdgcn_global_load_lds((const unsigned*)((const char*)(gbase) + (voff)[_i]), (LAS unsigned*)(lds + (bufoff) + ldsw + _i * 8192), 16, 0, 0); } while (0)
#define PG8_LDA(dst, b, h) do { _Pragma("unroll") for (int m = 0; m < 4; ++m) _Pragma("unroll") for (int k = 0; k < 2; ++k) dst[m][k] = *(const LAS bf16x8*)(lds + PG8_SA(b, h) + aoff + m * 2048 + k * 1024); } while (0)
#define PG8_LDB(dst, b, h) do { _Pragma("unroll") for (int n = 0; n < 2; ++n) _Pragma("unroll") for (int k = 0; k < 2; ++k) dst[n][k] = *(const LAS bf16x8*)(lds + PG8_SB(b, h) + boff + n * 2048 + k * 1024); } while (0)
#define PG8_MMA(ai, bj, At, Bt) do { __builtin_amdgcn_s_setprio(1); _Pragma("unroll") for (int m = 0; m < 4; ++m) _Pragma("unroll") for (int n = 0; n < 2; ++n) _Pragma("unroll") for (int k = 0; k < 2; ++k) \
        acc[ai][bj][m][n] = __builtin_amdgcn_mfma_f32_16x16x32_bf16(Bt[n][k], At[m][k], acc[ai][bj][m][n], 0, 0, 0); __builtin_amdgcn_s_setprio(0); } while (0)
#define PG8_WAIT_V(n) asm volatile("s_waitcnt vmcnt(" #n ")" ::: "memory")
#define PG8_WAIT_L(n) asm volatile("s_waitcnt lgkmcnt(" #n ")" ::: "memory")
#define PG8_BAR __builtin_amdgcn_s_barrier()
#define PG8_SCHED __builtin_amdgcn_sched_barrier(0)
    Unit cur, nxt; int ui = 0;
    if (!S.next(0, cur)) return;
    f32x4 acc[2][2][4][2];
#pragma unroll
    for (int a = 0; a < 2; ++a)
#pragma unroll
        for (int b = 0; b < 2; ++b)
#pragma unroll
            for (int m = 0; m < 4; ++m)
#pragma unroll
                for (int n = 0; n < 2; ++n) acc[a][b][m][n] = (f32x4){0.f, 0.f, 0.f, 0.f};
    bf16x8 At[4][2], B0[2][2], B1[2][2];
    const char* cA = (const char*)g.A + (size_t)cur.pm * tstepA; const char* cB = (const char*)g.Bt + (size_t)cur.pn * tstepB;
    PG8_STAGE(PG8_SB(0, 0), cB, voffB); PG8_STAGE(PG8_SB(0, 1), cB + hstepB, voffB); PG8_STAGE(PG8_SA(0, 0), cA, voffA); PG8_STAGE(PG8_SA(0, 1), cA + hstepA, voffA);
    if (wr == 1) PG8_BAR;
    PG8_WAIT_V(2); PG8_BAR;
    PG8_STAGE(PG8_SB(1, 0), cB + kstep, voffB); PG8_STAGE(PG8_SA(1, 0), cA + kstep, voffA); PG8_STAGE(PG8_SB(1, 1), cB + hstepB + kstep, voffB);
    PG8_WAIT_V(6); PG8_BAR;
    for (;;) {
        const bool has_next = S.next(ui + 1, nxt);
        const char* nA = has_next ? (const char*)g.A + (size_t)nxt.pm * tstepA : cA; const char* nB = has_next ? (const char*)g.Bt + (size_t)nxt.pn * tstepB : cB;
        for (int t = 0; t < nt; t += 2) {
            const bool last = (t == nt - 2);
            const char* a1 = cA + (size_t)(t + 1) * kstep;
            const char* a2 = last ? nA : cA + (size_t)(t + 2) * kstep; const char* b2 = last ? nB : cB + (size_t)(t + 2) * kstep;
            const char* a3 = a2 + kstep; const char* b3 = b2 + kstep;
            PG8_LDB(B0, 0, 0); PG8_LDB(B1, 0, 1); PG8_SCHED; PG8_LDA(At, 0, 0); PG8_STAGE(PG8_SA(1, 1), a1 + hstepA, voffA);
            PG8_WAIT_V(8); PG8_WAIT_L(0); PG8_BAR; PG8_MMA(0, 0, At, B0); PG8_MMA(0, 1, At, B1); PG8_BAR; PG8_SCHED;
            PG8_LDA(At, 0, 1); PG8_STAGE(PG8_SB(0, 0), b2, voffB); PG8_STAGE(PG8_SB(0, 1), b2 + hstepB, voffB); PG8_STAGE(PG8_SA(0, 0), a2, voffA);
            PG8_WAIT_V(8); PG8_WAIT_L(0); PG8_BAR; PG8_MMA(1, 0, At, B0); PG8_MMA(1, 1, At, B1); PG8_BAR; PG8_SCHED;
            PG8_LDB(B0, 1, 0); PG8_LDB(B1, 1, 1); PG8_SCHED; PG8_LDA(At, 1, 0); PG8_STAGE(PG8_SA(0, 1), a2 + hstepA, voffA);
            PG8_WAIT_V(8); PG8_WAIT_L(0); PG8_BAR; PG8_MMA(0, 0, At, B0); PG8_MMA(0, 1, At, B1); PG8_BAR; PG8_SCHED;
            PG8_LDA(At, 1, 1); PG8_STAGE(PG8_SB(1, 0), b3, voffB); PG8_STAGE(PG8_SB(1, 1), b3 + hstepB, voffB); PG8_STAGE(PG8_SA(1, 0), a3, voffA);
            PG8_WAIT_V(8); PG8_WAIT_L(0); PG8_BAR; PG8_MMA(1, 0, At, B0); PG8_MMA(1, 1, At, B1); PG8_BAR; PG8_SCHED;
        }
        if (wr == 0) PG8_BAR;
        E(acc, cur, wr, wc, fr, fq);
        if (!has_next) break;
#pragma unroll
        for (int a = 0; a < 2; ++a)
#pragma unroll
            for (int b = 0; b < 2; ++b)
#pragma unroll
                for (int m = 0; m < 4; ++m)
#pragma unroll
                    for (int n = 0; n < 2; ++n) acc[a][b][m][n] = (f32x4){0.f, 0.f, 0.f, 0.f};
        cur = nxt; cA = nA; cB = nB; ++ui;
        if (wr == 1) PG8_BAR;
    }
    PG8_WAIT_V(0);
    PG8_BAR;
#undef PG8_SA
#undef PG8_SB
#undef PG8_STAGE
#undef PG8_LDA
#undef PG8_LDB
#undef PG8_MMA
#undef PG8_WAIT_V
#undef PG8_WAIT_L
#undef PG8_BAR
#undef PG8_SCHED
}

template <int ACT> struct EpiBf {
    static constexpr bool PERM = true;
    bf16_t* O; int ldc;
    __device__ __forceinline__ void operator()(const f32x4 (&acc)[2][2][4][2], const Unit& u, int wr, int wc, int fr, int fq) const {
        const int row0 = u.pm * BM + wr * 64 + fr, col0 = u.pn * BM + wc * 32 + 8 * fq;
#pragma unroll
        for (int ai = 0; ai < 2; ++ai)
#pragma unroll
            for (int m = 0; m < 4; ++m) { bf16_t* rowp = O + (size_t)(row0 + ai * HALF + m * 16) * ldc + col0;
#pragma unroll
                for (int bj = 0; bj < 2; ++bj) { f32x4 v0 = acc[ai][bj][m][0], v1 = acc[ai][bj][m][1];
                    if (ACT == 1) {
#pragma unroll
                        for (int e = 0; e < 4; ++e) { const float a = fmaxf(v0[e], 0.f), b = fmaxf(v1[e], 0.f); v0[e] = a * a; v1[e] = b * b; } }
                    u32x4 w; w.x = pk2(v0[0], v0[1]); w.y = pk2(v0[2], v0[3]); w.z = pk2(v1[0], v1[1]); w.w = pk2(v1[2], v1[3]);
                    *(u32x4*)(rowp + bj * HALF) = w; } }
    }
};
struct EpiRes {
    static constexpr bool PERM = false;
    const float* in_lat; const float* in_ctx; float* out_lat; float* out_ctx; const float* gate; int pm_off;
    __device__ __forceinline__ void operator()(const f32x4 (&acc)[2][2][4][2], const Unit& u, int wr, int wc, int fr, int fq) const {
        const int gpm = u.pm + pm_off;
        const float* rin; float* rout; int v;
        if (gpm < 8) { rin = in_ctx + (size_t)gpm * 256 * DM; rout = out_ctx + (size_t)gpm * 256 * DM; v = 8; }
        else { rin = in_lat + (size_t)(gpm - 8) * 256 * DM; rout = out_lat + (size_t)(gpm - 8) * 256 * DM; v = (gpm - 8) >> 4; }
        const int col0 = u.pn * BM + wc * 32 + 4 * fq;
        const float* gp = gate + (size_t)v * 6144 + col0;
        f32x4 gv[2][2];
#pragma unroll
        for (int bj = 0; bj < 2; ++bj)
#pragma unroll
            for (int n = 0; n < 2; ++n) gv[bj][n] = *(const f32x4*)(gp + bj * HALF + n * 16);
#pragma unroll
        for (int ai = 0; ai < 2; ++ai)
#pragma unroll
            for (int m = 0; m < 4; ++m) { const size_t off = (size_t)(ai * HALF + wr * 64 + m * 16 + fr) * DM + col0;
#pragma unroll
                for (int bj = 0; bj < 2; ++bj)
#pragma unroll
                    for (int n = 0; n < 2; ++n) { const f32x4 x = *(const f32x4*)(rin + off + bj * HALF + n * 16); *(f32x4*)(rout + off + bj * HALF + n * 16) = x + gv[bj][n] * acc[ai][bj][m][n]; }
                asm volatile("" ::: "memory"); }
    }
};
}

__device__ __forceinline__ void transpose_item(const float* W, int ldw, int c0, int K, bf16_t* WT, int nblk, LAS float* scr, int item, int lane) {
    const int kb = item / nblk, nb = item % nblk, k0 = 64 * kb, n0 = 32 * nb;
#pragma unroll 8
    for (int i = 0; i < 32; ++i) { const int kk = 2 * i + (lane >> 5); scr[kk * 33 + (lane & 31)] = W[(size_t)(k0 + kk) * ldw + c0 + n0 + (lane & 31)]; }
    asm volatile("s_waitcnt lgkmcnt(0)" ::: "memory");
    const int c = lane & 7;
#pragma unroll
    for (int j = 0; j < 4; ++j) { const int n = (lane >> 3) + 8 * j; const LAS float* s = scr + (8 * c) * 33 + n;
        u32x4 o; o.x = pk2(s[0 * 33], s[1 * 33]); o.y = pk2(s[2 * 33], s[3 * 33]); o.z = pk2(s[4 * 33], s[5 * 33]); o.w = pk2(s[6 * 33], s[7 * 33]);
        *(u32x4*)(WT + (size_t)(n0 + n) * K + k0 + 8 * c) = o; }
    asm volatile("s_waitcnt lgkmcnt(0)" ::: "memory");
}

__device__ __forceinline__ void phase_prologue(const TC tc, KP P, LAS unsigned char* lds) {
    const int tid = tc.tid, lane = tid & 63, wave = tid >> 6;
    const int G = tc.G, gw = tc.bid * 8 + wave, NGW = G * 8;
    unsigned char* ws = P->ws;
    {
        LAS float* scr = (LAS float*)(lds + wave * 8704);
        constexpr int I_IN_A = 16 * 104, I_IN_B = 16 * 8, I_OUT = 16 * 32, I_1 = 16 * 128, I_2 = 64 * 32, I_G = 4 * 8;
        constexpr int I_L = I_IN_A + I_IN_B + I_OUT + I_1 + I_2 + I_G;
        for (int it = gw; it < 2 * I_L; it += NGW) {
            const int l = it / I_L; int r = it % I_L;
            unsigned char* wl = ws + WS_W + (size_t)l * SZ_WL;
            bf16_t* win = (bf16_t*)wl; bf16_t* wout = (bf16_t*)(wl + SZ_WIN); bf16_t* w1 = (bf16_t*)(wl + SZ_WIN + SZ_WOUT); bf16_t* w2 = (bf16_t*)(wl + SZ_WIN + SZ_WOUT + SZ_W1);
            bf16_t* wg = (bf16_t*)(wl + SZ_WIN + SZ_WOUT + SZ_W1 + SZ_W2);
            if (r < I_IN_A) { transpose_item(P->in[8] + (size_t)l * DM * DIN, DIN, 0, DM, win, 104, scr, r, lane); continue; } r -= I_IN_A;
            if (r < I_IN_B) { transpose_item(P->in[8] + (size_t)l * DM * DIN, DIN, 3344, DM, win + (size_t)3328 * DM, 8, scr, r, lane); continue; } r -= I_IN_B;
            if (r < I_OUT) { transpose_item(P->in[26] + (size_t)l * DM * DM, DM, 0, DM, wout, 32, scr, r, lane); continue; } r -= I_OUT;
            if (r < I_1) { transpose_item(P->in[27] + (size_t)l * DM * DFF, DFF, 0, DM, w1, 128, scr, r, lane); continue; } r -= I_1;
            if (r < I_2) { transpose_item(P->in[28] + (size_t)l * DFF * DM, DM, 0, DFF, w2, 32, scr, r, lane); continue; } r -= I_2;
            transpose_item(P->in[24] + (size_t)l * DG * DG, DG, 0, DG, wg, 8, scr, r, lane);
        }
    }
    const int gt = tc.bid * 512 + tid, NGT = G * 512;
    for (int i = gt; i < 2 * 16 * DM; i += NGT) { const int l = i / (16 * DM), c = (i / DM) % 16, k = i % DM;
        ((float*)(ws + WS_W + (size_t)l * SZ_WL + SZ_WL - SZ_WAB))[c * DM + k] = P->in[8][(size_t)l * DM * DIN + (size_t)k * DIN + 3328 + c]; }
    for (int i = gt; i < TSEQ * 32; i += NGT) { const int pos = i >> 5, f = i & 31;
        const float inv = powf(10000.0f, -(float)f / 32.0f); const float ang = (float)pos * inv; float s, c; sincosf(ang, &s, &c);
        ((f32x2*)(ws + WS_ROPE))[i] = (f32x2){c, s}; }
    for (int i = gt; i < 2 * DG; i += NGT) { const float a = P->in[9][i], b = P->in[9][2 * DG + i]; const float mx = fmaxf(a, b), ea = expf(a - mx), eb = expf(b - mx);
        float* lb = (float*)(ws + WS_LB); lb[i] = 0.f; lb[2 * DG + i] = eb / (ea + eb); }
    for (int i = gt; i < 2 * 2 * 16 * 64; i += NGT) { const int p = i & 63, g = (i >> 6) & 15, d = (i >> 10) & 1, l = i >> 11;
        const float lr = P->in[16][i], li = P->in[17][i]; const float dt = expf(P->in[18][(l * 2 + d) * 16 + g]);
        const float mag = expf(lr * dt); float sn, cs; sincosf(li * dt, &sn, &cs); const float ar = mag * cs, ai = mag * sn;
        const float den = lr * lr + li * li, nr = ar - 1.0f, ni = ai; const float fr = (nr * lr + ni * li) / den, fi = (ni * lr - nr * li) / den;
        float* o = (float*)(ws + WS_S5P) + (size_t)i * 34; o[0] = ar; o[1] = ai;
        const float* bre = P->in[19] + ((size_t)(l * 16 + g) * 64 + p) * 16; const float* bim = P->in[20] + ((size_t)(l * 16 + g) * 64 + p) * 16;
        for (int c = 0; c < 16; ++c) { o[2 + c] = fr * bre[c] - fi * bim[c]; o[18 + c] = fr * bim[c] + fi * bre[c]; } }
    __syncthreads();
    {
        LAS float* sc = (LAS float*)lds;
        LAS float* red = (LAS float*)(lds + 36864);
        for (int i = tid; i < 9 * DM; i += 512) { const int v = i >> 10, k = i & 1023; const float x = v < 8 ? P->in[1][v * DM + k] : P->in[3][k]; sc[i] = siluf_(x); }
        __syncthreads();
        for (int item = tc.bid; item < 2 * 96; item += G) {
            const int l = item / 96, cg0 = (item % 96) * 64;
            const int c4 = (tid & 15) * 4, kl = tid >> 4;
            const float* W = P->in[4] + (size_t)l * DM * 6144 + cg0 + c4;
            f32x4 a[9];
#pragma unroll
            for (int v = 0; v < 9; ++v) a[v] = (f32x4){0.f, 0.f, 0.f, 0.f};
            for (int k = kl; k < DM; k += 32) { const f32x4 w = *(const f32x4*)(W + (size_t)k * 6144);
#pragma unroll
                for (int v = 0; v < 9; ++v) a[v] += w * sc[v * DM + k]; }
#pragma unroll
            for (int v = 0; v < 9; ++v) *(LAS f32x4*)(red + kl * 576 + v * 64 + c4) = a[v];
            __syncthreads();
            for (int o = tid; o < 576; o += 512) { float s = 0.f; for (int q = 0; q < 32; ++q) s += red[q * 576 + o];
                const int v = o >> 6, c = cg0 + (o & 63);
                ((float*)(ws + WS_MOD))[((size_t)l * 9 + v) * 6144 + c] = s + P->in[5][l * 6144 + c]; }
            __syncthreads();
        }
    }
}

__device__ __forceinline__ void phase_norm(const TC tc, KP P, LAS unsigned char* lds, int l, int which, const float* src_lat, const float* src_ctx, int r0, bool do_ab) {
    const int tid = tc.tid, lane = tid & 63, wave = tid >> 6;
    const int gw = tc.bid * 8 + wave, NGW = tc.G * 8;
    unsigned char* ws = P->ws;
    LAS float* wab = (LAS float*)lds;
    if (do_ab) { const float* src = (const float*)(ws + WS_W + (size_t)l * SZ_WL + SZ_WL - SZ_WAB);
        for (int i = tid; i < 16 * DM / 4; i += 512) ((LAS f32x4*)wab)[i] = ((const f32x4*)src)[i];
        __syncthreads(); }
    const float* gvec = P->in[which ? 7 : 6] + l * DM;
    const float* mod = (const float*)(ws + WS_MOD) + (size_t)l * 9 * 6144;
    bf16_t* H = (bf16_t*)(ws + WS_HB);
    float* AB = (float*)(ws + WS_AB);
    for (int r = r0 + gw; r < MALL; r += NGW) {
        const float* xrow; int v;
        if (r < MCTX) { xrow = src_ctx + (size_t)r * DM; v = 8; } else { xrow = src_lat + (size_t)(r - MCTX) * DM; v = (r - MCTX) >> 12; }
        const float* sh = mod + (size_t)v * 6144 + (which ? 3 : 0) * DM; const float* scl = mod + (size_t)v * 6144 + (which ? 4 : 1) * DM;
        f32x4 x[4]; float ss = 0.f;
#pragma unroll
        for (int j = 0; j < 4; ++j) { x[j] = ((const f32x4*)xrow)[j * 64 + lane]; ss += (x[j].x * x[j].x + x[j].y * x[j].y) + (x[j].z * x[j].z + x[j].w * x[j].w); }
        const float rstd = rsqrtf(wave_sum(ss) * (1.0f / DM) + EPS);
#pragma unroll
        for (int j = 0; j < 4; ++j) { const f32x4 g = ((const f32x4*)gvec)[j * 64 + lane], s1 = ((const f32x4*)scl)[j * 64 + lane], s0 = ((const f32x4*)sh)[j * 64 + lane];
            x[j] = x[j] * rstd * g * (1.0f + s1) + s0;
            u32x2 w; w.x = pk2(x[j].x, x[j].y); w.y = pk2(x[j].z, x[j].w);
            ((u32x2*)(H + (size_t)r * DM))[j * 64 + lane] = w; }
        if (do_ab) {
#pragma unroll 1
            for (int cq = 0; cq < 4; ++cq) {
                float p[4];
#pragma unroll
                for (int c = 0; c < 4; ++c) { float a = 0.f;
#pragma unroll
                    for (int j = 0; j < 4; ++j) { const f32x4 w = *(const LAS f32x4*)(wab + (cq * 4 + c) * DM + (j * 64 + lane) * 4); a += (x[j].x * w.x + x[j].y * w.y) + (x[j].z * w.z + x[j].w * w.w); }
                    p[c] = a; }
                bool bb = (lane & 32) != 0;
                { const float k0 = bb ? p[2] : p[0], s0 = bb ? p[0] : p[2], k1 = bb ? p[3] : p[1], s1 = bb ? p[1] : p[3]; p[0] = k0 + __shfl_xor(s0, 32); p[1] = k1 + __shfl_xor(s1, 32); }
                bb = (lane & 16) != 0;
                { const float k0 = bb ? p[1] : p[0], s0 = bb ? p[0] : p[1]; p[0] = k0 + __shfl_xor(s0, 16); }
                float tot = p[0];
                tot += __shfl_xor(tot, 8); tot += __shfl_xor(tot, 4); tot += __shfl_xor(tot, 2); tot += __shfl_xor(tot, 1);
                if ((lane & 15) == 0) { const int c = cq * 4 + 2 * ((lane >> 5) & 1) + ((lane >> 4) & 1);
                    float o;
                    if (c < 8) { const int d = c >> 2, h = c & 3; const float xx = tot + P->in[14][(l * 2 + d) * 4 + h]; const float sp = xx > 20.f ? xx : log1pf(expf(xx));
                        o = -expf(P->in[13][(l * 2 + d) * 4 + h]) * sp; }
                    else o = 1.0f / (1.0f + expf(-tot));
                    AB[(size_t)r * 16 + c] = o; }
            }
        }
    }
}

__device__ __forceinline__ void phase_mixpre(const TC tc, KP P, int l) {
    const int tid = tc.tid, lane = tid & 63, wave = tid >> 6;
    const int gw = tc.bid * 8 + wave, NGW = tc.G * 8;
    unsigned char* ws = P->ws;
    bf16_t* Z = (bf16_t*)(ws + WS_Z);
    bf16_t* QC = (bf16_t*)(ws + WS_HB);
    const float* lb = (const float*)(ws + WS_LB) + l * 2 * DG;
    const f32x2* rope = (const f32x2*)(ws + WS_ROPE);
    const float* cw = P->in[12] + (size_t)l * 9 * 768;
    for (int r = gw; r < MALL; r += NGW) {
        bf16_t* zr = Z + (size_t)r * NZ;
        int pos, b, s; bool isctx = r < MCTX;
        if (isctx) { b = r >> 8; s = r & 255; pos = s; } else { b = (r - MCTX) >> 12; s = (r - MCTX) & 4095; pos = TCTX + s; }
        { u32x2 w = ((u32x2*)(zr + ZC_HQ))[lane];
          w.x = pk2(siluf_(bflo(w.x)) * 0.125f, siluf_(bfhi(w.x)) * 0.125f); w.y = pk2(siluf_(bflo(w.y)) * 0.125f, siluf_(bfhi(w.y)) * 0.125f);
          ((u32x2*)(zr + ZC_HQ))[lane] = w; }
        { u32x4 w = ((u32x4*)(zr + ZC_HF))[lane]; const int c0 = lane * 8; unsigned* pw = (unsigned*)&w;
#pragma unroll
          for (int e = 0; e < 4; ++e) { const int c = c0 + 2 * e;
              const float f0 = bflo(pw[e]), f1 = bfhi(pw[e]);
              const float l0 = fmaxf(lb[c], 1e-30f), l1 = fmaxf(lb[c + 1], 1e-30f);
              const float s0 = 1.0f / (1.0f + expf(-f0)), s1 = 1.0f / (1.0f + expf(-f1));
              pw[e] = pk2(logf(l0 * (1.0f - s0) + s0), logf(l1 * (1.0f - s1) + s1)); }
          ((u32x4*)(zr + ZC_HF))[lane] = w; }
        {
#pragma unroll
          for (int qk = 0; qk < 2; ++qk) { bf16_t* base = zr + (qk ? ZC_RK : ZC_RQ) + (lane >> 4) * 64 + (lane & 15) * 2;
              const unsigned w1 = *(const unsigned*)base, w2 = *(const unsigned*)(base + 32);
              const f32x2 cs0 = rope[pos * 32 + (lane & 15) * 2], cs1 = rope[pos * 32 + (lane & 15) * 2 + 1];
              const float sc = qk ? 0.125f : 1.0f;
              const float a0 = bflo(w1), a1 = bfhi(w1), b0 = bflo(w2), b1 = bfhi(w2);
              *(unsigned*)base = pk2((a0 * cs0.x - b0 * cs0.y) * sc, (a1 * cs1.x - b1 * cs1.y) * sc);
              *(unsigned*)(base + 32) = pk2((a0 * cs0.y + b0 * cs0.x) * sc, (a1 * cs1.y + b1 * cs1.x) * sc); } }
        {
            float acc[3][4];
#pragma unroll
            for (int g = 0; g < 3; ++g)
#pragma unroll
                for (int e = 0; e < 4; ++e) acc[g][e] = 0.f;
            const int gx = isctx ? s : (s & 63), gy = isctx ? 0 : (s >> 6), W = isctx ? TCTX : 64, Hh = isctx ? 1 : 64;
#pragma unroll
            for (int dy = 0; dy < 3; ++dy) { const int yy = gy + dy - 1; if (yy < 0 || yy >= Hh) continue;
#pragma unroll
                for (int dx = 0; dx < 3; ++dx) { const int xx = gx + dx - 1; if (xx < 0 || xx >= W) continue;
                    const int rr = r + (dy - 1) * 64 + (dx - 1);
                    const bf16_t* zn = Z + (size_t)rr * NZ + ZC_GQKV + lane * 4; const float* wp = cw + (dy * 3 + dx) * 768 + lane * 4;
#pragma unroll
                    for (int g = 0; g < 3; ++g) { const u32x2 w = *(const u32x2*)(zn + g * 256); const f32x4 k = *(const f32x4*)(wp + g * 256);
                        acc[g][0] += bflo(w.x) * k.x; acc[g][1] += bfhi(w.x) * k.y; acc[g][2] += bflo(w.y) * k.z; acc[g][3] += bfhi(w.y) * k.w; } } }
#pragma unroll
            for (int g = 0; g < 3; ++g) {
#pragma unroll
                for (int e = 0; e < 4; ++e) acc[g][e] = siluf_(acc[g][e]);
                if (g < 2) { float ss = (acc[g][0] * acc[g][0] + acc[g][1] * acc[g][1]) + (acc[g][2] * acc[g][2] + acc[g][3] * acc[g][3]);
                    ss += __shfl_xor(ss, 1); ss += __shfl_xor(ss, 2); ss += __shfl_xor(ss, 4); ss += __shfl_xor(ss, 8);
                    const float rn = rsqrtf(ss + EPS) * (g == 0 ? 0.125f : 1.0f);
#pragma unroll
                    for (int e = 0; e < 4; ++e) acc[g][e] *= rn; }
                u32x2 w; w.x = pk2(acc[g][0], acc[g][1]); w.y = pk2(acc[g][2], acc[g][3]);
                *(u32x2*)(QC + (size_t)r * 768 + g * 256 + lane * 4) = w; }
        }
    }
}

constexpr int TB = 32, NBATCH = TSEQ / TB;
constexpr int CH_ARR = TB * 64 * 4;
constexpr int CH_BUF = 4 * CH_ARR + 256;
constexpr int CH_OS = 2 * CH_BUF;
static_assert(CH_OS + 2 * CH_ARR <= LDS_BYTES, "chain LDS");

template <int KIND>
__device__ __forceinline__ void chain_matrix(const TC tc, KP P, LAS unsigned char* lds, int l, int chain) {
    const int tid = tc.tid, lane = tid & 63, wave = tid >> 6;
    const int b = chain >> 3, h = (chain >> 1) & 3, d = chain & 1;
    unsigned char* ws = P->ws;
    const bf16_t* Z = (const bf16_t*)(ws + WS_Z);
    const bf16_t* QC = (const bf16_t*)(ws + WS_HB);
    const float* AB = (const float*)(ws + WS_AB);
    bf16_t* O = (bf16_t*)(ws + (d ? WS_OB : WS_OF));
    const int ocol = KIND * 256 + h * 64;
    const bool loader = wave >= 4;
    const int lt = tid - 256, ltok = lt >> 3, lseg = lt & 7;
    float gam = 0.f;
    if (KIND == 1) gam = 1.0f / (1.0f + expf(-P->in[11][(l * 2 + d) * 4 + h]));
    auto load = [&](int n, int bi) {
        const int row = seq_row(b, d, n * TB + ltok);
        LAS float* base = (LAS float*)(lds + bi * CH_BUF) + ltok * 64 + lseg * 8;
        u32x4 q, k, v;
        if (KIND == 0) { const bf16_t* zr = Z + (size_t)row * NZ + h * 64 + lseg * 8; q = *(const u32x4*)(zr + ZC_HQ); k = *(const u32x4*)(zr + ZC_HF + d * 256); v = *(const u32x4*)(zr + ZC_HI); }
        else if (KIND == 1) { const bf16_t* zr = Z + (size_t)row * NZ + h * 64 + lseg * 8; q = *(const u32x4*)(zr + ZC_RQ); k = *(const u32x4*)(zr + ZC_RK); v = *(const u32x4*)(zr + ZC_RV); }
        else { const bf16_t* qr = QC + (size_t)row * 768 + h * 64 + lseg * 8; q = *(const u32x4*)qr; k = *(const u32x4*)(qr + 256); v = *(const u32x4*)(qr + 512);
            if (lseg == 0) { LAS float* sc = (LAS float*)(lds + bi * CH_BUF + 4 * CH_ARR); sc[ltok * 2] = expf(AB[(size_t)row * 16 + d * 4 + h]); sc[ltok * 2 + 1] = AB[(size_t)row * 16 + 8 + d * 4 + h]; } }
        const unsigned* pq = (const unsigned*)&q; const unsigned* pk = (const unsigned*)&k; const unsigned* pv = (const unsigned*)&v;
#pragma unroll
        for (int e = 0; e < 4; ++e) {
            base[2 * e] = bflo(pq[e]); base[2 * e + 1] = bfhi(pq[e]);
            base[3 * TB * 64 + 2 * e] = bflo(pv[e]); base[3 * TB * 64 + 2 * e + 1] = bfhi(pv[e]);
            if (KIND == 0) { const float l0 = bflo(pk[e]), l1 = bfhi(pk[e]); const float f0 = expf(l0), f1 = expf(l1);
                base[TB * 64 + 2 * e] = f0; base[TB * 64 + 2 * e + 1] = f1; base[2 * TB * 64 + 2 * e] = -expm1f(l0); base[2 * TB * 64 + 2 * e + 1] = -expm1f(l1); }
            else { base[TB * 64 + 2 * e] = bflo(pk[e]); base[TB * 64 + 2 * e + 1] = bfhi(pk[e]); }
        }
    };
    auto store = [&](int n, int bi) {
        const int row = seq_row(b, d, n * TB + ltok);
        const LAS float* os = (const LAS float*)(lds + CH_OS + bi * CH_ARR) + ltok * 64 + lseg * 8;
        u32x4 w; w.x = pk2(os[0], os[1]); w.y = pk2(os[2], os[3]); w.z = pk2(os[4], os[5]); w.w = pk2(os[6], os[7]);
        *(u32x4*)(O + (size_t)row * DM + ocol + lseg * 8) = w;
    };
    float S[16];
#pragma unroll
    for (int i = 0; i < 16; ++i) S[i] = 0.f;
    const int vl = lane >> 2, kg = lane & 3, vcol = (wave & 3) * 16 + vl;
    if (loader) load(0, 0);
    __syncthreads();
    for (int n = 0; n < NBATCH; ++n) {
        if (loader) { if (n + 1 < NBATCH) load(n + 1, (n + 1) & 1); if (n >= 1) store(n - 1, (n - 1) & 1); }
        else {
            const LAS float* A0 = (const LAS float*)(lds + (n & 1) * CH_BUF);
            const LAS float* sc = (const LAS float*)(lds + (n & 1) * CH_BUF + 4 * CH_ARR);
            LAS float* os = (LAS float*)(lds + CH_OS + (n & 1) * CH_ARR);
#pragma unroll 2
            for (int tt = 0; tt < TB; ++tt) {
                const LAS float* a = A0 + tt * 64 + kg * 16;
                float q[16], k[16];
#pragma unroll
                for (int i = 0; i < 4; ++i) { const f32x4 t4 = *(const LAS f32x4*)(a + 4 * i); q[4 * i] = t4.x; q[4 * i + 1] = t4.y; q[4 * i + 2] = t4.z; q[4 * i + 3] = t4.w; }
#pragma unroll
                for (int i = 0; i < 4; ++i) { const f32x4 t4 = *(const LAS f32x4*)(a + TB * 64 + 4 * i); k[4 * i] = t4.x; k[4 * i + 1] = t4.y; k[4 * i + 2] = t4.z; k[4 * i + 3] = t4.w; }
                const float vv = A0[3 * TB * 64 + tt * 64 + vcol];
                float o = 0.f;
                if (KIND == 0) {
                    float kk[16];
#pragma unroll
                    for (int i = 0; i < 4; ++i) { const f32x4 t4 = *(const LAS f32x4*)(a + 2 * TB * 64 + 4 * i); kk[4 * i] = t4.x; kk[4 * i + 1] = t4.y; kk[4 * i + 2] = t4.z; kk[4 * i + 3] = t4.w; }
#pragma unroll
                    for (int i = 0; i < 16; ++i) { S[i] = k[i] * S[i] + kk[i] * vv; o += q[i] * S[i]; }
                } else if (KIND == 1) {
#pragma unroll
                    for (int i = 0; i < 16; ++i) { S[i] = gam * S[i] + k[i] * vv; o += q[i] * S[i]; }
                } else {
                    const float alpha = sc[tt * 2], beta = sc[tt * 2 + 1];
                    float r = 0.f;
#pragma unroll
                    for (int i = 0; i < 16; ++i) r += k[i] * S[i];
                    r = quad_sum(r);
                    const float c = beta * (vv - alpha * r);
#pragma unroll
                    for (int i = 0; i < 16; ++i) { S[i] = alpha * S[i] + k[i] * c; o += q[i] * S[i]; }
                }
                o = quad_sum(o);
                if (kg == 0) os[tt * 64 + vcol] = o;
            }
        }
        __syncthreads();
    }
    if (loader) store(NBATCH - 1, (NBATCH - 1) & 1);
    __syncthreads();
}

constexpr int S5_US = 0, S5_YS = 2 * 4 * TB * 16 * 4;
__device__ __forceinline__ void chain_s5(const TC tc, KP P, LAS unsigned char* lds, int l, int item) {
    const int tid = tc.tid, lane = tid & 63, wave = tid >> 6;
    const int b = item >> 3, d = (item >> 2) & 1, gq = item & 3;
    unsigned char* ws = P->ws;
    const bf16_t* Z = (const bf16_t*)(ws + WS_Z);
    bf16_t* O = (bf16_t*)(ws + (d ? WS_OB : WS_OF));
    const bool loader = wave >= 4;
    const int lt = tid - 256, lch = lt >> 6, ltok = (lt >> 1) & 31, lhalf = lt & 1;
    auto load = [&](int n, int bi) {
        const int row = seq_row(b, d, n * TB + ltok);
        const u32x4 u = *(const u32x4*)(Z + (size_t)row * NZ + ZC_SU + gq * 64 + lch * 16 + lhalf * 8);
        LAS float* us = (LAS float*)(lds + S5_US) + ((bi * 4 + lch) * TB + ltok) * 16 + lhalf * 8; const unsigned* pu = (const unsigned*)&u;
#pragma unroll
        for (int e = 0; e < 4; ++e) { us[2 * e] = bflo(pu[e]); us[2 * e + 1] = bfhi(pu[e]); }
    };
    auto store = [&](int n, int bi) {
        const int row = seq_row(b, d, n * TB + ltok);
        const LAS float* ys = (const LAS float*)(lds + S5_YS) + ((bi * 4 + lch) * TB + ltok) * 16 + lhalf * 8;
        u32x4 w; w.x = pk2(ys[0], ys[1]); w.y = pk2(ys[2], ys[3]); w.z = pk2(ys[4], ys[5]); w.w = pk2(ys[6], ys[7]);
        *(u32x4*)(O + (size_t)row * DM + 768 + gq * 64 + lch * 16 + lhalf * 8) = w;
    };
    float bre[16], bim[16], cre[16], cim[16], ar = 0.f, ai = 0.f, hr = 0.f, hi = 0.f;
    if (!loader) {
        const int g = gq * 4 + wave;
        const float* sp = (const float*)(ws + WS_S5P) + ((size_t)((l * 2 + d) * 16 + g) * 64 + lane) * 34;
        ar = sp[0]; ai = sp[1];
#pragma unroll
        for (int c = 0; c < 16; ++c) { bre[c] = sp[2 + c]; bim[c] = sp[18 + c];
            cre[c] = P->in[21][((size_t)(l * 16 + g) * 16 + c) * 64 + lane]; cim[c] = P->in[22][((size_t)(l * 16 + g) * 16 + c) * 64 + lane]; }
    }
    if (loader) load(0, 0);
    __syncthreads();
    for (int n = 0; n < NBATCH; ++n) {
        if (loader) { if (n + 1 < NBATCH) load(n + 1, (n + 1) & 1); if (n >= 1) store(n - 1, (n - 1) & 1); }
        else {
            const LAS float* us = (const LAS float*)(lds + S5_US) + (((n & 1) * 4 + wave) * TB) * 16;
            LAS float* ys = (LAS float*)(lds + S5_YS) + (((n & 1) * 4 + wave) * TB) * 16;
            for (int tt = 0; tt < TB; ++tt) {
                float u[16];
#pragma unroll
                for (int i = 0; i < 4; ++i) { const f32x4 t4 = *(const LAS f32x4*)(us + tt * 16 + 4 * i); u[4 * i] = t4.x; u[4 * i + 1] = t4.y; u[4 * i + 2] = t4.z; u[4 * i + 3] = t4.w; }
                float xr = 0.f, xi = 0.f;
#pragma unroll
                for (int c = 0; c < 16; ++c) { xr += bre[c] * u[c]; xi += bim[c] * u[c]; }
                const float nhr = ar * hr - ai * hi + xr, nhi = ar * hi + ai * hr + xi; hr = nhr; hi = nhi;
                float p[16];
#pragma unroll
                for (int c = 0; c < 16; ++c) p[c] = cre[c] * hr - cim[c] * hi;
                const float tot = reduce16(p, lane);
                if ((lane & 3) == 0) { const int c = 8 * ((lane >> 5) & 1) + 4 * ((lane >> 4) & 1) + 2 * ((lane >> 3) & 1) + ((lane >> 2) & 1); ys[tt * 16 + c] = tot; }
            }
        }
        __syncthreads();
    }
    if (loader) store(NBATCH - 1, (NBATCH - 1) & 1);
    __syncthreads();
}

namespace mx {
constexpr int PITCH = 144, IMG = 64 * PITCH;
__device__ __forceinline__ bf16x8 frag(const LAS unsigned char* img, int t, int ks, int fr, int fq) { return *(const LAS bf16x8*)(img + (t * 16 + fr) * PITCH + (ks * 32 + fq * 8) * 2); }
__device__ __forceinline__ void store4(LAS unsigned char* img, int row, int col0, float a, float b, float c, float d) { u32x2 w; w.x = pk2(a, b); w.y = pk2(c, d); *(LAS u32x2*)(img + row * PITCH + col0 * 2) = w; }
__device__ __forceinline__ float bfe(const u32x2& w, int e) { return e == 0 ? bflo(w.x) : e == 1 ? bfhi(w.x) : e == 2 ? bflo(w.y) : bfhi(w.y); }
__device__ __forceinline__ unsigned rawe(const u32x2& w, int e) { return e == 0 ? (w.x & 0xffffu) : e == 1 ? (w.x >> 16) : e == 2 ? (w.y & 0xffffu) : (w.y >> 16); }
__device__ __forceinline__ void tile10(int idx, int& mt, int& nt) { nt = idx >= 6 ? 3 : idx >= 3 ? 2 : idx >= 1 ? 1 : 0; mt = idx - (nt * (nt + 1)) / 2; }
}
#define MFMA16(a, b, c) __builtin_amdgcn_mfma_f32_16x16x32_bf16(a, b, c, 0, 0, 0)

__device__ __forceinline__ void lin_attn_os(const LAS unsigned char* Qg, const LAS unsigned char* VT, const LAS unsigned char* Pm, const LAS unsigned char* KdT, const LAS unsigned char* STc, LAS unsigned char* STn,
                                           f32x4& S0, f32x4& S1, const f32x4 dec, bf16_t* Og, int b, int d, int p, int ocol, int wave, int fr, int fq) {
    const int mt = wave & 3;
#pragma unroll
    for (int hh = 0; hh < 2; ++hh) {
        const int nt = (wave >> 2) + 2 * hh;
        f32x4 acc = (f32x4){0.f, 0.f, 0.f, 0.f};
        acc = MFMA16(mx::frag(VT, mt, 0, fr, fq), mx::frag(Pm, nt, 0, fr, fq), acc);
        if (nt >= 2) acc = MFMA16(mx::frag(VT, mt, 1, fr, fq), mx::frag(Pm, nt, 1, fr, fq), acc);
        acc = MFMA16(mx::frag(STc, mt, 0, fr, fq), mx::frag(Qg, nt, 0, fr, fq), acc);
        acc = MFMA16(mx::frag(STc, mt, 1, fr, fq), mx::frag(Qg, nt, 1, fr, fq), acc);
        { const int row = seq_row(b, d, p * 64 + nt * 16 + fr); u32x2 w; w.x = pk2(acc[0], acc[1]); w.y = pk2(acc[2], acc[3]);
          *(u32x2*)(Og + (size_t)row * DM + ocol + mt * 16 + fq * 4) = w; }
        f32x4 sn = (hh == 0 ? S0 : S1) * dec;
        sn = MFMA16(mx::frag(KdT, mt, 0, fr, fq), mx::frag(VT, nt, 0, fr, fq), sn);
        sn = MFMA16(mx::frag(KdT, mt, 1, fr, fq), mx::frag(VT, nt, 1, fr, fq), sn);
        if (hh == 0) S0 = sn; else S1 = sn;
        mx::store4(STn, nt * 16 + fr, mt * 16 + fq * 4, sn[0], sn[1], sn[2], sn[3]);
    }
}

__device__ __forceinline__ void chain_ret(const TC tc, KP P, LAS unsigned char* lds, int l, int chain) {
    const int tid = tc.tid, lane = tid & 63, wave = __builtin_amdgcn_readfirstlane(tid >> 6), fr = lane & 15, fq = lane >> 4;
    const int b = chain >> 3, h = (chain >> 1) & 3, d = chain & 1;
    unsigned char* ws = P->ws;
    const bf16_t* Z = (const bf16_t*)(ws + WS_Z);
    bf16_t* Og = (bf16_t*)(ws + (d ? WS_OB : WS_OF));
    const int ocol = 256 + h * 64;
    const float gam = 1.0f / (1.0f + expf(-P->in[11][(l * 2 + d) * 4 + h])), lg2 = log2f(gam);
    LAS unsigned char* Qn = lds; LAS unsigned char* Kn = lds + mx::IMG; LAS unsigned char* Qg = lds + 2 * mx::IMG; LAS unsigned char* VT = lds + 3 * mx::IMG; LAS unsigned char* KdT = lds + 4 * mx::IMG;
    LAS unsigned char* Pm = lds + 5 * mx::IMG; LAS unsigned char* ST = lds + 6 * mx::IMG;
    for (int i = tid; i < 3 * mx::IMG / 16; i += 512) *(LAS u32x4*)(Pm + i * 16) = (u32x4){0u, 0u, 0u, 0u};
    f32x4 S0 = (f32x4){0.f, 0.f, 0.f, 0.f}, S1 = S0;
    const f32x4 dec = (f32x4){1.f, 1.f, 1.f, 1.f} * exp2f(64.0f * lg2);
    const int tok = tid >> 3, seg = tid & 7, tp = tid & 31, fs = tid >> 5;
    u32x4 rq, rk; u32x2 rv0, rv1, rk0, rk1;
    auto fetch = [&](int p) {
        const bf16_t* zr = Z + (size_t)seq_row(b, d, p * 64 + tok) * NZ + h * 64 + seg * 8;
        rq = *(const u32x4*)(zr + ZC_RQ); rk = *(const u32x4*)(zr + ZC_RK);
        const bf16_t* z0 = Z + (size_t)seq_row(b, d, p * 64 + 2 * tp) * NZ + h * 64 + fs * 4; const bf16_t* z1 = Z + (size_t)seq_row(b, d, p * 64 + 2 * tp + 1) * NZ + h * 64 + fs * 4;
        rv0 = *(const u32x2*)(z0 + ZC_RV); rv1 = *(const u32x2*)(z1 + ZC_RV); rk0 = *(const u32x2*)(z0 + ZC_RK); rk1 = *(const u32x2*)(z1 + ZC_RK);
    };
    fetch(0);
    __syncthreads();
    for (int p = 0; p < 68; ++p) {
        { *(LAS u32x4*)(Qn + tok * mx::PITCH + seg * 16) = rq; *(LAS u32x4*)(Kn + tok * mx::PITCH + seg * 16) = rk;
          const float sc = exp2f((float)(tok + 1) * lg2); u32x4 g;
          g.x = pk2(bflo(rq.x) * sc, bfhi(rq.x) * sc); g.y = pk2(bflo(rq.y) * sc, bfhi(rq.y) * sc); g.z = pk2(bflo(rq.z) * sc, bfhi(rq.z) * sc); g.w = pk2(bflo(rq.w) * sc, bfhi(rq.w) * sc);
          *(LAS u32x4*)(Qg + tok * mx::PITCH + seg * 16) = g;
          const float s0 = exp2f((float)(63 - 2 * tp) * lg2), s1 = exp2f((float)(62 - 2 * tp) * lg2);
#pragma unroll
          for (int e = 0; e < 4; ++e) { const int f = fs * 4 + e;
              *(LAS unsigned*)(VT + f * mx::PITCH + tp * 4) = mx::rawe(rv0, e) | (mx::rawe(rv1, e) << 16);
              *(LAS unsigned*)(KdT + f * mx::PITCH + tp * 4) = pk2(mx::bfe(rk0, e) * s0, mx::bfe(rk1, e) * s1); } }
        __syncthreads();
        if (p + 1 < 68) fetch(p + 1);
#pragma unroll
        for (int hh = 0; hh < 2; ++hh) { const int idx = wave + 8 * hh; if (idx < 10) { int mt, nt; mx::tile10(idx, mt, nt);
            f32x4 acc = (f32x4){0.f, 0.f, 0.f, 0.f};
            acc = MFMA16(mx::frag(Kn, mt, 0, fr, fq), mx::frag(Qn, nt, 0, fr, fq), acc); acc = MFMA16(mx::frag(Kn, mt, 1, fr, fq), mx::frag(Qn, nt, 1, fr, fq), acc);
            const int e0 = 16 * (nt - mt) + fr - 4 * fq;
            float v[4];
#pragma unroll
            for (int r = 0; r < 4; ++r) { const int e = e0 - r; v[r] = e >= 0 ? acc[r] * exp2f((float)e * lg2) : 0.f; }
            mx::store4(Pm, nt * 16 + fr, mt * 16 + fq * 4, v[0], v[1], v[2], v[3]); } }
        __syncthreads();
        lin_attn_os(Qg, VT, Pm, KdT, ST + (p & 1) * mx::IMG, ST + ((p + 1) & 1) * mx::IMG, S0, S1, dec, Og, b, d, p, ocol, wave, fr, fq);
        __syncthreads();
    }
}

__device__ __forceinline__ void chain_hgrn(const TC tc, KP P, LAS unsigned char* lds, int l, int chain) {
    const int tid = tc.tid, lane = tid & 63, wave = __builtin_amdgcn_readfirstlane(tid >> 6), fr = lane & 15, fq = lane >> 4;
    const int b = chain >> 3, h = (chain >> 1) & 3, d = chain & 1;
    unsigned char* ws = P->ws;
    const bf16_t* Z = (const bf16_t*)(ws + WS_Z);
    bf16_t* Og = (bf16_t*)(ws + (d ? WS_OB : WS_OF));
    const int ocol = h * 64;
    LAS unsigned char* Qa = lds; LAS unsigned char* Qg = lds + mx::IMG; LAS unsigned char* KdT = lds + 2 * mx::IMG; LAS unsigned char* VT = lds + 3 * mx::IMG; LAS unsigned char* Pm = lds + 4 * mx::IMG;
    LAS unsigned char* ST = lds + 5 * mx::IMG; LAS unsigned char* Kr = lds + 7 * mx::IMG;
    LAS float* Bf = (LAS float*)(lds + 11 * mx::IMG);
    LAS float* tot = (LAS float*)(lds + 11 * mx::IMG + 16384);
    for (int i = tid; i < 3 * mx::IMG / 16; i += 512) *(LAS u32x4*)(Pm + i * 16) = (u32x4){0u, 0u, 0u, 0u};
    f32x4 S0 = (f32x4){0.f, 0.f, 0.f, 0.f}, S1 = S0;
    const int tok = tid >> 3, seg = tid & 7, tp = tid & 31, fs = tid >> 5, ck = tid & 63, sg = tid >> 6;
    const int zf = ZC_HF + d * 256 + h * 64;
    u32x4 rq, rl; u32x2 rv0, rv1, rl0, rl1; unsigned short rc[8];
    auto fetch = [&](int p) {
        const bf16_t* zr = Z + (size_t)seq_row(b, d, p * 64 + tok) * NZ + seg * 8;
        rq = *(const u32x4*)(zr + ZC_HQ + h * 64); rl = *(const u32x4*)(zr + zf);
        const bf16_t* z0 = Z + (size_t)seq_row(b, d, p * 64 + 2 * tp) * NZ + fs * 4; const bf16_t* z1 = Z + (size_t)seq_row(b, d, p * 64 + 2 * tp + 1) * NZ + fs * 4;
        rv0 = *(const u32x2*)(z0 + ZC_HI + h * 64); rv1 = *(const u32x2*)(z1 + ZC_HI + h * 64); rl0 = *(const u32x2*)(z0 + zf); rl1 = *(const u32x2*)(z1 + zf);
#pragma unroll
        for (int e = 0; e < 8; ++e) rc[e] = Z[(size_t)seq_row(b, d, p * 64 + sg * 8 + e) * NZ + zf + ck];
    };
    fetch(0);
    __syncthreads();
    for (int p = 0; p < 68; ++p) {
        float c[8];
        { float a = 0.f;
#pragma unroll
          for (int e = 0; e < 8; ++e) { a += __builtin_bit_cast(float, (unsigned)rc[e] << 16); c[e] = a; }
          tot[sg * 64 + ck] = a; }
        __syncthreads();
        { float off = 0.f;
#pragma unroll
          for (int s2 = 0; s2 < 7; ++s2) off += (s2 < sg) ? tot[s2 * 64 + ck] : 0.f;
#pragma unroll
          for (int e = 0; e < 8; ++e) Bf[(sg * 8 + e) * 64 + ck] = c[e] + off; }
        __syncthreads();
        { const int a = tok >> 4;
          float q[8], lf[8], bb[8];
          { const unsigned* pq = (const unsigned*)&rq; const unsigned* pl = (const unsigned*)&rl;
#pragma unroll
            for (int e = 0; e < 4; ++e) { q[2 * e] = bflo(pq[e]); q[2 * e + 1] = bfhi(pq[e]); lf[2 * e] = bflo(pl[e]); lf[2 * e + 1] = bfhi(pl[e]); } }
          { const f32x4 b0 = *(const LAS f32x4*)(Bf + tok * 64 + seg * 8), b1 = *(const LAS f32x4*)(Bf + tok * 64 + seg * 8 + 4);
            bb[0] = b0[0]; bb[1] = b0[1]; bb[2] = b0[2]; bb[3] = b0[3]; bb[4] = b1[0]; bb[5] = b1[1]; bb[6] = b1[2]; bb[7] = b1[3]; }
          float o[8];
#pragma unroll
          for (int e = 0; e < 8; ++e) o[e] = q[e] * __expf(bb[e]);
          { u32x4 w; w.x = pk2(o[0], o[1]); w.y = pk2(o[2], o[3]); w.z = pk2(o[4], o[5]); w.w = pk2(o[6], o[7]); *(LAS u32x4*)(Qg + tok * mx::PITCH + seg * 16) = w; }
#pragma unroll
          for (int a2 = 0; a2 < 4; ++a2) {
              if (a2 < a) continue;
              float rr[8];
              if (a2 == 0) {
#pragma unroll
                  for (int e = 0; e < 8; ++e) rr[e] = 0.f; }
              else { const f32x4 r0 = *(const LAS f32x4*)(Bf + (16 * a2 - 1) * 64 + seg * 8), r1 = *(const LAS f32x4*)(Bf + (16 * a2 - 1) * 64 + seg * 8 + 4);
                  rr[0] = r0[0]; rr[1] = r0[1]; rr[2] = r0[2]; rr[3] = r0[3]; rr[4] = r1[0]; rr[5] = r1[1]; rr[6] = r1[2]; rr[7] = r1[3]; }
              if (a2 == a) {
#pragma unroll
                  for (int e = 0; e < 8; ++e) o[e] = q[e] * __expf(bb[e] - rr[e]);
                  u32x4 w; w.x = pk2(o[0], o[1]); w.y = pk2(o[2], o[3]); w.z = pk2(o[4], o[5]); w.w = pk2(o[6], o[7]); *(LAS u32x4*)(Qa + tok * mx::PITCH + seg * 16) = w; }
#pragma unroll
              for (int e = 0; e < 8; ++e) o[e] = (1.0f - __expf(lf[e])) * __expf(rr[e] - bb[e]);
              u32x4 w; w.x = pk2(o[0], o[1]); w.y = pk2(o[2], o[3]); w.z = pk2(o[4], o[5]); w.w = pk2(o[6], o[7]); *(LAS u32x4*)(Kr + a2 * mx::IMG + tok * mx::PITCH + seg * 16) = w;
          }
#pragma unroll
          for (int e = 0; e < 4; ++e) { const int f = fs * 4 + e; const float b63 = Bf[63 * 64 + f];
              *(LAS unsigned*)(VT + f * mx::PITCH + tp * 4) = mx::rawe(rv0, e) | (mx::rawe(rv1, e) << 16);
              const float k0 = (1.0f - __expf(mx::bfe(rl0, e))) * __expf(b63 - Bf[(2 * tp) * 64 + f]), k1 = (1.0f - __expf(mx::bfe(rl1, e))) * __expf(b63 - Bf[(2 * tp + 1) * 64 + f]);
              *(LAS unsigned*)(KdT + f * mx::PITCH + tp * 4) = pk2(k0, k1); } }
        __syncthreads();
        if (p + 1 < 68) fetch(p + 1);
#pragma unroll
        for (int hh = 0; hh < 2; ++hh) { const int idx = wave + 8 * hh; if (idx < 10) { int mt, nt; mx::tile10(idx, mt, nt);
            f32x4 acc = (f32x4){0.f, 0.f, 0.f, 0.f};
            acc = MFMA16(mx::frag(Kr + nt * mx::IMG, mt, 0, fr, fq), mx::frag(Qa, nt, 0, fr, fq), acc); acc = MFMA16(mx::frag(Kr + nt * mx::IMG, mt, 1, fr, fq), mx::frag(Qa, nt, 1, fr, fq), acc);
            const int e0 = 16 * (nt - mt) + fr - 4 * fq;
            mx::store4(Pm, nt * 16 + fr, mt * 16 + fq * 4, e0 >= 0 ? acc[0] : 0.f, e0 >= 1 ? acc[1] : 0.f, e0 >= 2 ? acc[2] : 0.f, e0 >= 3 ? acc[3] : 0.f); } }
        f32x4 dec; { const f32x4 b63 = *(const LAS f32x4*)(Bf + 63 * 64 + (wave & 3) * 16 + fq * 4); dec = (f32x4){__expf(b63[0]), __expf(b63[1]), __expf(b63[2]), __expf(b63[3])}; }
        __syncthreads();
        lin_attn_os(Qg, VT, Pm, KdT, ST + (p & 1) * mx::IMG, ST + ((p + 1) & 1) * mx::IMG, S0, S1, dec, Og, b, d, p, ocol, wave, fr, fq);
        __syncthreads();
    }
}

__device__ __forceinline__ int nat_row(int b, int c, int t) { return c < 4 ? b * TCTX + c * 64 + t : MCTX + b * TLAT + (c - 4) * 64 + t; }
__device__ __forceinline__ void phase_gdnpre(const TC tc, KP P, LAS unsigned char* lds, int l) {
    const int tid = tc.tid, lane = tid & 63, wave = __builtin_amdgcn_readfirstlane(tid >> 6), fr = lane & 15, fq = lane >> 4;
    unsigned char* ws = P->ws;
    bf16_t* Z = (bf16_t*)(ws + WS_Z);
    const bf16_t* QC = (const bf16_t*)(ws + WS_HB);
    const float* AB = (const float*)(ws + WS_AB);
    LAS unsigned char* Qn = lds; LAS unsigned char* Kn = lds + mx::IMG; LAS unsigned char* Tim = lds + 2 * mx::IMG;
    LAS float* KKf = (LAS float*)(lds + 4 * mx::IMG);
    LAS float* Af = (LAS float*)(lds + 4 * mx::IMG + 64 * 68 * 4);
    LAS float* gar = (LAS float*)(lds + 4 * mx::IMG + 3 * 64 * 68 * 4);
    const int tok = tid >> 3, seg = tid & 7;
    for (int u = tc.bid; u < NB * 68 * 4; u += tc.G) {
        const int h = u & 3, c = (u >> 2) % 68, b = (u >> 2) / 68;
        { const bf16_t* qr = QC + (size_t)nat_row(b, c, tok) * 768 + h * 64 + seg * 8;
          *(LAS u32x4*)(Qn + tok * mx::PITCH + seg * 16) = *(const u32x4*)qr; *(LAS u32x4*)(Kn + tok * mx::PITCH + seg * 16) = *(const u32x4*)(qr + 256); }
        if (tid < 128) { const int d = tid >> 6, i = tid & 63, t = d ? 63 - i : i; const float* ab = AB + (size_t)nat_row(b, c, t) * 16;
            float g = ab[d * 4 + h];
#pragma unroll
            for (int o = 1; o < 64; o <<= 1) { const float x = __shfl_up(g, o); if (i >= o) g += x; }
            gar[d * 64 + i] = g; gar[128 + d * 64 + i] = ab[8 + d * 4 + h]; }
        __syncthreads();
#pragma unroll
        for (int hh = 0; hh < 2; ++hh) { const int mt = wave & 3, nt = (wave >> 2) + 2 * hh;
            f32x4 a1 = (f32x4){0.f, 0.f, 0.f, 0.f}, a2 = a1;
            const bf16x8 k0 = mx::frag(Kn, mt, 0, fr, fq), k1 = mx::frag(Kn, mt, 1, fr, fq);
            a1 = MFMA16(k0, mx::frag(Qn, nt, 0, fr, fq), a1); a1 = MFMA16(k1, mx::frag(Qn, nt, 1, fr, fq), a1);
            a2 = MFMA16(k0, mx::frag(Kn, nt, 0, fr, fq), a2); a2 = MFMA16(k1, mx::frag(Kn, nt, 1, fr, fq), a2);
            { u32x2 w; w.x = pk2(a1[0], a1[1]); w.y = pk2(a1[2], a1[3]); *(u32x2*)(Z + (size_t)nat_row(b, c, nt * 16 + fr) * NZ + ZC_GQKV + 512 + h * 64 + mt * 16 + fq * 4) = w; }
            *(LAS f32x4*)(KKf + (nt * 16 + fr) * 68 + mt * 16 + fq * 4) = a2; }
        __syncthreads();
#pragma unroll
        for (int it = 0; it < 16; ++it) { const int e = it * 512 + tid, d = e >> 12, i = (e >> 6) & 63, j = e & 63;
            const int ti = d ? 63 - i : i, tj = d ? 63 - j : j;
            Af[(d * 64 + i) * 68 + j] = j < i ? gar[128 + d * 64 + i] * KKf[ti * 68 + tj] * __expf(gar[d * 64 + i] - gar[d * 64 + j]) : 0.f; }
        __syncthreads();
        if (wave < 2) {
            const LAS float* A = Af + wave * 64 * 68; LAS unsigned char* To = Tim + wave * mx::IMG;
            float T[64];
#pragma unroll
            for (int i = 0; i < 64; ++i) {
                float acc = (i == lane) ? 1.0f : 0.0f;
#pragma unroll
                for (int j4 = 0; j4 < (i + 3) / 4; ++j4) { const f32x4 a = *(const LAS f32x4*)(A + i * 68 + j4 * 4);
#pragma unroll
                    for (int e = 0; e < 4; ++e) if (j4 * 4 + e < i) acc -= a[e] * T[j4 * 4 + e]; }
                T[i] = acc;
                *(LAS unsigned short*)(To + i * mx::PITCH + lane * 2) = (unsigned short)f2bf(acc);
            }
        }
        __syncthreads();
        { const int d = tid >> 8, i = (tid >> 2) & 63, qd = tid & 3;
          bf16_t* dst = Z + (size_t)nat_row(b, c, i) * NZ + ZC_GQKV + (h * 2 + d) * 64 + qd * 16;
          const LAS unsigned char* src = Tim + d * mx::IMG + i * mx::PITCH + qd * 32;
          *(u32x4*)dst = *(const LAS u32x4*)src; *(u32x4*)(dst + 8) = *(const LAS u32x4*)(src + 16); }
        __syncthreads();
    }
}

__device__ __forceinline__ void chain_gdn(const TC tc, KP P, LAS unsigned char* lds, int l, int chain) {
    const int tid = tc.tid, lane = tid & 63, wave = __builtin_amdgcn_readfirstlane(tid >> 6), fr = lane & 15, fq = lane >> 4;
    const int b = chain >> 3, h = (chain >> 1) & 3, d = chain & 1;
    unsigned char* ws = P->ws;
    const bf16_t* Z = (const bf16_t*)(ws + WS_Z);
    const bf16_t* QC = (const bf16_t*)(ws + WS_HB);
    const float* AB = (const float*)(ws + WS_AB);
    bf16_t* Og = (bf16_t*)(ws + (d ? WS_OB : WS_OF));
    const int ocol = 512 + h * 64;
    LAS unsigned char* Tm = lds; LAS unsigned char* QKm = lds + mx::IMG; LAS unsigned char* Kg = lds + 2 * mx::IMG; LAS unsigned char* Qg = lds + 3 * mx::IMG; LAS unsigned char* KdT = lds + 4 * mx::IMG;
    LAS unsigned char* VT = lds + 5 * mx::IMG; LAS unsigned char* RT = lds + 6 * mx::IMG; LAS unsigned char* VnT = lds + 7 * mx::IMG; LAS unsigned char* ST = lds + 8 * mx::IMG;
    LAS float* gar = (LAS float*)(lds + 10 * mx::IMG);
    for (int i = tid; i < 2 * mx::IMG / 16; i += 512) *(LAS u32x4*)(ST + i * 16) = (u32x4){0u, 0u, 0u, 0u};
    f32x4 S0 = (f32x4){0.f, 0.f, 0.f, 0.f}, S1 = S0;
    const int tok = tid >> 3, seg = tid & 7, tp = tid & 31, fs = tid >> 5;
    u32x4 rt, rqk, rq, rk; u32x2 rv0, rv1, rk0, rk1; float rla = 0.f, rbe = 0.f;
    auto fetch = [&](int p) {
        const int c = p < 4 ? (d ? 3 - p : p) : 4 + (d ? 67 - p : p - 4);
        rt = *(const u32x4*)(Z + (size_t)nat_row(b, c, tok) * NZ + ZC_GQKV + (h * 2 + d) * 64 + seg * 8);
        rqk = *(const u32x4*)(Z + (size_t)nat_row(b, c, d ? 63 - tok : tok) * NZ + ZC_GQKV + 512 + h * 64 + (d ? 7 - seg : seg) * 8);
        const bf16_t* qr = QC + (size_t)seq_row(b, d, p * 64 + tok) * 768 + h * 64 + seg * 8;
        rq = *(const u32x4*)qr; rk = *(const u32x4*)(qr + 256);
        const bf16_t* z0 = QC + (size_t)seq_row(b, d, p * 64 + 2 * tp) * 768 + h * 64 + fs * 4; const bf16_t* z1 = QC + (size_t)seq_row(b, d, p * 64 + 2 * tp + 1) * 768 + h * 64 + fs * 4;
        rv0 = *(const u32x2*)(z0 + 512); rv1 = *(const u32x2*)(z1 + 512); rk0 = *(const u32x2*)(z0 + 256); rk1 = *(const u32x2*)(z1 + 256);
        if (tid < 64) { const float* ab = AB + (size_t)seq_row(b, d, p * 64 + tid) * 16; rla = ab[d * 4 + h]; rbe = ab[8 + d * 4 + h]; }
    };
    fetch(0);
    __syncthreads();
    for (int p = 0; p < 68; ++p) {
        if (tid < 64) { float g = rla;
#pragma unroll
            for (int o = 1; o < 64; o <<= 1) { const float x = __shfl_up(g, o); if (tid >= o) g += x; }
            gar[tid] = g; gar[64 + tid] = rbe; }
        __syncthreads();
        { *(LAS u32x4*)(Tm + tok * mx::PITCH + seg * 16) = rt;
          const float gi = gar[tok], eg = __expf(gi);
          { const unsigned* pq = (const unsigned*)&rq; const unsigned* pk = (const unsigned*)&rk; u32x4 wq, wk; unsigned* oq = (unsigned*)&wq; unsigned* ok = (unsigned*)&wk;
#pragma unroll
            for (int e = 0; e < 4; ++e) { oq[e] = pk2(bflo(pq[e]) * eg, bfhi(pq[e]) * eg); ok[e] = pk2(bflo(pk[e]) * eg, bfhi(pk[e]) * eg); }
            *(LAS u32x4*)(Qg + tok * mx::PITCH + seg * 16) = wq; *(LAS u32x4*)(Kg + tok * mx::PITCH + seg * 16) = wk; }
          { const unsigned* pr = (const unsigned*)&rqk; float x[8];
#pragma unroll
            for (int e = 0; e < 4; ++e) { x[2 * e] = bflo(pr[e]); x[2 * e + 1] = bfhi(pr[e]); }
            float y[8];
#pragma unroll
            for (int e = 0; e < 8; ++e) { const int j = seg * 8 + e; const float raw = d ? x[7 - e] : x[e]; y[e] = j <= tok ? raw * __expf(gi - gar[j]) : 0.f; }
            u32x4 w; w.x = pk2(y[0], y[1]); w.y = pk2(y[2], y[3]); w.z = pk2(y[4], y[5]); w.w = pk2(y[6], y[7]); *(LAS u32x4*)(QKm + tok * mx::PITCH + seg * 16) = w; }
          const float g63 = gar[63], s0 = __expf(g63 - gar[2 * tp]), s1 = __expf(g63 - gar[2 * tp + 1]);
#pragma unroll
          for (int e = 0; e < 4; ++e) { const int f = fs * 4 + e;
              *(LAS unsigned*)(VT + f * mx::PITCH + tp * 4) = mx::rawe(rv0, e) | (mx::rawe(rv1, e) << 16);
              *(LAS unsigned*)(KdT + f * mx::PITCH + tp * 4) = pk2(mx::bfe(rk0, e) * s0, mx::bfe(rk1, e) * s1); } }
        __syncthreads();
        if (p + 1 < 68) fetch(p + 1);
        const LAS unsigned char* STc = ST + (p & 1) * mx::IMG; LAS unsigned char* STn = ST + ((p + 1) & 1) * mx::IMG;
        const int mt = wave & 3;
#pragma unroll
        for (int hh = 0; hh < 2; ++hh) { const int nt = (wave >> 2) + 2 * hh;
            f32x4 acc = (f32x4){0.f, 0.f, 0.f, 0.f};
            acc = MFMA16(mx::frag(Kg, mt, 0, fr, fq), mx::frag(STc, nt, 0, fr, fq), acc); acc = MFMA16(mx::frag(Kg, mt, 1, fr, fq), mx::frag(STc, nt, 1, fr, fq), acc);
            const u32x2 vv = *(const LAS u32x2*)(VT + (nt * 16 + fr) * mx::PITCH + (mt * 16 + fq * 4) * 2);
            const f32x4 be = *(const LAS f32x4*)(gar + 64 + mt * 16 + fq * 4);
            mx::store4(RT, nt * 16 + fr, mt * 16 + fq * 4, be[0] * (bflo(vv.x) - acc[0]), be[1] * (bfhi(vv.x) - acc[1]), be[2] * (bflo(vv.y) - acc[2]), be[3] * (bfhi(vv.y) - acc[3])); }
        __syncthreads();
#pragma unroll
        for (int hh = 0; hh < 2; ++hh) { const int nt = (wave >> 2) + 2 * hh;
            f32x4 acc = (f32x4){0.f, 0.f, 0.f, 0.f};
            acc = MFMA16(mx::frag(Tm, mt, 0, fr, fq), mx::frag(RT, nt, 0, fr, fq), acc); acc = MFMA16(mx::frag(Tm, mt, 1, fr, fq), mx::frag(RT, nt, 1, fr, fq), acc);
            mx::store4(VnT, nt * 16 + fr, mt * 16 + fq * 4, acc[0], acc[1], acc[2], acc[3]); }
        __syncthreads();
        { const float dg = __expf(gar[63]);
#pragma unroll
          for (int hh = 0; hh < 2; ++hh) { const int nt = (wave >> 2) + 2 * hh;
            f32x4 acc = (f32x4){0.f, 0.f, 0.f, 0.f};
            acc = MFMA16(mx::frag(VnT, mt, 0, fr, fq), mx::frag(QKm, nt, 0, fr, fq), acc); acc = MFMA16(mx::frag(VnT, mt, 1, fr, fq), mx::frag(QKm, nt, 1, fr, fq), acc);
            acc = MFMA16(mx::frag(STc, mt, 0, fr, fq), mx::frag(Qg, nt, 0, fr, fq), acc); acc = MFMA16(mx::frag(STc, mt, 1, fr, fq), mx::frag(Qg, nt, 1, fr, fq), acc);
            { const int row = seq_row(b, d, p * 64 + nt * 16 + fr); u32x2 w; w.x = pk2(acc[0], acc[1]); w.y = pk2(acc[2], acc[3]);
              *(u32x2*)(Og + (size_t)row * DM + ocol + mt * 16 + fq * 4) = w; }
            f32x4 sn = (hh == 0 ? S0 : S1) * dg;
            sn = MFMA16(mx::frag(KdT, mt, 0, fr, fq), mx::frag(VnT, nt, 0, fr, fq), sn); sn = MFMA16(mx::frag(KdT, mt, 1, fr, fq), mx::frag(VnT, nt, 1, fr, fq), sn);
            if (hh == 0) S0 = sn; else S1 = sn;
            mx::store4(STn, nt * 16 + fr, mt * 16 + fq * 4, sn[0], sn[1], sn[2], sn[3]); } }
        __syncthreads();
    }
}

constexpr int S5_XT = 128 * 80, S5_H = 16 * 272, S5_CH = 2 * S5_XT + 2 * S5_H;
static_assert(4 * S5_CH <= LDS_BYTES - 64, "S5 LDS");
__device__ __forceinline__ void chain_s5m(const TC tc, KP P, LAS unsigned char* lds, int l, int item) {
    const int tid = tc.tid, lane = tid & 63, wave = __builtin_amdgcn_readfirstlane(tid >> 6), fr = lane & 15, fq = lane >> 4;
    const int b = item >> 3, d = (item >> 2) & 1, gq = item & 3, ch = wave & 3, g = gq * 4 + ch;
    const bool isA = wave < 4;
    unsigned char* ws = P->ws;
    const bf16_t* Z = (const bf16_t*)(ws + WS_Z);
    bf16_t* Og = (bf16_t*)(ws + (d ? WS_OB : WS_OF));
    LAS unsigned char* base = lds + ch * S5_CH;
    const float* sp0 = (const float*)(ws + WS_S5P) + (size_t)((l * 2 + d) * 16 + g) * 64 * 34;
    bf16x8 bbf[8], ccf[4]; float ar = 0.f, ai = 0.f, hr = 0.f, hi = 0.f;
    if (isA) {
#pragma unroll
        for (int nt = 0; nt < 8; ++nt) { const int s = nt * 16 + fr, p = s & 63; const float* sp = sp0 + p * 34 + (s < 64 ? 2 : 18) + (fq & 1) * 8;
            u32x4 w = (u32x4){0u, 0u, 0u, 0u};
            if (fq < 2) { w.x = pk2(sp[0], sp[1]); w.y = pk2(sp[2], sp[3]); w.z = pk2(sp[4], sp[5]); w.w = pk2(sp[6], sp[7]); }
            bbf[nt] = __builtin_bit_cast(bf16x8, w); }
#pragma unroll
        for (int ks = 0; ks < 4; ++ks) { const int s0 = ks * 32 + fq * 8; const bool im = s0 >= 64; const float* cp = P->in[im ? 22 : 21] + ((size_t)(l * 16 + g) * 16 + fr) * 64 + (s0 & 63); const float sg = im ? -1.0f : 1.0f;
            u32x4 w; w.x = pk2(sg * cp[0], sg * cp[1]); w.y = pk2(sg * cp[2], sg * cp[3]); w.z = pk2(sg * cp[4], sg * cp[5]); w.w = pk2(sg * cp[6], sg * cp[7]);
            ccf[ks] = __builtin_bit_cast(bf16x8, w); }
    } else { ar = sp0[lane * 34]; ai = sp0[lane * 34 + 1]; }
    u32x4 uf = (u32x4){0u, 0u, 0u, 0u};
    auto fetchu = [&](int it) { if (fq < 2) uf = *(const u32x4*)(Z + (size_t)seq_row(b, d, it * 16 + fr) * NZ + ZC_SU + g * 16 + fq * 8); };
    if (isA) fetchu(0);
    constexpr int NST = TSEQ / 16;
    for (int it = 0; it < NST + 2; ++it) {
        if (isA) {
            if (it < NST) {
                const bf16x8 ua = __builtin_bit_cast(bf16x8, uf);
                if (it + 1 < NST) fetchu(it + 1);
                LAS unsigned char* xt = base + (it & 1) * S5_XT;
#pragma unroll
                for (int nt = 0; nt < 8; ++nt) { f32x4 acc = (f32x4){0.f, 0.f, 0.f, 0.f}; acc = MFMA16(ua, bbf[nt], acc);
                    *(LAS f32x4*)(xt + (nt * 16 + fr) * 80 + fq * 16) = acc; }
            }
            if (it >= 2) {
                const LAS unsigned char* hh = base + 2 * S5_XT + (it & 1) * S5_H;
                f32x4 acc = (f32x4){0.f, 0.f, 0.f, 0.f};
#pragma unroll
                for (int ks = 0; ks < 4; ++ks) acc = MFMA16(ccf[ks], *(const LAS bf16x8*)(hh + fr * 272 + (ks * 32 + fq * 8) * 2), acc);
                const int row = seq_row(b, d, (it - 2) * 16 + fr); u32x2 w; w.x = pk2(acc[0], acc[1]); w.y = pk2(acc[2], acc[3]);
                *(u32x2*)(Og + (size_t)row * DM + 768 + g * 16 + fq * 4) = w;
            }
        } else if (it >= 1 && it <= NST) {
            const LAS unsigned char* xt = base + ((it - 1) & 1) * S5_XT; LAS unsigned char* hh = base + 2 * S5_XT + ((it - 1) & 1) * S5_H;
#pragma unroll
            for (int tq = 0; tq < 4; ++tq) { const f32x4 xr = *(const LAS f32x4*)(xt + lane * 80 + tq * 16), xi = *(const LAS f32x4*)(xt + (64 + lane) * 80 + tq * 16);
#pragma unroll
                for (int e = 0; e < 4; ++e) { const float nr = ar * hr - ai * hi + xr[e], ni = ar * hi + ai * hr + xi[e]; hr = nr; hi = ni;
                    *(LAS unsigned short*)(hh + (tq * 4 + e) * 272 + lane * 2) = (unsigned short)f2bf(hr); *(LAS unsigned short*)(hh + (tq * 4 + e) * 272 + 128 + lane * 2) = (unsigned short)f2bf(hi); } }
        }
        __syncthreads();
    }
}

#ifndef CHAIN_NEW
#define CHAIN_NEW 15
#endif
__device__ __forceinline__ void phase_mixscan(const TC tc, KP P, LAS unsigned char* lds, int l) {
    for (int item = tc.bid; item < 256; item += tc.G) {
        const int kind = item >> 6, c = item & 63;
        if (kind == 0) { if (CHAIN_NEW & 1) chain_hgrn(tc, P, lds, l, c); else chain_matrix<0>(tc, P, lds, l, c); }
        else if (kind == 1) { if (CHAIN_NEW & 2) chain_ret(tc, P, lds, l, c); else chain_matrix<1>(tc, P, lds, l, c); }
        else if (kind == 2) { if (CHAIN_NEW & 4) chain_gdn(tc, P, lds, l, c); else chain_matrix<2>(tc, P, lds, l, c); }
        else { if (CHAIN_NEW & 8) chain_s5m(tc, P, lds, l, c); else chain_s5(tc, P, lds, l, c); }
    }
}

__device__ __forceinline__ void phase_combine(const TC tc, KP P, int l, int r0) {
    const int tid = tc.tid, lane = tid & 63, wave = tid >> 6;
    const int gw = tc.bid * 8 + wave, NGW = tc.G * 8;
    unsigned char* ws = P->ws;
    const bf16_t* Z = (const bf16_t*)(ws + WS_Z);
    const bf16_t* OF = (const bf16_t*)(ws + WS_OF); const bf16_t* OB = (const bf16_t*)(ws + WS_OB);
    bf16_t* CAT = (bf16_t*)(ws + WS_HB);
    const float* ghg = P->in[10] + l * 64; const float* ggd = P->in[15] + l * 64; const float* dsk = P->in[23] + l * DG;
    const int hc = (lane & 15) * 4;
    const f32x4 g_h = *(const f32x4*)(ghg + hc), g_g = *(const f32x4*)(ggd + hc);
    const f32x4 dv = *(const f32x4*)(dsk + lane * 4);
    for (int r = r0 + gw; r < MALL; r += NGW) {
        const bf16_t* zr = Z + (size_t)r * NZ;
#pragma unroll
        for (int mx = 0; mx < 3; ++mx) {
            const u32x2 a = *(const u32x2*)(OF + (size_t)r * DM + mx * 256 + lane * 4), bb = *(const u32x2*)(OB + (size_t)r * DM + mx * 256 + lane * 4);
            f32x4 o = (f32x4){bflo(a.x) + bflo(bb.x), bfhi(a.x) + bfhi(bb.x), bflo(a.y) + bflo(bb.y), bfhi(a.y) + bfhi(bb.y)};
            float ss = (o.x * o.x + o.y * o.y) + (o.z * o.z + o.w * o.w);
            ss += __shfl_xor(ss, 1); ss += __shfl_xor(ss, 2); ss += __shfl_xor(ss, 4); ss += __shfl_xor(ss, 8);
            const float rn = rsqrtf(ss * (1.0f / 64.0f) + EPS);
            o = o * rn; if (mx == 0) o = o * g_h; if (mx == 2) o = o * g_g;
            const u32x2 gt = *(const u32x2*)(zr + (mx == 0 ? ZC_HG : mx == 1 ? ZC_RG : ZC_GG) + lane * 4);
            u32x2 w; w.x = pk2(o.x * siluf_(bflo(gt.x)), o.y * siluf_(bfhi(gt.x))); w.y = pk2(o.z * siluf_(bflo(gt.y)), o.w * siluf_(bfhi(gt.y)));
            *(u32x2*)(CAT + (size_t)r * DM + mx * 256 + lane * 4) = w;
        }
        { const u32x2 a = *(const u32x2*)(OF + (size_t)r * DM + 768 + lane * 4), bb = *(const u32x2*)(OB + (size_t)r * DM + 768 + lane * 4);
          const u32x2 uu = *(const u32x2*)(zr + ZC_SU + lane * 4);
          const float y0 = bflo(a.x) + bflo(bb.x) + bflo(uu.x) * dv.x, y1 = bfhi(a.x) + bfhi(bb.x) + bfhi(uu.x) * dv.y, y2 = bflo(a.y) + bflo(bb.y) + bflo(uu.y) * dv.z, y3 = bfhi(a.y) + bfhi(bb.y) + bfhi(uu.y) * dv.w;
          u32x2 w; w.x = pk2(gelu_tanh(y0), gelu_tanh(y1)); w.y = pk2(gelu_tanh(y2), gelu_tanh(y3));
          *(u32x2*)(CAT + (size_t)r * DM + 768 + lane * 4) = w; }
    }
}

__device__ __forceinline__ void phase_glu(const TC tc, KP P, LAS unsigned char* lds, int l, int r0) {
    const int tid = tc.tid, lane = tid & 63, wave = tid >> 6;
    const int gw = tc.bid * 8 + wave, NGW = tc.G * 8;
    const int ntile = (MALL - r0) / 16;
    if (tc.bid * 8 >= ntile) return;
    unsigned char* ws = P->ws;
    const bf16_t* wg = (const bf16_t*)(ws + WS_W + (size_t)l * SZ_WL + SZ_WIN + SZ_WOUT + SZ_W1 + SZ_W2);
    for (int i = tid; i < 256 * 32; i += 512) { const int n = i >> 5, c = i & 31; *(LAS u32x4*)(lds + n * 528 + c * 16) = *(const u32x4*)(wg + n * 256 + c * 8); }
    __syncthreads();
    bf16_t* CAT = (bf16_t*)(ws + WS_HB);
    const float* bias = P->in[25] + l * DG;
    const int fr = lane & 15, fq = lane >> 4;
    for (int t = gw; t < ntile; t += NGW) {
        bf16_t* rowp = CAT + (size_t)(r0 + t * 16 + fr) * DM + 768;
        bf16x8 af[8];
#pragma unroll
        for (int ks = 0; ks < 8; ++ks) af[ks] = *(const bf16x8*)(rowp + ks * 32 + fq * 8);
        f32x4 acc[16];
#pragma unroll
        for (int nt = 0; nt < 16; ++nt) acc[nt] = (f32x4){0.f, 0.f, 0.f, 0.f};
#pragma unroll
        for (int ks = 0; ks < 8; ++ks)
#pragma unroll
            for (int nt = 0; nt < 16; ++nt) { const bf16x8 wf = *(const LAS bf16x8*)(lds + (nt * 16 + fr) * 528 + (ks * 32 + fq * 8) * 2);
                acc[nt] = __builtin_amdgcn_mfma_f32_16x16x32_bf16(wf, af[ks], acc[nt], 0, 0, 0); if ((nt & 7) == 7) asm volatile("" ::: "memory"); }
#pragma unroll
        for (int nt = 0; nt < 16; ++nt) { const int c = nt * 16 + 4 * fq; asm volatile("" ::: "memory"); const f32x4 bv = *(const f32x4*)(bias + c); const u32x2 y = *(const u32x2*)(rowp + c);
            u32x2 w; w.x = pk2(bflo(y.x) * sigmoidf_(acc[nt][0] + bv[0]), bfhi(y.x) * sigmoidf_(acc[nt][1] + bv[1])); w.y = pk2(bflo(y.y) * sigmoidf_(acc[nt][2] + bv[2]), bfhi(y.y) * sigmoidf_(acc[nt][3] + bv[3]));
            *(u32x2*)(rowp + c) = w; }
    }
}

__device__ __forceinline__ void phase_final(const TC tc, KP P) {
    const int tid = tc.tid, lane = tid & 63, wave = tid >> 6;
    const int gw = tc.bid * 8 + wave, NGW = tc.G * 8;
    const float* g = P->in[29];
    for (int r = gw; r < MLAT; r += NGW) {
        float* xr = P->out + (size_t)r * DM;
        f32x4 x[4]; float ss = 0.f;
#pragma unroll
        for (int j = 0; j < 4; ++j) { x[j] = ((const f32x4*)xr)[j * 64 + lane]; ss += (x[j].x * x[j].x + x[j].y * x[j].y) + (x[j].z * x[j].z + x[j].w * x[j].w); }
        const float rstd = rsqrtf(wave_sum(ss) * (1.0f / DM) + EPS);
#pragma unroll
        for (int j = 0; j < 4; ++j) ((f32x4*)xr)[j * 64 + lane] = x[j] * rstd * ((const f32x4*)g)[j * 64 + lane];
    }
}


#define XB_TMO      128
#define XB_XCNT(j)  (256  + 64 * (j))
#define XB_XSUB(j)  (1280 + 64 * (j))
#define XB_XGEN(j)  (2304 + 64 * (j))
#define XB_TOP      3328
#define XB_TOPGEN   3392
#define XCD_BAR_WORDS 3456
#define XB_SPIN_CAP (1u << 22)
__device__ __forceinline__ unsigned xb_ld(unsigned* p)              { return __hip_atomic_load(p, __ATOMIC_RELAXED, __HIP_MEMORY_SCOPE_AGENT); }
__device__ __forceinline__ unsigned xb_add(unsigned* p, unsigned v) { return __hip_atomic_fetch_add(p, v, __ATOMIC_RELAXED, __HIP_MEMORY_SCOPE_AGENT); }
__device__ __forceinline__ unsigned xb_xcc_id() { return (unsigned)__builtin_amdgcn_s_getreg((3 << 11) | 20) & 0xFu; }
#define XB_SPIN(cond, bar) do { unsigned _sp = 0; while (cond) { __builtin_amdgcn_s_sleep(1); \
    if ((++_sp & 255u) == 0u) { if (xb_ld(&(bar)[XB_TMO])) break; if (_sp > XB_SPIN_CAP) { atomicAdd(&(bar)[XB_TMO], 1u); break; } } } } while (0)
__device__ __forceinline__ void xcd_barrier_complete(unsigned* bar, unsigned x, unsigned G, unsigned& nloc, unsigned& nx) {
    unsigned sum, cnt, mine, sp = 0u;
    for (;;) {
        sum = 0u; cnt = 0u; mine = 0u;
#pragma unroll
        for (unsigned j = 0; j < 16; ++j) { const unsigned c = xb_ld(&bar[XB_XCNT(j)]); sum += c; cnt += (c > 0u) ? 1u : 0u; mine = (j == x) ? c : mine; }
        if (sum == G) break;
        __builtin_amdgcn_s_sleep(1);
        if ((++sp & 255u) == 0u) { if (xb_ld(&bar[XB_TMO])) break; if (sp > XB_SPIN_CAP) { atomicAdd(&bar[XB_TMO], 1u); break; } }
    }
    nloc = mine > 0u ? mine : 1u; nx = cnt > 0u ? cnt : 1u;
}
__device__ __forceinline__ void xcd_barrier(unsigned* bar, volatile LAS unsigned* st, int tid, unsigned G) {
    asm volatile("s_waitcnt vmcnt(0)" ::: "memory");
    __syncthreads();
    if (tid == 0) {
        __builtin_amdgcn_s_waitcnt(0);
        const unsigned x = xb_xcc_id();
        unsigned nloc = st[0], nx = st[1];
        if (nloc == 0u) { xcd_barrier_complete(bar, x, G, nloc, nx); st[0] = nloc; st[1] = nx; }
        const unsigned old = xb_add(&bar[XB_XSUB(x)], 1u);
        const unsigned gen = old / nloc;
        if (old + 1u == (gen + 1u) * nloc) {
            __builtin_amdgcn_fence(__ATOMIC_RELEASE, "agent");
            asm volatile("s_waitcnt vmcnt(0)" ::: "memory");
            const unsigned og = xb_add(&bar[XB_TOP], 1u);
            const unsigned tg = og / nx;
            if (og + 1u == (tg + 1u) * nx) xb_add(&bar[XB_TOPGEN], 1u);
            else XB_SPIN(xb_ld(&bar[XB_TOPGEN]) == tg, bar);
            __builtin_amdgcn_fence(__ATOMIC_ACQUIRE, "agent");
            xb_add(&bar[XB_XGEN(x)], 1u);
            asm volatile("s_waitcnt vmcnt(0)" ::: "memory");
        } else {
            XB_SPIN(xb_ld(&bar[XB_XGEN(x)]) == gen, bar);
            __builtin_amdgcn_fence(__ATOMIC_ACQUIRE, "agent");
            asm volatile("s_waitcnt vmcnt(0)" ::: "memory");
        }
    }
    __syncthreads();
}

__global__ void __launch_bounds__(512, 2) mega(Params Pk) {
    extern __shared__ __attribute__((aligned(16))) unsigned char lds_raw[];
    LAS unsigned char* lds = (LAS unsigned char*)lds_raw;
    cg::grid_group grid = cg::this_grid();
    volatile LAS unsigned* bst = (volatile LAS unsigned*)(lds + LDS_BYTES - 64);
    if (threadIdx.x < 16) bst[threadIdx.x] = 0u;
    __syncthreads();
    if (threadIdx.x == 0) (void)xb_add((unsigned*)(Pk.ws + WS_CTL) + XB_XCNT(xb_xcc_id()), 1u);
#ifndef PROBE_DUP
#define PROBE_DUP 0
#endif
    for (int phx = Pk.ph_lo * 2; phx < Pk.ph_hi * 2; ++phx) {
        const int ph = phx >> 1;
        if (phx & 1) { if (!(PROBE_DUP && ph >= 1 && ph < NPHASE - 1 && ((PROBE_DUP >> ((ph - 1) % NSP)) & 1))) continue; xcd_barrier((unsigned*)(Pk.ws + WS_CTL), bst, threadIdx.x, gridDim.x); }
        KP P = (KP)__builtin_amdgcn_kernarg_segment_ptr();
        asm volatile("" : "+s"(P));
        TC tc; tc.tid = threadIdx.x; tc.bid = blockIdx.x; tc.G = gridDim.x;
        asm volatile("" : "+v"(tc.tid)); asm volatile("" : "+s"(tc.bid)); asm volatile("" : "+s"(tc.G));
        unsigned char* ws = P->ws;
#ifndef PHMASK
#define PHMASK 0xFFFF
#endif
        if (ph == 0) { if (PHMASK & 1) phase_prologue(tc, P, lds); }
        else if (ph == NPHASE - 1) { if (PHMASK & 2) phase_final(tc, P); }
        else {
            const int l = (ph - 1) / NSP, sp = (ph - 1) % NSP;
            const int pm_off = (l == DEPTH - 1) ? 8 : 0, r0 = pm_off * 256, Mrows = MALL - r0;
#define WL(off) ((const bf16_t*)(ws + WS_W + (size_t)l * SZ_WL + (off)))
#define HB_ ((bf16_t*)(ws + WS_HB))
#define XC_ ((float*)(ws + WS_XC))
#define MODL ((const float*)(ws + WS_MOD) + (size_t)l * 9 * 6144)
            switch (sp) {
            case 0: if (PHMASK & (1 << 2)) phase_norm(tc, P, lds, l, 0, (l == 0) ? P->in[0] : (const float*)P->out, (l == 0) ? P->in[2] : (const float*)XC_, 0, true); break;
            case 1: if (PHMASK & (1 << 3)) { pg8::Gemm g{HB_, WL(0), MALL, NZ, DM, DM}; pg8::StaticOrder S; S.init(MALL, NZ, tc.G, tc.bid); pg8::EpiBf<0> E{(bf16_t*)(ws + WS_Z), NZ}; pg8::gemm_phase(tc, lds, g, S, E); } break;
            case 2: if (PHMASK & (1 << 4)) phase_mixpre(tc, P, l); break;
            case 3: if (PHMASK & (1 << 5)) { if (CHAIN_NEW & 4) phase_gdnpre(tc, P, lds, l); } break;
            case 4: if (PHMASK & (1 << 6)) phase_mixscan(tc, P, lds, l); break;
            case 5: if (PHMASK & (1 << 7)) phase_combine(tc, P, l, r0); break;
            case 6: if (PHMASK & (1 << 8)) phase_glu(tc, P, lds, l, r0); break;
            case 7: if (PHMASK & (1 << 9)) { pg8::Gemm g{HB_ + (size_t)r0 * DM, WL(SZ_WIN), Mrows, DM, DM, DM}; pg8::StaticOrder S; S.init(Mrows, DM, tc.G, tc.bid);
                      pg8::EpiRes E{(l == 0) ? P->in[0] : (const float*)P->out, (l == 0) ? P->in[2] : (const float*)XC_, P->out, XC_, MODL + 2 * DM, pm_off}; pg8::gemm_phase(tc, lds, g, S, E); } break;
            case 8: if (PHMASK & (1 << 10)) phase_norm(tc, P, lds, l, 1, P->out, XC_, r0, false); break;
            case 9: if (PHMASK & (1 << 11)) { pg8::Gemm g{HB_ + (size_t)r0 * DM, WL(SZ_WIN + SZ_WOUT), Mrows, DFF, DM, DM}; pg8::StaticOrder S; S.init(Mrows, DFF, tc.G, tc.bid); pg8::EpiBf<1> E{(bf16_t*)(ws + WS_U) + (size_t)r0 * DFF, DFF}; pg8::gemm_phase(tc, lds, g, S, E); } break;
            case 10: if (PHMASK & (1 << 12)) { pg8::Gemm g{(const bf16_t*)(ws + WS_U) + (size_t)r0 * DFF, WL(SZ_WIN + SZ_WOUT + SZ_W1), Mrows, DM, DFF, DFF}; pg8::StaticOrder S; S.init(Mrows, DM, tc.G, tc.bid);
                      pg8::EpiRes E{P->out, XC_, P->out, XC_, MODL + 5 * DM, pm_off}; pg8::gemm_phase(tc, lds, g, S, E); } break;
            }
        }
        if (ph + 1 < Pk.ph_hi) { if (ph == Pk.ph_lo) grid.sync(); else xcd_barrier((unsigned*)(P->ws + WS_CTL), bst, tc.tid, (unsigned)tc.G); }
    }
}

extern "C" void kernel_launch(void* const* d_in, const int* in_sizes, int n_in, void* d_out, int out_size, void* d_ws, size_t ws_size, hipStream_t stream) {
    static int grid = 0;
    if (grid == 0) {
        if (n_in != 30 || in_sizes[0] != MLAT * DM || out_size != MLAT * DM || ws_size < WS_TOTAL) {
            fprintf(stderr, "kernel_launch: unexpected shapes: n_in %d in0 %d out %d ws %zu (need %zu)\n", n_in, n_in > 0 ? in_sizes[0] : -1, out_size, ws_size, (size_t)WS_TOTAL); grid = -1; return; }
        int dev = 0, cus = 0, per_cu = 0;
        hipGetDevice(&dev); hipDeviceGetAttribute(&cus, hipDeviceAttributeMultiprocessorCount, dev);
        if (hipFuncSetAttribute((const void*)mega, hipFuncAttributeMaxDynamicSharedMemorySize, LDS_BYTES) != hipSuccess) { fprintf(stderr, "kernel_launch: hipFuncSetAttribute failed\n"); grid = -1; return; }
        if (hipOccupancyMaxActiveBlocksPerMultiprocessor(&per_cu, (const void*)mega, 512, LDS_BYTES) != hipSuccess || per_cu < 1) { fprintf(stderr, "kernel_launch: occupancy query failed (%d)\n", per_cu); (void)hipGetLastError(); per_cu = 1; }
        grid = cus * 1;
        if (per_cu < 1) grid = -1;
    }
    if (grid < 0) return;
    if (hipMemsetAsync((char*)d_ws + WS_CTL, 0, CTL_BYTES, stream) != hipSuccess) { fprintf(stderr, "kernel_launch: memset failed\n"); return; }
    Params p{};
    for (int i = 0; i < 30; ++i) p.in[i] = (const float*)d_in[i];
    p.out = (float*)d_out; p.ws = (unsigned char*)d_ws;
#if MK_MULTI
    for (int ph = 0; ph < NPHASE; ++ph) { p.ph_lo = ph; p.ph_hi = ph + 1; hipLaunchKernelGGL(mega, dim3(grid), dim3(512), LDS_BYTES, stream, p); }
#else
    p.ph_lo = 0; p.ph_hi = NPHASE;
    void* args[] = {&p};
    hipError_t e = hipLaunchCooperativeKernel((const void*)mega, dim3(grid), dim3(512), args, LDS_BYTES, stream);
    if (e != hipSuccess) fprintf(stderr, "cooperative launch failed: %s (grid %d)\n", hipGetErrorString(e), grid);
#endif
}
```

```cpp
#include <hip/hip_runtime.h>
#include <hip/hip_cooperative_groups.h>
#include <cstdio>
#include <cstdint>
namespace cg = cooperative_groups;

#ifndef MK_MULTI
#define MK_MULTI 0
#endif
#ifndef CHAIN_DUP
#define CHAIN_DUP 0
#endif
#ifndef HG_DUP
#define HG_DUP 0
#endif

#define LAS __attribute__((address_space(3)))
typedef unsigned short bf16_t;
typedef short bf16x8 __attribute__((ext_vector_type(8)));
typedef float f32x4 __attribute__((ext_vector_type(4)));
typedef float f32x2 __attribute__((ext_vector_type(2)));
typedef unsigned u32x4 __attribute__((ext_vector_type(4)));
typedef unsigned u32x2 __attribute__((ext_vector_type(2)));

constexpr int NB = 8, TLAT = 4096, TCTX = 256, DM = 1024, DEPTH = 2, DG = 256, DIN = 3600, NZ = 3584, DFF = 4096;
constexpr int MCTX = NB * TCTX, MLAT = NB * TLAT, MALL = MCTX + MLAT;
constexpr int TSEQ = TCTX + TLAT;
constexpr float EPS = 1e-6f;
constexpr int ZC_HQ = 0, ZC_HI = 256, ZC_HG = 512, ZC_HF = 768, ZC_RQ = 1280, ZC_RK = 1536, ZC_RV = 1792, ZC_RG = 2048, ZC_GQKV = 2304, ZC_GG = 3072, ZC_SU = 3328;

constexpr size_t SZ_WIN = (size_t)NZ * DM * 2, SZ_WOUT = (size_t)DM * DM * 2, SZ_W1 = (size_t)DFF * DM * 2, SZ_W2 = (size_t)DM * DFF * 2, SZ_GLU = (size_t)DG * DG * 2, SZ_WAB = 16 * DM * 4;
constexpr size_t SZ_WL = SZ_WIN + SZ_WOUT + SZ_W1 + SZ_W2 + SZ_GLU + SZ_WAB;
constexpr size_t WS_W = 0;
constexpr size_t WS_MOD = WS_W + 2 * SZ_WL;
constexpr size_t WS_ROPE = WS_MOD + (size_t)2 * 9 * 6144 * 4;
constexpr size_t WS_LB = WS_ROPE + (size_t)TSEQ * 32 * 2 * 4;
constexpr size_t WS_S5P = WS_LB + 4096;
constexpr size_t WS_XC = WS_S5P + (size_t)2 * 2 * 16 * 64 * 34 * 4;
constexpr size_t WS_AB = WS_XC + (size_t)MCTX * DM * 4;
constexpr size_t WS_HB = WS_AB + (size_t)MALL * 16 * 4;
constexpr size_t WS_Z = WS_HB + (size_t)MALL * DM * 2;
constexpr size_t WS_OF = WS_Z + (size_t)MALL * NZ * 2;
constexpr size_t WS_OB = WS_OF + (size_t)MALL * DM * 2;
constexpr size_t WS_END = WS_OB + (size_t)MALL * DM * 2;
constexpr size_t WS_CTL = WS_END;
constexpr size_t CTL_BYTES = 16384;
constexpr size_t WS_TOTAL = WS_CTL + CTL_BYTES;
constexpr size_t WS_U = WS_Z;
static_assert(WS_U + (size_t)MALL * DFF * 2 <= WS_END, "U overlay");
static_assert(WS_MOD % 256 == 0 && WS_ROPE % 256 == 0 && WS_S5P % 256 == 0 && WS_XC % 256 == 0 && WS_AB % 256 == 0 && WS_HB % 256 == 0 && WS_Z % 256 == 0 && WS_OF % 256 == 0, "align");

constexpr int LDS_BYTES = 147456;
constexpr int NSP = 11, NPHASE = 2 + 2 * NSP;

struct Params {
    const float* in[30];
    float* out;
    unsigned char* ws;
    int ph_lo, ph_hi;
};
typedef const __attribute__((address_space(4))) Params* KP;
struct TC { int tid, bid, G; };

__device__ __forceinline__ unsigned f2bf(float f) { unsigned u = __builtin_bit_cast(unsigned, f); return (u + 0x7fffu + ((u >> 16) & 1u)) >> 16; }
typedef __bf16 bf16x2_t __attribute__((ext_vector_type(2)));
__device__ __forceinline__ unsigned pk2(float lo, float hi) { const f32x2 v = {lo, hi}; return __builtin_bit_cast(unsigned, __builtin_convertvector(v, bf16x2_t)); }
__device__ __forceinline__ float bflo(unsigned w) { return __builtin_bit_cast(float, w << 16); }
__device__ __forceinline__ float bfhi(unsigned w) { return __builtin_bit_cast(float, w & 0xffff0000u); }
__device__ __forceinline__ float wave_sum(float v) {
#pragma unroll
    for (int o = 1; o < 64; o <<= 1) v += __shfl_xor(v, o);
    return v;
}
__device__ __forceinline__ float quad_sum(float x) {
    x += __builtin_bit_cast(float, __builtin_amdgcn_mov_dpp(__builtin_bit_cast(int, x), 0xB1, 0xf, 0xf, true));
    x += __builtin_bit_cast(float, __builtin_amdgcn_mov_dpp(__builtin_bit_cast(int, x), 0x4E, 0xf, 0xf, true));
    return x;
}
__device__ __forceinline__ float sigmoidf_(float x) { return __builtin_amdgcn_rcpf(1.0f + __builtin_amdgcn_exp2f(-1.4426950408889634f * x)); }
__device__ __forceinline__ float siluf_(float x) { return x / (1.0f + __expf(-x)); }
__device__ __forceinline__ float gelu_tanh(float x) { const float u = 0.7978845608028654f * (x + 0.044715f * x * x * x); return 0.5f * x * (1.0f + tanhf(u)); }
__device__ __forceinline__ float reduce16(float (&p)[16], int lane) {
    bool b = (lane & 32) != 0;
#pragma unroll
    for (int i = 0; i < 8; ++i) { const float keep = b ? p[i + 8] : p[i], send = b ? p[i] : p[i + 8]; p[i] = keep + __shfl_xor(send, 32); }
    b = (lane & 16) != 0;
#pragma unroll
    for (int i = 0; i < 4; ++i) { const float keep = b ? p[i + 4] : p[i], send = b ? p[i] : p[i + 4]; p[i] = keep + __shfl_xor(send, 16); }
    b = (lane & 8) != 0;
#pragma unroll
    for (int i = 0; i < 2; ++i) { const float keep = b ? p[i + 2] : p[i], send = b ? p[i] : p[i + 2]; p[i] = keep + __shfl_xor(send, 8); }
    b = (lane & 4) != 0;
    { const float keep = b ? p[1] : p[0], send = b ? p[0] : p[1]; p[0] = keep + __shfl_xor(send, 4); }
    p[0] += __shfl_xor(p[0], 2); p[0] += __shfl_xor(p[0], 1);
    return p[0];
}
__device__ __forceinline__ int seq_row(int b, int d, int j) {
    if (j < TCTX) return b * TCTX + (d ? (TCTX - 1 - j) : j);
    const int t = j - TCTX; return MCTX + b * TLAT + (d ? (TLAT - 1 - t) : t);
}

__device__ __forceinline__ int seq_row0(int b, int d, int j0) { return __builtin_amdgcn_readfirstlane(seq_row(b, d, j0)); }

namespace pg8 {
constexpr int BM = 256, BK = 64, HALF = 128, HTB = HALF * BK * 2, STAGE_BYTES = 8 * HTB, NXCD = 8, WGM = 8;
__host__ __device__ __forceinline__ int lds_byte(int r, int c) { const int st = (r >> 4) * 2 + (c >> 5), rr = r & 15, cc = c & 31, ob = rr * 64 + cc * 2; return st * 1024 + (ob ^ (((ob >> 9) & 1) << 5)); }
__host__ __device__ __forceinline__ void stage_rc(int b, int& R, int& C) { const int st = b / 1024, sb = b % 1024, swz = sb ^ (((sb >> 9) & 1) << 5); R = (st >> 1) * 16 + swz / 64; C = (st & 1) * 32 + (swz % 64) / 2; }
__host__ __device__ __forceinline__ int perm32(int rho) { const int n = rho >> 4, i = rho & 15; return 8 * (i >> 2) + 4 * n + (i & 3); }
struct Unit { int pm, pn; };
struct Gemm { const bf16_t* A; const bf16_t* Bt; int M, N, K, lda; };
struct StaticOrder {
    int nM, nN, nwg, G, c;
    __device__ void init(int M, int N, int G_, int c_) { nM = M / BM; nN = N / BM; nwg = nM * nN; G = G_; c = c_; }
    __device__ bool next(int i, Unit& u) const {
        const long L = (long)i * G + c; if (L >= nwg) return false;
        int wgid = (int)L; { const int q = nwg / NXCD, r = nwg % NXCD, xcd = wgid % NXCD, off = wgid / NXCD; wgid = (xcd < r ? xcd * (q + 1) : r * (q + 1) + (xcd - r) * q) + off; }
        const int nig = WGM * nN, gid = wgid / nig, fm = gid * WGM, gsz = (nM - fm) < WGM ? (nM - fm) : WGM;
        u.pm = fm + ((wgid % nig) % gsz); u.pn = (wgid % nig) / gsz; return true;
    }
};
template <class Epi>
__device__ __forceinline__ void gemm_phase(const TC tc, LAS unsigned char* lds, const Gemm g, const StaticOrder& S, const Epi& E) {
    const int tid = tc.tid, wid = __builtin_amdgcn_readfirstlane(tid >> 6), lane = tid & 63, wr = wid >> 2, wc = wid & 3, fr = lane & 15, fq = lane >> 4;
    const int K = g.K, nt = K / BK, lda = g.lda;
    unsigned voffA[2], voffB[2];
#pragma unroll
    for (int i = 0; i < 2; ++i) { int R, C; stage_rc(tid * 16 + i * 8192, R, C); const int Rb = Epi::PERM ? ((R & ~31) + perm32(R & 31)) : R;
        voffA[i] = (unsigned)(R * lda + C) * 2u; voffB[i] = (unsigned)(Rb * K + C) * 2u; }
    const size_t kstep = (size_t)(BK * 2);
    const size_t hstepA = (size_t)HALF * lda * 2, hstepB = (size_t)HALF * K * 2;
    const size_t tstepA = 2 * hstepA, tstepB = 2 * hstepB;
    const unsigned ldsw = (unsigned)wid * 1024u;
    const int aoff = lds_byte(wr * 64 + fr, fq * 8), boff = lds_byte(wc * 32 + fr, fq * 8);
#define PG8_SA(b, h) (((b) * 2 + (h)) * HTB)
#define PG8_SB(b, h) ((4 + (b) * 2 + (h)) * HTB)
#define PG8_STAGE(bufoff, gbase, voff) do { _Pragma("unroll") for (int _i = 0; _i < 2; ++_i) \
        __builtin_amdgcn_global_load_lds((const unsigned*)((const char*)(gbase) + (voff)[_i]), (LAS unsigned*)(lds + (bufoff) + ldsw + _i * 8192), 16, 0, 0); } while (0)
#define PG8_LDA(dst, b, h) do { _Pragma("unroll") for (int m = 0; m < 4; ++m) _Pragma("unroll") for (int k = 0; k < 2; ++k) dst[m][k] = *(const LAS bf16x8*)(lds + PG8_SA(b, h) + aoff + m * 2048 + k * 1024); } while (0)
#define PG8_LDB(dst, b, h) do { _Pragma("unroll") for (int n = 0; n < 2; ++n) _Pragma("unroll") for (int k = 0; k < 2; ++k) dst[n][k] = *(const LAS bf16x8*)(lds + PG8_SB(b, h) + boff + n * 2048 + k * 1024); } while (0)
#define PG8_MMA(ai, bj, At, Bt) do { __builtin_amdgcn_s_setprio(1); _Pragma("unroll") for (int m = 0; m < 4; ++m) _Pragma("unroll") for (int n = 0; n < 2; ++n) _Pragma("unroll") for (int k = 0; k < 2; ++k) \
        acc[ai][bj][m][n] = __builtin_amdgcn_mfma_f32_16x16x32_bf16(Bt[n][k], At[m][k], acc[ai][bj][m][n], 0, 0, 0); __builtin_amdgcn_s_setprio(0); } while (0)
#define PG8_WAIT_V(n) asm volatile("s_waitcnt vmcnt(" #n ")" ::: "memory")
#define PG8_WAIT_L(n) asm volatile("s_waitcnt lgkmcnt(" #n ")" ::: "memory")
#define PG8_BAR __builtin_amdgcn_s_barrier()
#define PG8_SCHED __builtin_amdgcn_sched_barrier(0)
    Unit cur, nxt; int ui = 0;
    if (!S.next(0, cur)) return;
    f32x4 acc[2][2][4][2];
#pragma unroll
    for (int a = 0; a < 2; ++a)
#pragma unroll
        for (int b = 0; b < 2; ++b)
#pragma unroll
            for (int m = 0; m < 4; ++m)
#pragma unroll
                for (int n = 0; n < 2; ++n) acc[a][b][m][n] = (f32x4){0.f, 0.f, 0.f, 0.f};
    bf16x8 At[4][2], B0[2][2], B1[2][2];
    const char* cA = (const char*)g.A + (size_t)cur.pm * tstepA; const char* cB = (const char*)g.Bt + (size_t)cur.pn * tstepB;
    PG8_STAGE(PG8_SB(0, 0), cB, voffB); PG8_STAGE(PG8_SB(0, 1), cB + hstepB, voffB); PG8_STAGE(PG8_SA(0, 0), cA, voffA); PG8_STAGE(PG8_SA(0, 1), cA + hstepA, voffA);
    if (wr == 1) PG8_BAR;
    PG8_WAIT_V(2); PG8_BAR;
    PG8_STAGE(PG8_SB(1, 0), cB + kstep, voffB); PG8_STAGE(PG8_SA(1, 0), cA + kstep, voffA); PG8_STAGE(PG8_SB(1, 1), cB + hstepB + kstep, voffB);
    PG8_WAIT_V(6); PG8_BAR;
    for (;;) {
        const bool has_next = S.next(ui + 1, nxt);
        const char* nA = has_next ? (const char*)g.A + (size_t)nxt.pm * tstepA : cA; const char* nB = has_next ? (const char*)g.Bt + (size_t)nxt.pn * tstepB : cB;
        for (int t = 0; t < nt; t += 2) {
            const bool last = (t == nt - 2);
            const char* a1 = cA + (size_t)(t + 1) * kstep;
            const char* a2 = last ? nA : cA + (size_t)(t + 2) * kstep; const char* b2 = last ? nB : cB + (size_t)(t + 2) * kstep;
            const char* a3 = a2 + kstep; const char* b3 = b2 + kstep;
            PG8_LDB(B0, 0, 0); PG8_LDB(B1, 0, 1); PG8_SCHED; PG8_LDA(At, 0, 0); PG8_STAGE(PG8_SA(1, 1), a1 + hstepA, voffA);
            PG8_WAIT_V(8); PG8_WAIT_L(0); PG8_BAR; PG8_MMA(0, 0, At, B0); PG8_MMA(0, 1, At, B1); PG8_BAR; PG8_SCHED;
            PG8_LDA(At, 0, 1); PG8_STAGE(PG8_SB(0, 0), b2, voffB); PG8_STAGE(PG8_SB(0, 1), b2 + hstepB, voffB); PG8_STAGE(PG8_SA(0, 0), a2, voffA);
            PG8_WAIT_V(8); PG8_WAIT_L(0); PG8_BAR; PG8_MMA(1, 0, At, B0); PG8_MMA(1, 1, At, B1); PG8_BAR; PG8_SCHED;
            PG8_LDB(B0, 1, 0); PG8_LDB(B1, 1, 1); PG8_SCHED; PG8_LDA(At, 1, 0); PG8_STAGE(PG8_SA(0, 1), a2 + hstepA, voffA);
            PG8_WAIT_V(8); PG8_WAIT_L(0); PG8_BAR; PG8_MMA(0, 0, At, B0); PG8_MMA(0, 1, At, B1); PG8_BAR; PG8_SCHED;
            PG8_LDA(At, 1, 1); PG8_STAGE(PG8_SB(1, 0), b3, voffB); PG8_STAGE(PG8_SB(1, 1), b3 + hstepB, voffB); PG8_STAGE(PG8_SA(1, 0), a3, voffA);
            PG8_WAIT_V(8); PG8_WAIT_L(0); PG8_BAR; PG8_MMA(1, 0, At, B0); PG8_MMA(1, 1, At, B1); PG8_BAR; PG8_SCHED;
        }
        if (wr == 0) PG8_BAR;
        E(acc, cur, wr, wc, fr, fq);
        if (!has_next) break;
#pragma unroll
        for (int a = 0; a < 2; ++a)
#pragma unroll
            for (int b = 0; b < 2; ++b)
#pragma unroll
                for (int m = 0; m < 4; ++m)
#pragma unroll
                    for (int n = 0; n < 2; ++n) acc[a][b][m][n] = (f32x4){0.f, 0.f, 0.f, 0.f};
        cur = nxt; cA = nA; cB = nB; ++ui;
        if (wr == 1) PG8_BAR;
    }
    PG8_WAIT_V(0);
    PG8_BAR;
#undef PG8_SA
#undef PG8_SB
#undef PG8_STAGE
#undef PG8_LDA
#undef PG8_LDB
#undef PG8_MMA
#undef PG8_WAIT_V
#undef PG8_WAIT_L
#undef PG8_BAR
#undef PG8_SCHED
}

template <int ACT> struct EpiBf {
    static constexpr bool PERM = true;
    bf16_t* O; int ldc;
    __device__ __forceinline__ void operator()(const f32x4 (&acc)[2][2][4][2], const Unit& u, int wr, int wc, int fr, int fq) const {
        const int row0 = u.pm * BM + wr * 64 + fr, col0 = u.pn * BM + wc * 32 + 8 * fq;
#pragma unroll
        for (int ai = 0; ai < 2; ++ai)
#pragma unroll
            for (int m = 0; m < 4; ++m) { bf16_t* rowp = O + (size_t)(row0 + ai * HALF + m * 16) * ldc + col0;
#pragma unroll
                for (int bj = 0; bj < 2; ++bj) { f32x4 v0 = acc[ai][bj][m][0], v1 = acc[ai][bj][m][1];
                    if (ACT == 1) {
#pragma unroll
                        for (int e = 0; e < 4; ++e) { const float a = fmaxf(v0[e], 0.f), b = fmaxf(v1[e], 0.f); v0[e] = a * a; v1[e] = b * b; } }
                    u32x4 w; w.x = pk2(v0[0], v0[1]); w.y = pk2(v0[2], v0[3]); w.z = pk2(v1[0], v1[1]); w.w = pk2(v1[2], v1[3]);
                    *(u32x4*)(rowp + bj * HALF) = w; } }
    }
};
struct EpiRes {
    static constexpr bool PERM = false;
    const float* in_lat; const float* in_ctx; float* out_lat; float* out_ctx; const float* gate; int pm_off;
    __device__ __forceinline__ void operator()(const f32x4 (&acc)[2][2][4][2], const Unit& u, int wr, int wc, int fr, int fq) const {
        const int gpm = u.pm + pm_off;
        const float* rin; float* rout; int v;
        if (gpm < 8) { rin = in_ctx + (size_t)gpm * 256 * DM; rout = out_ctx + (size_t)gpm * 256 * DM; v = 8; }
        else { rin = in_lat + (size_t)(gpm - 8) * 256 * DM; rout = out_lat + (size_t)(gpm - 8) * 256 * DM; v = (gpm - 8) >> 4; }
        const int col0 = u.pn * BM + wc * 32 + 4 * fq;
        const float* gp = gate + (size_t)v * 6144 + col0;
        f32x4 gv[2][2];
#pragma unroll
        for (int bj = 0; bj < 2; ++bj)
#pragma unroll
            for (int n = 0; n < 2; ++n) gv[bj][n] = *(const f32x4*)(gp + bj * HALF + n * 16);
#pragma unroll
        for (int ai = 0; ai < 2; ++ai)
#pragma unroll
            for (int m = 0; m < 4; ++m) { const size_t off = (size_t)(ai * HALF + wr * 64 + m * 16 + fr) * DM + col0;
#pragma unroll
                for (int bj = 0; bj < 2; ++bj)
#pragma unroll
                    for (int n = 0; n < 2; ++n) { const f32x4 x = *(const f32x4*)(rin + off + bj * HALF + n * 16); *(f32x4*)(rout + off + bj * HALF + n * 16) = x + gv[bj][n] * acc[ai][bj][m][n]; }
                asm volatile("" ::: "memory"); }
    }
};
}

__device__ __forceinline__ void transpose_item(const float* W, int ldw, int c0, int K, bf16_t* WT, int nblk, LAS float* scr, int item, int lane) {
    const int kb = item / nblk, nb = item % nblk, k0 = 64 * kb, n0 = 32 * nb;
#pragma unroll 8
    for (int i = 0; i < 32; ++i) { const int kk = 2 * i + (lane >> 5); scr[kk * 33 + (lane & 31)] = W[(size_t)(k0 + kk) * ldw + c0 + n0 + (lane & 31)]; }
    asm volatile("s_waitcnt lgkmcnt(0)" ::: "memory");
    const int c = lane & 7;
#pragma unroll
    for (int j = 0; j < 4; ++j) { const int n = (lane >> 3) + 8 * j; const LAS float* s = scr + (8 * c) * 33 + n;
        u32x4 o; o.x = pk2(s[0 * 33], s[1 * 33]); o.y = pk2(s[2 * 33], s[3 * 33]); o.z = pk2(s[4 * 33], s[5 * 33]); o.w = pk2(s[6 * 33], s[7 * 33]);
        *(u32x4*)(WT + (size_t)(n0 + n) * K + k0 + 8 * c) = o; }
    asm volatile("s_waitcnt lgkmcnt(0)" ::: "memory");
}

__device__ __forceinline__ void phase_prologue(const TC tc, KP P, LAS unsigned char* lds) {
    const int tid = tc.tid, lane = tid & 63, wave = tid >> 6;
    const int G = tc.G, gw = tc.bid * 8 + wave, NGW = G * 8;
    unsigned char* ws = P->ws;
    {
        LAS float* scr = (LAS float*)(lds + wave * 8704);
        constexpr int I_IN_A = 16 * 104, I_IN_B = 16 * 8, I_OUT = 16 * 32, I_1 = 16 * 128, I_2 = 64 * 32, I_G = 4 * 8;
        constexpr int I_L = I_IN_A + I_IN_B + I_OUT + I_1 + I_2 + I_G;
        for (int it = gw; it < 2 * I_L; it += NGW) {
            const int l = it / I_L; int r = it % I_L;
            unsigned char* wl = ws + WS_W + (size_t)l * SZ_WL;
            bf16_t* win = (bf16_t*)wl; bf16_t* wout = (bf16_t*)(wl + SZ_WIN); bf16_t* w1 = (bf16_t*)(wl + SZ_WIN + SZ_WOUT); bf16_t* w2 = (bf16_t*)(wl + SZ_WIN + SZ_WOUT + SZ_W1);
            bf16_t* wg = (bf16_t*)(wl + SZ_WIN + SZ_WOUT + SZ_W1 + SZ_W2);
            if (r < I_IN_A) { transpose_item(P->in[8] + (size_t)l * DM * DIN, DIN, 0, DM, win, 104, scr, r, lane); continue; } r -= I_IN_A;
            if (r < I_IN_B) { transpose_item(P->in[8] + (size_t)l * DM * DIN, DIN, 3344, DM, win + (size_t)3328 * DM, 8, scr, r, lane); continue; } r -= I_IN_B;
            if (r < I_OUT) { transpose_item(P->in[26] + (size_t)l * DM * DM, DM, 0, DM, wout, 32, scr, r, lane); continue; } r -= I_OUT;
            if (r < I_1) { transpose_item(P->in[27] + (size_t)l * DM * DFF, DFF, 0, DM, w1, 128, scr, r, lane); continue; } r -= I_1;
            if (r < I_2) { transpose_item(P->in[28] + (size_t)l * DFF * DM, DM, 0, DFF, w2, 32, scr, r, lane); continue; } r -= I_2;
            transpose_item(P->in[24] + (size_t)l * DG * DG, DG, 0, DG, wg, 8, scr, r, lane);
        }
    }
    const int gt = tc.bid * 512 + tid, NGT = G * 512;
    for (int i = gt; i < 2 * 16 * DM; i += NGT) { const int l = i / (16 * DM), c = (i / DM) % 16, k = i % DM;
        ((float*)(ws + WS_W + (size_t)l * SZ_WL + SZ_WL - SZ_WAB))[c * DM + k] = P->in[8][(size_t)l * DM * DIN + (size_t)k * DIN + 3328 + c]; }
    for (int i = gt; i < TSEQ * 32; i += NGT) { const int pos = i >> 5, f = i & 31;
        const float inv = powf(10000.0f, -(float)f / 32.0f); const float ang = (float)pos * inv; float s, c; sincosf(ang, &s, &c);
        ((f32x2*)(ws + WS_ROPE))[i] = (f32x2){c, s}; }
    for (int i = gt; i < 2 * DG; i += NGT) { const float a = P->in[9][i], b = P->in[9][2 * DG + i]; const float mx = fmaxf(a, b), ea = expf(a - mx), eb = expf(b - mx);
        float* lb = (float*)(ws + WS_LB); lb[i] = 0.f; lb[2 * DG + i] = eb / (ea + eb); }
    for (int i = gt; i < 2 * 2 * 16 * 64; i += NGT) { const int p = i & 63, g = (i >> 6) & 15, d = (i >> 10) & 1, l = i >> 11;
        const float lr = P->in[16][i], li = P->in[17][i]; const float dt = expf(P->in[18][(l * 2 + d) * 16 + g]);
        const float mag = expf(lr * dt); float sn, cs; sincosf(li * dt, &sn, &cs); const float ar = mag * cs, ai = mag * sn;
        const float den = lr * lr + li * li, nr = ar - 1.0f, ni = ai; const float fr = (nr * lr + ni * li) / den, fi = (ni * lr - nr * li) / den;
        float* o = (float*)(ws + WS_S5P) + (size_t)i * 34; o[0] = ar; o[1] = ai;
        const float* bre = P->in[19] + ((size_t)(l * 16 + g) * 64 + p) * 16; const float* bim = P->in[20] + ((size_t)(l * 16 + g) * 64 + p) * 16;
        for (int c = 0; c < 16; ++c) { o[2 + c] = fr * bre[c] - fi * bim[c]; o[18 + c] = fr * bim[c] + fi * bre[c]; } }
    __syncthreads();
    {
        LAS float* sc = (LAS float*)lds;
        LAS float* red = (LAS float*)(lds + 36864);
        for (int i = tid; i < 9 * DM; i += 512) { const int v = i >> 10, k = i & 1023; const float x = v < 8 ? P->in[1][v * DM + k] : P->in[3][k]; sc[i] = siluf_(x); }
        __syncthreads();
        for (int item = tc.bid; item < 2 * 96; item += G) {
            const int l = item / 96, cg0 = (item % 96) * 64;
            const int c4 = (tid & 15) * 4, kl = tid >> 4;
            const float* W = P->in[4] + (size_t)l * DM * 6144 + cg0 + c4;
            f32x4 a[9];
#pragma unroll
            for (int v = 0; v < 9; ++v) a[v] = (f32x4){0.f, 0.f, 0.f, 0.f};
            for (int k = kl; k < DM; k += 32) { const f32x4 w = *(const f32x4*)(W + (size_t)k * 6144);
#pragma unroll
                for (int v = 0; v < 9; ++v) a[v] += w * sc[v * DM + k]; }
#pragma unroll
            for (int v = 0; v < 9; ++v) *(LAS f32x4*)(red + kl * 576 + v * 64 + c4) = a[v];
            __syncthreads();
            for (int o = tid; o < 576; o += 512) { float s = 0.f; for (int q = 0; q < 32; ++q) s += red[q * 576 + o];
                const int v = o >> 6, c = cg0 + (o & 63);
                ((float*)(ws + WS_MOD))[((size_t)l * 9 + v) * 6144 + c] = s + P->in[5][l * 6144 + c]; }
            __syncthreads();
        }
    }
}

__device__ __forceinline__ void phase_norm(const TC tc, KP P, LAS unsigned char* lds, int l, int which, const float* src_lat, const float* src_ctx, int r0, bool do_ab) {
    const int tid = tc.tid, lane = tid & 63, wave = tid >> 6;
    const int gw = tc.bid * 8 + wave, NGW = tc.G * 8;
    unsigned char* ws = P->ws;
    LAS float* wab = (LAS float*)lds;
    if (do_ab) { const float* src = (const float*)(ws + WS_W + (size_t)l * SZ_WL + SZ_WL - SZ_WAB);
        for (int i = tid; i < 16 * DM / 4; i += 512) ((LAS f32x4*)wab)[i] = ((const f32x4*)src)[i];
        __syncthreads(); }
    const float* gvec = P->in[which ? 7 : 6] + l * DM;
    const float* mod = (const float*)(ws + WS_MOD) + (size_t)l * 9 * 6144;
    bf16_t* H = (bf16_t*)(ws + WS_HB);
    float* AB = (float*)(ws + WS_AB);
    const int per = (MALL - r0 + NGW - 1) / NGW, rbeg = r0 + gw * per, rend = (rbeg + per < MALL) ? rbeg + per : MALL;
    int vcur = -1; f32x4 gs[4], sh[4], x[4], nx[4];
    auto rowptr = [&](int r) -> const float* { return r < MCTX ? src_ctx + (size_t)r * DM : src_lat + (size_t)(r - MCTX) * DM; };
    if (rbeg < rend) {
#pragma unroll
        for (int j = 0; j < 4; ++j) nx[j] = ((const f32x4*)rowptr(rbeg))[j * 64 + lane]; }
    for (int r = rbeg; r < rend; ++r) {
        const int v = r < MCTX ? 8 : (r - MCTX) >> 12;
#pragma unroll
        for (int j = 0; j < 4; ++j) x[j] = nx[j];
        if (r + 1 < rend) {
#pragma unroll
            for (int j = 0; j < 4; ++j) nx[j] = ((const f32x4*)rowptr(r + 1))[j * 64 + lane]; }
        if (v != vcur) { vcur = v;
            const float* shp = mod + (size_t)v * 6144 + (which ? 3 : 0) * DM; const float* scl = mod + (size_t)v * 6144 + (which ? 4 : 1) * DM;
#pragma unroll
            for (int j = 0; j < 4; ++j) { gs[j] = ((const f32x4*)gvec)[j * 64 + lane] * (1.0f + ((const f32x4*)scl)[j * 64 + lane]); sh[j] = ((const f32x4*)shp)[j * 64 + lane]; } }
        float ss = 0.f;
#pragma unroll
        for (int j = 0; j < 4; ++j) ss += (x[j].x * x[j].x + x[j].y * x[j].y) + (x[j].z * x[j].z + x[j].w * x[j].w);
        const float rstd = rsqrtf(wave_sum(ss) * (1.0f / DM) + EPS);
#pragma unroll
        for (int j = 0; j < 4; ++j) { x[j] = x[j] * rstd * gs[j] + sh[j];
            u32x2 w; w.x = pk2(x[j].x, x[j].y); w.y = pk2(x[j].z, x[j].w);
            ((u32x2*)(H + (size_t)r * DM))[j * 64 + lane] = w; }
        if (do_ab) {
#pragma unroll 1
            for (int cq = 0; cq < 4; ++cq) {
                float p[4];
#pragma unroll
                for (int c = 0; c < 4; ++c) { float a = 0.f;
#pragma unroll
                    for (int j = 0; j < 4; ++j) { const f32x4 w = *(const LAS f32x4*)(wab + (cq * 4 + c) * DM + (j * 64 + lane) * 4); a += (x[j].x * w.x + x[j].y * w.y) + (x[j].z * w.z + x[j].w * w.w); }
                    p[c] = a; }
                bool bb = (lane & 32) != 0;
                { const float k0 = bb ? p[2] : p[0], s0 = bb ? p[0] : p[2], k1 = bb ? p[3] : p[1], s1 = bb ? p[1] : p[3]; p[0] = k0 + __shfl_xor(s0, 32); p[1] = k1 + __shfl_xor(s1, 32); }
                bb = (lane & 16) != 0;
                { const float k0 = bb ? p[1] : p[0], s0 = bb ? p[0] : p[1]; p[0] = k0 + __shfl_xor(s0, 16); }
                float tot = p[0];
                tot += __shfl_xor(tot, 8); tot += __shfl_xor(tot, 4); tot += __shfl_xor(tot, 2); tot += __shfl_xor(tot, 1);
                if ((lane & 15) == 0) { const int c = cq * 4 + 2 * ((lane >> 5) & 1) + ((lane >> 4) & 1);
                    float o;
                    if (c < 8) { const int d = c >> 2, h = c & 3; const float xx = tot + P->in[14][(l * 2 + d) * 4 + h]; const float sp = xx > 20.f ? xx : log1pf(expf(xx));
                        o = -expf(P->in[13][(l * 2 + d) * 4 + h]) * sp; }
                    else o = 1.0f / (1.0f + expf(-tot));
                    AB[(size_t)r * 16 + c] = o; }
            }
        }
    }
}

__device__ __forceinline__ void phase_mixpre(const TC tc, KP P, int l) {
    const int tid = tc.tid, lane = tid & 63, wave = tid >> 6;
    const int gw = tc.bid * 8 + wave, NGW = tc.G * 8;
    unsigned char* ws = P->ws;
    bf16_t* Z = (bf16_t*)(ws + WS_Z);
    bf16_t* QC = (bf16_t*)(ws + WS_HB);
    const float* lb = (const float*)(ws + WS_LB) + l * 2 * DG;
    const f32x2* rope = (const f32x2*)(ws + WS_ROPE);
    const float* cw = P->in[12] + (size_t)l * 9 * 768;
    f32x4 cwr[27];
#pragma unroll
    for (int i = 0; i < 27; ++i) cwr[i] = *(const f32x4*)(cw + (i / 3) * 768 + (i % 3) * 256 + lane * 4);
    for (int r = gw; r < MALL; r += NGW) {
        bf16_t* zr = Z + (size_t)r * NZ;
        int pos, b, s; bool isctx = r < MCTX;
        if (isctx) { b = r >> 8; s = r & 255; pos = s; } else { b = (r - MCTX) >> 12; s = (r - MCTX) & 4095; pos = TCTX + s; }
        { u32x2 w = ((u32x2*)(zr + ZC_HQ))[lane];
          w.x = pk2(siluf_(bflo(w.x)) * 0.125f, siluf_(bfhi(w.x)) * 0.125f); w.y = pk2(siluf_(bflo(w.y)) * 0.125f, siluf_(bfhi(w.y)) * 0.125f);
          ((u32x2*)(zr + ZC_HQ))[lane] = w; }
        { u32x4 w = ((u32x4*)(zr + ZC_HF))[lane]; const int c0 = lane * 8; unsigned* pw = (unsigned*)&w;
#pragma unroll
          for (int e = 0; e < 4; ++e) { const int c = c0 + 2 * e;
              const float f0 = bflo(pw[e]), f1 = bfhi(pw[e]);
              const float l0 = fmaxf(lb[c], 1e-30f), l1 = fmaxf(lb[c + 1], 1e-30f);
              const float s0 = 1.0f / (1.0f + expf(-f0)), s1 = 1.0f / (1.0f + expf(-f1));
              pw[e] = pk2(logf(l0 * (1.0f - s0) + s0), logf(l1 * (1.0f - s1) + s1)); }
          ((u32x4*)(zr + ZC_HF))[lane] = w; }
        {
#pragma unroll
          for (int qk = 0; qk < 2; ++qk) { bf16_t* base = zr + (qk ? ZC_RK : ZC_RQ) + (lane >> 4) * 64 + (lane & 15) * 2;
              const unsigned w1 = *(const unsigned*)base, w2 = *(const unsigned*)(base + 32);
              const f32x2 cs0 = rope[pos * 32 + (lane & 15) * 2], cs1 = rope[pos * 32 + (lane & 15) * 2 + 1];
              const float sc = qk ? 0.125f : 1.0f;
              const float a0 = bflo(w1), a1 = bfhi(w1), b0 = bflo(w2), b1 = bfhi(w2);
              *(unsigned*)base = pk2((a0 * cs0.x - b0 * cs0.y) * sc, (a1 * cs1.x - b1 * cs1.y) * sc);
              *(unsigned*)(base + 32) = pk2((a0 * cs0.y + b0 * cs0.x) * sc, (a1 * cs1.y + b1 * cs1.x) * sc); } }
        {
            float acc[3][4];
#pragma unroll
            for (int g = 0; g < 3; ++g)
#pragma unroll
                for (int e = 0; e < 4; ++e) acc[g][e] = 0.f;
            const int gx = isctx ? s : (s & 63), gy = isctx ? 0 : (s >> 6), W = isctx ? TCTX : 64, Hh = isctx ? 1 : 64;
#pragma unroll
            for (int dy = 0; dy < 3; ++dy) { const int yy = gy + dy - 1; if (yy < 0 || yy >= Hh) continue;
#pragma unroll
                for (int dx = 0; dx < 3; ++dx) { const int xx = gx + dx - 1; if (xx < 0 || xx >= W) continue;
                    const int rr = r + (dy - 1) * 64 + (dx - 1);
                    const bf16_t* zn = Z + (size_t)rr * NZ + ZC_GQKV + lane * 4;
#pragma unroll
                    for (int g = 0; g < 3; ++g) { const u32x2 w = *(const u32x2*)(zn + g * 256); const f32x4 k = cwr[(dy * 3 + dx) * 3 + g];
                        acc[g][0] += bflo(w.x) * k.x; acc[g][1] += bfhi(w.x) * k.y; acc[g][2] += bflo(w.y) * k.z; acc[g][3] += bfhi(w.y) * k.w; } } }
#pragma unroll
            for (int g = 0; g < 3; ++g) {
#pragma unroll
                for (int e = 0; e < 4; ++e) acc[g][e] = siluf_(acc[g][e]);
                if (g < 2) { float ss = (acc[g][0] * acc[g][0] + acc[g][1] * acc[g][1]) + (acc[g][2] * acc[g][2] + acc[g][3] * acc[g][3]);
                    ss += __shfl_xor(ss, 1); ss += __shfl_xor(ss, 2); ss += __shfl_xor(ss, 4); ss += __shfl_xor(ss, 8);
                    const float rn = rsqrtf(ss + EPS) * (g == 0 ? 0.125f : 1.0f);
#pragma unroll
                    for (int e = 0; e < 4; ++e) acc[g][e] *= rn; }
                u32x2 w; w.x = pk2(acc[g][0], acc[g][1]); w.y = pk2(acc[g][2], acc[g][3]);
                *(u32x2*)(QC + (size_t)r * 768 + g * 256 + lane * 4) = w; }
        }
    }
}

constexpr int TB = 32, NBATCH = TSEQ / TB;
constexpr int CH_ARR = TB * 64 * 4;
constexpr int CH_BUF = 4 * CH_ARR + 256;
constexpr int CH_OS = 2 * CH_BUF;
static_assert(CH_OS + 2 * CH_ARR <= LDS_BYTES, "chain LDS");

template <int KIND>
__device__ __forceinline__ void chain_matrix(const TC tc, KP P, LAS unsigned char* lds, int l, int chain) {
    const int tid = tc.tid, lane = tid & 63, wave = tid >> 6;
    const int b = chain >> 3, h = (chain >> 1) & 3, d = chain & 1;
    unsigned char* ws = P->ws;
    const bf16_t* Z = (const bf16_t*)(ws + WS_Z);
    const bf16_t* QC = (const bf16_t*)(ws + WS_HB);
    const float* AB = (const float*)(ws + WS_AB);
    bf16_t* O = (bf16_t*)(ws + (d ? WS_OB : WS_OF));
    const int ocol = KIND * 256 + h * 64;
    const bool loader = wave >= 4;
    const int lt = tid - 256, ltok = lt >> 3, lseg = lt & 7;
    float gam = 0.f;
    if (KIND == 1) gam = 1.0f / (1.0f + expf(-P->in[11][(l * 2 + d) * 4 + h]));
    auto load = [&](int n, int bi) {
        const int row = seq_row(b, d, n * TB + ltok);
        LAS float* base = (LAS float*)(lds + bi * CH_BUF) + ltok * 64 + lseg * 8;
        u32x4 q, k, v;
        if (KIND == 0) { const bf16_t* zr = Z + (size_t)row * NZ + h * 64 + lseg * 8; q = *(const u32x4*)(zr + ZC_HQ); k = *(const u32x4*)(zr + ZC_HF + d * 256); v = *(const u32x4*)(zr + ZC_HI); }
        else if (KIND == 1) { const bf16_t* zr = Z + (size_t)row * NZ + h * 64 + lseg * 8; q = *(const u32x4*)(zr + ZC_RQ); k = *(const u32x4*)(zr + ZC_RK); v = *(const u32x4*)(zr + ZC_RV); }
        else { const bf16_t* qr = QC + (size_t)row * 768 + h * 64 + lseg * 8; q = *(const u32x4*)qr; k = *(const u32x4*)(qr + 256); v = *(const u32x4*)(qr + 512);
            if (lseg == 0) { LAS float* sc = (LAS float*)(lds + bi * CH_BUF + 4 * CH_ARR); sc[ltok * 2] = expf(AB[(size_t)row * 16 + d * 4 + h]); sc[ltok * 2 + 1] = AB[(size_t)row * 16 + 8 + d * 4 + h]; } }
        const unsigned* pq = (const unsigned*)&q; const unsigned* pk = (const unsigned*)&k; const unsigned* pv = (const unsigned*)&v;
#pragma unroll
        for (int e = 0; e < 4; ++e) {
            base[2 * e] = bflo(pq[e]); base[2 * e + 1] = bfhi(pq[e]);
            base[3 * TB * 64 + 2 * e] = bflo(pv[e]); base[3 * TB * 64 + 2 * e + 1] = bfhi(pv[e]);
            if (KIND == 0) { const float l0 = bflo(pk[e]), l1 = bfhi(pk[e]); const float f0 = expf(l0), f1 = expf(l1);
                base[TB * 64 + 2 * e] = f0; base[TB * 64 + 2 * e + 1] = f1; base[2 * TB * 64 + 2 * e] = -expm1f(l0); base[2 * TB * 64 + 2 * e + 1] = -expm1f(l1); }
            else { base[TB * 64 + 2 * e] = bflo(pk[e]); base[TB * 64 + 2 * e + 1] = bfhi(pk[e]); }
        }
    };
    auto store = [&](int n, int bi) {
        const int row = seq_row(b, d, n * TB + ltok);
        const LAS float* os = (const LAS float*)(lds + CH_OS + bi * CH_ARR) + ltok * 64 + lseg * 8;
        u32x4 w; w.x = pk2(os[0], os[1]); w.y = pk2(os[2], os[3]); w.z = pk2(os[4], os[5]); w.w = pk2(os[6], os[7]);
        *(u32x4*)(O + (size_t)row * DM + ocol + lseg * 8) = w;
    };
    float S[16];
#pragma unroll
    for (int i = 0; i < 16; ++i) S[i] = 0.f;
    const int vl = lane >> 2, kg = lane & 3, vcol = (wave & 3) * 16 + vl;
    if (loader) load(0, 0);
    __syncthreads();
    for (int n = 0; n < NBATCH; ++n) {
        if (loader) { if (n + 1 < NBATCH) load(n + 1, (n + 1) & 1); if (n >= 1) store(n - 1, (n - 1) & 1); }
        else {
            const LAS float* A0 = (const LAS float*)(lds + (n & 1) * CH_BUF);
            const LAS float* sc = (const LAS float*)(lds + (n & 1) * CH_BUF + 4 * CH_ARR);
            LAS float* os = (LAS float*)(lds + CH_OS + (n & 1) * CH_ARR);
#pragma unroll 2
            for (int tt = 0; tt < TB; ++tt) {
                const LAS float* a = A0 + tt * 64 + kg * 16;
                float q[16], k[16];
#pragma unroll
                for (int i = 0; i < 4; ++i) { const f32x4 t4 = *(const LAS f32x4*)(a + 4 * i); q[4 * i] = t4.x; q[4 * i + 1] = t4.y; q[4 * i + 2] = t4.z; q[4 * i + 3] = t4.w; }
#pragma unroll
                for (int i = 0; i < 4; ++i) { const f32x4 t4 = *(const LAS f32x4*)(a + TB * 64 + 4 * i); k[4 * i] = t4.x; k[4 * i + 1] = t4.y; k[4 * i + 2] = t4.z; k[4 * i + 3] = t4.w; }
                const float vv = A0[3 * TB * 64 + tt * 64 + vcol];
                float o = 0.f;
                if (KIND == 0) {
                    float kk[16];
#pragma unroll
                    for (int i = 0; i < 4; ++i) { const f32x4 t4 = *(const LAS f32x4*)(a + 2 * TB * 64 + 4 * i); kk[4 * i] = t4.x; kk[4 * i + 1] = t4.y; kk[4 * i + 2] = t4.z; kk[4 * i + 3] = t4.w; }
#pragma unroll
                    for (int i = 0; i < 16; ++i) { S[i] = k[i] * S[i] + kk[i] * vv; o += q[i] * S[i]; }
                } else if (KIND == 1) {
#pragma unroll
                    for (int i = 0; i < 16; ++i) { S[i] = gam * S[i] + k[i] * vv; o += q[i] * S[i]; }
                } else {
                    const float alpha = sc[tt * 2], beta = sc[tt * 2 + 1];
                    float r = 0.f;
#pragma unroll
                    for (int i = 0; i < 16; ++i) r += k[i] * S[i];
                    r = quad_sum(r);
                    const float c = beta * (vv - alpha * r);
#pragma unroll
                    for (int i = 0; i < 16; ++i) { S[i] = alpha * S[i] + k[i] * c; o += q[i] * S[i]; }
                }
                o = quad_sum(o);
                if (kg == 0) os[tt * 64 + vcol] = o;
            }
        }
        __syncthreads();
    }
    if (loader) store(NBATCH - 1, (NBATCH - 1) & 1);
    __syncthreads();
}

constexpr int S5_US = 0, S5_YS = 2 * 4 * TB * 16 * 4;
__device__ __forceinline__ void chain_s5(const TC tc, KP P, LAS unsigned char* lds, int l, int item) {
    const int tid = tc.tid, lane = tid & 63, wave = tid >> 6;
    const int b = item >> 3, d = (item >> 2) & 1, gq = item & 3;
    unsigned char* ws = P->ws;
    const bf16_t* Z = (const bf16_t*)(ws + WS_Z);
    bf16_t* O = (bf16_t*)(ws + (d ? WS_OB : WS_OF));
    const bool loader = wave >= 4;
    const int lt = tid - 256, lch = lt >> 6, ltok = (lt >> 1) & 31, lhalf = lt & 1;
    auto load = [&](int n, int bi) {
        const int row = seq_row(b, d, n * TB + ltok);
        const u32x4 u = *(const u32x4*)(Z + (size_t)row * NZ + ZC_SU + gq * 64 + lch * 16 + lhalf * 8);
        LAS float* us = (LAS float*)(lds + S5_US) + ((bi * 4 + lch) * TB + ltok) * 16 + lhalf * 8; const unsigned* pu = (const unsigned*)&u;
#pragma unroll
        for (int e = 0; e < 4; ++e) { us[2 * e] = bflo(pu[e]); us[2 * e + 1] = bfhi(pu[e]); }
    };
    auto store = [&](int n, int bi) {
        const int row = seq_row(b, d, n * TB + ltok);
        const LAS float* ys = (const LAS float*)(lds + S5_YS) + ((bi * 4 + lch) * TB + ltok) * 16 + lhalf * 8;
        u32x4 w; w.x = pk2(ys[0], ys[1]); w.y = pk2(ys[2], ys[3]); w.z = pk2(ys[4], ys[5]); w.w = pk2(ys[6], ys[7]);
        *(u32x4*)(O + (size_t)row * DM + 768 + gq * 64 + lch * 16 + lhalf * 8) = w;
    };
    float bre[16], bim[16], cre[16], cim[16], ar = 0.f, ai = 0.f, hr = 0.f, hi = 0.f;
    if (!loader) {
        const int g = gq * 4 + wave;
        const float* sp = (const float*)(ws + WS_S5P) + ((size_t)((l * 2 + d) * 16 + g) * 64 + lane) * 34;
        ar = sp[0]; ai = sp[1];
#pragma unroll
        for (int c = 0; c < 16; ++c) { bre[c] = sp[2 + c]; bim[c] = sp[18 + c];
            cre[c] = P->in[21][((size_t)(l * 16 + g) * 16 + c) * 64 + lane]; cim[c] = P->in[22][((size_t)(l * 16 + g) * 16 + c) * 64 + lane]; }
    }
    if (loader) load(0, 0);
    __syncthreads();
    for (int n = 0; n < NBATCH; ++n) {
        if (loader) { if (n + 1 < NBATCH) load(n + 1, (n + 1) & 1); if (n >= 1) store(n - 1, (n - 1) & 1); }
        else {
            const LAS float* us = (const LAS float*)(lds + S5_US) + (((n & 1) * 4 + wave) * TB) * 16;
            LAS float* ys = (LAS float*)(lds + S5_YS) + (((n & 1) * 4 + wave) * TB) * 16;
            for (int tt = 0; tt < TB; ++tt) {
                float u[16];
#pragma unroll
                for (int i = 0; i < 4; ++i) { const f32x4 t4 = *(const LAS f32x4*)(us + tt * 16 + 4 * i); u[4 * i] = t4.x; u[4 * i + 1] = t4.y; u[4 * i + 2] = t4.z; u[4 * i + 3] = t4.w; }
                float xr = 0.f, xi = 0.f;
#pragma unroll
                for (int c = 0; c < 16; ++c) { xr += bre[c] * u[c]; xi += bim[c] * u[c]; }
                const float nhr = ar * hr - ai * hi + xr, nhi = ar * hi + ai * hr + xi; hr = nhr; hi = nhi;
                float p[16];
#pragma unroll
                for (int c = 0; c < 16; ++c) p[c] = cre[c] * hr - cim[c] * hi;
                const float tot = reduce16(p, lane);
                if ((lane & 3) == 0) { const int c = 8 * ((lane >> 5) & 1) + 4 * ((lane >> 4) & 1) + 2 * ((lane >> 3) & 1) + ((lane >> 2) & 1); ys[tt * 16 + c] = tot; }
            }
        }
        __syncthreads();
    }
    if (loader) store(NBATCH - 1, (NBATCH - 1) & 1);
    __syncthreads();
}

namespace mx {
constexpr int PITCH = 144, IMG = 64 * PITCH;
__device__ __forceinline__ bf16x8 frag(const LAS unsigned char* img, int t, int ks, int fr, int fq) { return *(const LAS bf16x8*)(img + (t * 16 + fr) * PITCH + (ks * 32 + fq * 8) * 2); }
__device__ __forceinline__ void store4(LAS unsigned char* img, int row, int col0, float a, float b, float c, float d) { u32x2 w; w.x = pk2(a, b); w.y = pk2(c, d); *(LAS u32x2*)(img + row * PITCH + col0 * 2) = w; }
__device__ __forceinline__ float bfe(const u32x2& w, int e) { return e == 0 ? bflo(w.x) : e == 1 ? bfhi(w.x) : e == 2 ? bflo(w.y) : bfhi(w.y); }
__device__ __forceinline__ unsigned rawe(const u32x2& w, int e) { return e == 0 ? (w.x & 0xffffu) : e == 1 ? (w.x >> 16) : e == 2 ? (w.y & 0xffffu) : (w.y >> 16); }
__device__ __forceinline__ void tile10(int idx, int& mt, int& nt) { nt = idx >= 6 ? 3 : idx >= 3 ? 2 : idx >= 1 ? 1 : 0; mt = idx - (nt * (nt + 1)) / 2; }
}
#define MFMA16(a, b, c) __builtin_amdgcn_mfma_f32_16x16x32_bf16(a, b, c, 0, 0, 0)
__device__ __forceinline__ float ex2(float x) { return __builtin_amdgcn_exp2f(x); }
__device__ __forceinline__ float exn(float x) { return __builtin_amdgcn_exp2f(x * 1.4426950408889634f); }

__device__ __forceinline__ void lin_attn_os(const LAS unsigned char* Qg, const LAS unsigned char* VT, const LAS unsigned char* Pm, const LAS unsigned char* KdT, const LAS unsigned char* STc, LAS unsigned char* STn,
                                           f32x4& S0, f32x4& S1, const f32x4 dec, bf16_t* Og, int r0, int dirs, int ocol, int wave, int fr, int fq) {
    const int mt = wave & 3, n0 = wave >> 2, n1 = n0 + 2;
    const bf16x8 vx0 = mx::frag(VT, mt, 0, fr, fq), vx1 = mx::frag(VT, mt, 1, fr, fq), sx0 = mx::frag(STc, mt, 0, fr, fq), sx1 = mx::frag(STc, mt, 1, fr, fq), kx0 = mx::frag(KdT, mt, 0, fr, fq), kx1 = mx::frag(KdT, mt, 1, fr, fq);
    const bf16x8 pa0 = mx::frag(Pm, n0, 0, fr, fq), pa1 = mx::frag(Pm, n0, 1, fr, fq), pb0 = mx::frag(Pm, n1, 0, fr, fq), pb1 = mx::frag(Pm, n1, 1, fr, fq);
    const bf16x8 qa0 = mx::frag(Qg, n0, 0, fr, fq), qa1 = mx::frag(Qg, n0, 1, fr, fq), qb0 = mx::frag(Qg, n1, 0, fr, fq), qb1 = mx::frag(Qg, n1, 1, fr, fq);
    const bf16x8 va0 = mx::frag(VT, n0, 0, fr, fq), va1 = mx::frag(VT, n0, 1, fr, fq), vb0 = mx::frag(VT, n1, 0, fr, fq), vb1 = mx::frag(VT, n1, 1, fr, fq);
    f32x4 oa = (f32x4){0.f, 0.f, 0.f, 0.f}, ob = oa, sa = S0 * dec, sb = S1 * dec;
    oa = MFMA16(vx0, pa0, oa); ob = MFMA16(vx0, pb0, ob); sa = MFMA16(kx0, va0, sa); sb = MFMA16(kx0, vb0, sb);
    oa = MFMA16(vx1, pa1, oa); ob = MFMA16(vx1, pb1, ob); sa = MFMA16(kx1, va1, sa); sb = MFMA16(kx1, vb1, sb);
    oa = MFMA16(sx0, qa0, oa); ob = MFMA16(sx0, qb0, ob);
    oa = MFMA16(sx1, qa1, oa); ob = MFMA16(sx1, qb1, ob);
    S0 = sa; S1 = sb;
    mx::store4(STn, n0 * 16 + fr, mt * 16 + fq * 4, sa[0], sa[1], sa[2], sa[3]);
    mx::store4(STn, n1 * 16 + fr, mt * 16 + fq * 4, sb[0], sb[1], sb[2], sb[3]);
    { const unsigned off = (unsigned)(r0 + dirs * (n0 * 16 + fr)) * DM + ocol + mt * 16 + fq * 4; u32x2 w; w.x = pk2(oa[0], oa[1]); w.y = pk2(oa[2], oa[3]); *(u32x2*)(Og + off) = w; }
    { const unsigned off = (unsigned)(r0 + dirs * (n1 * 16 + fr)) * DM + ocol + mt * 16 + fq * 4; u32x2 w; w.x = pk2(ob[0], ob[1]); w.y = pk2(ob[2], ob[3]); *(u32x2*)(Og + off) = w; }
}

__device__ __forceinline__ void chain_ret(const TC tc, KP P, LAS unsigned char* lds, int l, int chain) {
    const int tid = tc.tid, lane = tid & 63, wave = __builtin_amdgcn_readfirstlane(tid >> 6), fr = lane & 15, fq = lane >> 4;
    const int b = chain >> 3, h = (chain >> 1) & 3, d = chain & 1;
    unsigned char* ws = P->ws;
    const bf16_t* Z = (const bf16_t*)(ws + WS_Z);
    bf16_t* Og = (bf16_t*)(ws + (d ? WS_OB : WS_OF));
    const int ocol = 256 + h * 64;
    const float gam = 1.0f / (1.0f + expf(-P->in[11][(l * 2 + d) * 4 + h])), lg2 = log2f(gam);
    LAS unsigned char* Qn = lds; LAS unsigned char* Kn = lds + mx::IMG; LAS unsigned char* Qg = lds + 2 * mx::IMG; LAS unsigned char* VT = lds + 3 * mx::IMG; LAS unsigned char* KdT = lds + 4 * mx::IMG;
    LAS unsigned char* Pm = lds + 5 * mx::IMG; LAS unsigned char* ST = lds + 6 * mx::IMG;
    for (int i = tid; i < 3 * mx::IMG / 16; i += 512) *(LAS u32x4*)(Pm + i * 16) = (u32x4){0u, 0u, 0u, 0u};
    f32x4 S0 = (f32x4){0.f, 0.f, 0.f, 0.f}, S1 = S0;
    const f32x4 dec = (f32x4){1.f, 1.f, 1.f, 1.f} * exp2f(64.0f * lg2);
    const int tok = tid >> 3, seg = tid & 7, tp = tid & 31, fs = tid >> 5;
    struct RS { u32x4 rq, rk; u32x2 rv0, rv1, rk0, rk1; };
    RS RA, RB;
    auto fetch = [&](int p, RS& R) {
        auto& rq = R.rq; auto& rk = R.rk; auto& rv0 = R.rv0; auto& rv1 = R.rv1; auto& rk0 = R.rk0; auto& rk1 = R.rk1;
        const int r0 = seq_row0(b, d, p * 64), dirs = d ? -1 : 1;
        const bf16_t* zr = Z + ((unsigned)(r0 + dirs * tok) * NZ + h * 64 + seg * 8);
        rq = *(const u32x4*)(zr + ZC_RQ); rk = *(const u32x4*)(zr + ZC_RK);
        const bf16_t* z0 = Z + ((unsigned)(r0 + dirs * 2 * tp) * NZ + h * 64 + fs * 4); const bf16_t* z1 = z0 + dirs * NZ;
        rv0 = *(const u32x2*)(z0 + ZC_RV); rv1 = *(const u32x2*)(z1 + ZC_RV); rk0 = *(const u32x2*)(z0 + ZC_RK); rk1 = *(const u32x2*)(z1 + ZC_RK);
    };
    const float sc = ex2((float)(tok + 1) * lg2), s0 = ex2((float)(63 - 2 * tp) * lg2), s1 = ex2((float)(62 - 2 * tp) * lg2);
    int pmt[2], pnt[2]; float pf[2][4];
#pragma unroll
    for (int hh = 0; hh < 2; ++hh) { int idx = wave + 8 * hh; if (idx >= 10) idx -= 8; mx::tile10(idx, pmt[hh], pnt[hh]);
        const int e0 = 16 * (pnt[hh] - pmt[hh]) + fr - 4 * fq;
#pragma unroll
        for (int r = 0; r < 4; ++r) pf[hh][r] = (e0 - r) >= 0 ? ex2((float)(e0 - r) * lg2) : 0.f; }
    fetch(0, RA); fetch(1, RB);
    __syncthreads();
    auto step = [&](int p, RS& R) {
        auto& rq = R.rq; auto& rk = R.rk; auto& rv0 = R.rv0; auto& rv1 = R.rv1; auto& rk0 = R.rk0; auto& rk1 = R.rk1;
        { *(LAS u32x4*)(Qn + tok * mx::PITCH + seg * 16) = rq; *(LAS u32x4*)(Kn + tok * mx::PITCH + seg * 16) = rk;
          u32x4 g;
          g.x = pk2(bflo(rq.x) * sc, bfhi(rq.x) * sc); g.y = pk2(bflo(rq.y) * sc, bfhi(rq.y) * sc); g.z = pk2(bflo(rq.z) * sc, bfhi(rq.z) * sc); g.w = pk2(bflo(rq.w) * sc, bfhi(rq.w) * sc);
          *(LAS u32x4*)(Qg + tok * mx::PITCH + seg * 16) = g;
#pragma unroll
          for (int e = 0; e < 4; ++e) { const int f = fs * 4 + e;
              *(LAS unsigned*)(VT + f * mx::PITCH + tp * 4) = mx::rawe(rv0, e) | (mx::rawe(rv1, e) << 16);
              *(LAS unsigned*)(KdT + f * mx::PITCH + tp * 4) = pk2(mx::bfe(rk0, e) * s0, mx::bfe(rk1, e) * s1); } }
        __syncthreads();
        if (p + 2 < 68) fetch(p + 2, R);
        { const bf16x8 ka0 = mx::frag(Kn, pmt[0], 0, fr, fq), ka1 = mx::frag(Kn, pmt[0], 1, fr, fq), kb0 = mx::frag(Kn, pmt[1], 0, fr, fq), kb1 = mx::frag(Kn, pmt[1], 1, fr, fq);
          const bf16x8 qa0 = mx::frag(Qn, pnt[0], 0, fr, fq), qa1 = mx::frag(Qn, pnt[0], 1, fr, fq), qb0 = mx::frag(Qn, pnt[1], 0, fr, fq), qb1 = mx::frag(Qn, pnt[1], 1, fr, fq);
          f32x4 a0 = (f32x4){0.f, 0.f, 0.f, 0.f}, a1 = a0;
          a0 = MFMA16(ka0, qa0, a0); a1 = MFMA16(kb0, qb0, a1); a0 = MFMA16(ka1, qa1, a0); a1 = MFMA16(kb1, qb1, a1);
          mx::store4(Pm, pnt[0] * 16 + fr, pmt[0] * 16 + fq * 4, a0[0] * pf[0][0], a0[1] * pf[0][1], a0[2] * pf[0][2], a0[3] * pf[0][3]);
          mx::store4(Pm, pnt[1] * 16 + fr, pmt[1] * 16 + fq * 4, a1[0] * pf[1][0], a1[1] * pf[1][1], a1[2] * pf[1][2], a1[3] * pf[1][3]); }
        __syncthreads();
        lin_attn_os(Qg, VT, Pm, KdT, ST + (p & 1) * mx::IMG, ST + ((p + 1) & 1) * mx::IMG, S0, S1, dec, Og, seq_row0(b, d, p * 64), d ? -1 : 1, ocol, wave, fr, fq);
        __syncthreads();
    };
    for (int p = 0; p < 68; p += 2) { step(p, RA); step(p + 1, RB); }
}

__device__ __forceinline__ void chain_hgrn(const TC tc, KP P, LAS unsigned char* lds, int l, int chain) {
    const int tid = tc.tid, lane = tid & 63, wave = __builtin_amdgcn_readfirstlane(tid >> 6), fr = lane & 15, fq = lane >> 4;
    const int b = chain >> 3, h = (chain >> 1) & 3, d = chain & 1;
    unsigned char* ws = P->ws;
    const bf16_t* Z = (const bf16_t*)(ws + WS_Z);
    bf16_t* Og = (bf16_t*)(ws + (d ? WS_OB : WS_OF));
    const int ocol = h * 64;
    LAS unsigned char* Qa = lds; LAS unsigned char* Qg = lds + mx::IMG; LAS unsigned char* KdT = lds + 2 * mx::IMG; LAS unsigned char* VT = lds + 3 * mx::IMG; LAS unsigned char* Pm = lds + 4 * mx::IMG;
    LAS unsigned char* ST = lds + 5 * mx::IMG; LAS unsigned char* Kr = lds + 7 * mx::IMG;
    LAS float* Bf = (LAS float*)(lds + 11 * mx::IMG);
    LAS unsigned char* LT = lds + 11 * mx::IMG + 16384; LAS unsigned char* Lm = LT + mx::IMG;
    for (int i = tid; i < 64 * 32; i += 512) { const int r = i >> 5, c2 = (i & 31) * 2; *(LAS unsigned*)(Lm + r * mx::PITCH + c2 * 2) = (c2 <= r ? 0x3F80u : 0u) | (c2 + 1 <= r ? 0x3F800000u : 0u); }
    for (int i = tid; i < 3 * mx::IMG / 16; i += 512) *(LAS u32x4*)(Pm + i * 16) = (u32x4){0u, 0u, 0u, 0u};
    f32x4 S0 = (f32x4){0.f, 0.f, 0.f, 0.f}, S1 = S0;
    const int zf = ZC_HF + d * 256 + h * 64;
    struct RS { u32x4 rq, rl; u32x2 rv0, rv1, rl0, rl1; };
    RS RA, RB;
    auto fetch = [&](int p, RS& R) {
        int t2 = tid; asm volatile("" : "+v"(t2)); const int tok = t2 >> 3, seg = t2 & 7, tp = t2 & 31, fs = t2 >> 5;
        auto& rq = R.rq; auto& rl = R.rl; auto& rv0 = R.rv0; auto& rv1 = R.rv1; auto& rl0 = R.rl0; auto& rl1 = R.rl1;
        const int r0 = seq_row0(b, d, p * 64), dirs = d ? -1 : 1;
        const bf16_t* zr = Z + ((unsigned)(r0 + dirs * tok) * NZ + seg * 8);
        rq = *(const u32x4*)(zr + ZC_HQ + h * 64); rl = *(const u32x4*)(zr + zf);
        const bf16_t* z0 = Z + ((unsigned)(r0 + dirs * 2 * tp) * NZ + fs * 4); const bf16_t* z1 = z0 + dirs * NZ;
        rv0 = *(const u32x2*)(z0 + ZC_HI + h * 64); rv1 = *(const u32x2*)(z1 + ZC_HI + h * 64); rl0 = *(const u32x2*)(z0 + zf); rl1 = *(const u32x2*)(z1 + zf);
    };
    int pmt[2], pnt[2];
#pragma unroll
    for (int hh = 0; hh < 2; ++hh) { int idx = wave + 8 * hh; if (idx >= 10) idx -= 8; mx::tile10(idx, pmt[hh], pnt[hh]); }
    const int asub = wave >> 1;
    fetch(0, RA); fetch(1, RB);
    __syncthreads();
    auto step = [&](int p, RS& R) {
        int t2 = tid; asm volatile("" : "+v"(t2)); const int tok = t2 >> 3, seg = t2 & 7, tp = t2 & 31, fs = t2 >> 5;
        auto& rq = R.rq; auto& rl = R.rl; auto& rv0 = R.rv0; auto& rv1 = R.rv1; auto& rl0 = R.rl0; auto& rl1 = R.rl1;
#pragma unroll
        for (int e = 0; e < 4; ++e) *(LAS unsigned*)(LT + (fs * 4 + e) * mx::PITCH + tp * 4) = mx::rawe(rl0, e) | (mx::rawe(rl1, e) << 16);
        __syncthreads();
        { const int mtc = wave & 3, na = wave >> 2, nb = na + 2;
          const bf16x8 x0 = mx::frag(LT, mtc, 0, fr, fq), x1 = mx::frag(LT, mtc, 1, fr, fq), ya0 = mx::frag(Lm, na, 0, fr, fq), ya1 = mx::frag(Lm, na, 1, fr, fq), yb0 = mx::frag(Lm, nb, 0, fr, fq), yb1 = mx::frag(Lm, nb, 1, fr, fq);
          f32x4 a0 = (f32x4){0.f, 0.f, 0.f, 0.f}, a1 = a0;
          a0 = MFMA16(x0, ya0, a0); a1 = MFMA16(x0, yb0, a1); a0 = MFMA16(x1, ya1, a0); a1 = MFMA16(x1, yb1, a1);
          *(LAS f32x4*)(Bf + (na * 16 + fr) * 64 + mtc * 16 + fq * 4) = a0 * 1.4426950408889634f; *(LAS f32x4*)(Bf + (nb * 16 + fr) * 64 + mtc * 16 + fq * 4) = a1 * 1.4426950408889634f; }
        __syncthreads();
        float q[8], kk[8], bb[8];
        { const unsigned* pq = (const unsigned*)&rq; const unsigned* pl = (const unsigned*)&rl;
#pragma unroll
          for (int e = 0; e < 4; ++e) { q[2 * e] = bflo(pq[e]); q[2 * e + 1] = bfhi(pq[e]); kk[2 * e] = 1.0f - exn(bflo(pl[e])); kk[2 * e + 1] = 1.0f - exn(bfhi(pl[e])); } }
        { const f32x4 b0 = *(const LAS f32x4*)(Bf + tok * 64 + seg * 8), b1 = *(const LAS f32x4*)(Bf + tok * 64 + seg * 8 + 4);
          bb[0] = b0[0]; bb[1] = b0[1]; bb[2] = b0[2]; bb[3] = b0[3]; bb[4] = b1[0]; bb[5] = b1[1]; bb[6] = b1[2]; bb[7] = b1[3]; }
        {
          float o[8];
#pragma unroll
          for (int e = 0; e < 8; ++e) o[e] = q[e] * ex2(bb[e]);
          { u32x4 w; w.x = pk2(o[0], o[1]); w.y = pk2(o[2], o[3]); w.z = pk2(o[4], o[5]); w.w = pk2(o[6], o[7]); *(LAS u32x4*)(Qg + tok * mx::PITCH + seg * 16) = w; }
          for (int a2 = asub; a2 < 4; ++a2) {
              float rr[8];
              if (a2 == 0) {
#pragma unroll
                  for (int e = 0; e < 8; ++e) rr[e] = 0.f; }
              else { const f32x4 r0 = *(const LAS f32x4*)(Bf + (16 * a2 - 1) * 64 + seg * 8), r1 = *(const LAS f32x4*)(Bf + (16 * a2 - 1) * 64 + seg * 8 + 4);
                  rr[0] = r0[0]; rr[1] = r0[1]; rr[2] = r0[2]; rr[3] = r0[3]; rr[4] = r1[0]; rr[5] = r1[1]; rr[6] = r1[2]; rr[7] = r1[3]; }
              if (a2 == asub) {
#pragma unroll
                  for (int e = 0; e < 8; ++e) o[e] = q[e] * ex2(bb[e] - rr[e]);
                  u32x4 w; w.x = pk2(o[0], o[1]); w.y = pk2(o[2], o[3]); w.z = pk2(o[4], o[5]); w.w = pk2(o[6], o[7]); *(LAS u32x4*)(Qa + tok * mx::PITCH + seg * 16) = w; }
#pragma unroll
              for (int e = 0; e < 8; ++e) o[e] = kk[e] * ex2(rr[e] - bb[e]);
              u32x4 w; w.x = pk2(o[0], o[1]); w.y = pk2(o[2], o[3]); w.z = pk2(o[4], o[5]); w.w = pk2(o[6], o[7]); *(LAS u32x4*)(Kr + a2 * mx::IMG + tok * mx::PITCH + seg * 16) = w;
          }
#pragma unroll
          for (int e = 0; e < 4; ++e) { const int f = fs * 4 + e; const float b63 = Bf[63 * 64 + f];
              *(LAS unsigned*)(VT + f * mx::PITCH + tp * 4) = mx::rawe(rv0, e) | (mx::rawe(rv1, e) << 16);
              const float k0 = (1.0f - exn(mx::bfe(rl0, e))) * ex2(b63 - Bf[(2 * tp) * 64 + f]), k1 = (1.0f - exn(mx::bfe(rl1, e))) * ex2(b63 - Bf[(2 * tp + 1) * 64 + f]);
              *(LAS unsigned*)(KdT + f * mx::PITCH + tp * 4) = pk2(k0, k1); } }
        __syncthreads();
        for (int rep4 = 0; rep4 < 1 + ((HG_DUP >> 4) & 1); ++rep4) if (p + 2 < 68) fetch(p + 2, R);
        for (int rep3 = 0; rep3 < 1 + ((HG_DUP >> 2) & 1); ++rep3)
        { const LAS unsigned char* KrA = Kr + pnt[0] * mx::IMG; const LAS unsigned char* KrB = Kr + pnt[1] * mx::IMG;
          const bf16x8 ka0 = mx::frag(KrA, pmt[0], 0, fr, fq), ka1 = mx::frag(KrA, pmt[0], 1, fr, fq), kb0 = mx::frag(KrB, pmt[1], 0, fr, fq), kb1 = mx::frag(KrB, pmt[1], 1, fr, fq);
          const bf16x8 qa0 = mx::frag(Qa, pnt[0], 0, fr, fq), qa1 = mx::frag(Qa, pnt[0], 1, fr, fq), qb0 = mx::frag(Qa, pnt[1], 0, fr, fq), qb1 = mx::frag(Qa, pnt[1], 1, fr, fq);
          f32x4 a0 = (f32x4){0.f, 0.f, 0.f, 0.f}, a1 = a0;
          a0 = MFMA16(ka0, qa0, a0); a1 = MFMA16(kb0, qb0, a1); a0 = MFMA16(ka1, qa1, a0); a1 = MFMA16(kb1, qb1, a1);
          const int ea = 16 * (pnt[0] - pmt[0]) + fr - 4 * fq, eb = 16 * (pnt[1] - pmt[1]) + fr - 4 * fq;
          mx::store4(Pm, pnt[0] * 16 + fr, pmt[0] * 16 + fq * 4, ea >= 0 ? a0[0] : 0.f, ea >= 1 ? a0[1] : 0.f, ea >= 2 ? a0[2] : 0.f, ea >= 3 ? a0[3] : 0.f);
          mx::store4(Pm, pnt[1] * 16 + fr, pmt[1] * 16 + fq * 4, eb >= 0 ? a1[0] : 0.f, eb >= 1 ? a1[1] : 0.f, eb >= 2 ? a1[2] : 0.f, eb >= 3 ? a1[3] : 0.f); }
        f32x4 dec; { const f32x4 b63 = *(const LAS f32x4*)(Bf + 63 * 64 + (wave & 3) * 16 + fq * 4); dec = (f32x4){ex2(b63[0]), ex2(b63[1]), ex2(b63[2]), ex2(b63[3])}; }
        __syncthreads();
        if (HG_DUP & 8) { f32x4 t0 = S0, t1 = S1; lin_attn_os(Qg, VT, Pm, KdT, ST + (p & 1) * mx::IMG, ST + ((p + 1) & 1) * mx::IMG, t0, t1, dec, Og, seq_row0(b, d, p * 64), d ? -1 : 1, ocol, wave, fr, fq); asm volatile("" :: "v"(t0), "v"(t1)); }
        lin_attn_os(Qg, VT, Pm, KdT, ST + (p & 1) * mx::IMG, ST + ((p + 1) & 1) * mx::IMG, S0, S1, dec, Og, seq_row0(b, d, p * 64), d ? -1 : 1, ocol, wave, fr, fq);
        __syncthreads();
    };
    for (int p = 0; p < 68; p += 2) { step(p, RA); step(p + 1, RB); }
}

__device__ __forceinline__ int nat_row(int b, int c, int t) { return c < 4 ? b * TCTX + c * 64 + t : MCTX + b * TLAT + (c - 4) * 64 + t; }
constexpr int GP_WAVE = 64 * 68 * 4 + 512;
static_assert(8 * GP_WAVE <= LDS_BYTES - 64, "gdnpre LDS");
__device__ __forceinline__ void phase_gdnpre(const TC tc, KP P, LAS unsigned char* lds, int l) {
    const int tid = tc.tid, wave = __builtin_amdgcn_readfirstlane(tid >> 6);
    unsigned char* ws = P->ws;
    bf16_t* Z = (bf16_t*)(ws + WS_Z);
    const bf16_t* QC = (const bf16_t*)(ws + WS_HB);
    float* AB = (float*)(ws + WS_AB);
    LAS unsigned char* wl = lds + wave * GP_WAVE;
    LAS unsigned char* Kn = wl; LAS float* Af = (LAS float*)wl; LAS float* gb = (LAS float*)(wl + 64 * 68 * 4);
    for (int task = tc.bid * 8 + wave; task < NB * 68 * 4 * 2; task += tc.G * 8) {
        int t2 = tid; asm volatile("" : "+v"(t2)); const int lane = t2 & 63, fr = lane & 15, fq = lane >> 4;
        const int d = task & 1, h = (task >> 1) & 3, c = (task >> 3) % 68, b = (task >> 3) / 68;
        const int cb = __builtin_amdgcn_readfirstlane(nat_row(b, c, 0));
#pragma unroll
        for (int it = 0; it < 8; ++it) { const int row = it * 8 + (lane >> 3), seg = lane & 7;
            *(LAS u32x4*)(Kn + row * mx::PITCH + seg * 16) = *(const u32x4*)(QC + ((unsigned)(cb + row) * 768 + 256 + h * 64 + seg * 8)); }
        { const int t = d ? 63 - lane : lane; const float* ab = AB + (unsigned)(cb + t) * 16; float g = ab[d * 4 + h]; const float be = ab[8 + d * 4 + h];
#pragma unroll
          for (int o = 1; o < 64; o <<= 1) { const float x = __shfl_up(g, o); if (lane >= o) g += x; }
          AB[(unsigned)(cb + lane) * 16 + d * 4 + h] = g;
          gb[lane] = g; gb[64 + lane] = be; }
        asm volatile("s_waitcnt lgkmcnt(0)" ::: "memory");
        bf16x8 kf[4][2];
#pragma unroll
        for (int mt = 0; mt < 4; ++mt) { kf[mt][0] = mx::frag(Kn, mt, 0, fr, fq); kf[mt][1] = mx::frag(Kn, mt, 1, fr, fq); }
        asm volatile("s_waitcnt lgkmcnt(0)" ::: "memory");
#pragma unroll
        for (int nt = 0; nt < 4; ++nt) { const int n = nt * 16 + fr, i = d ? 63 - n : n; const float gi = gb[i], bi = gb[64 + i];
#pragma unroll
            for (int mt = 0; mt < 4; ++mt) { f32x4 kk = (f32x4){0.f, 0.f, 0.f, 0.f}; kk = MFMA16(kf[mt][0], kf[nt][0], kk); kk = MFMA16(kf[mt][1], kf[nt][1], kk);
                const int m0 = mt * 16 + fq * 4; float v[4];
#pragma unroll
                for (int r = 0; r < 4; ++r) { const int j = d ? 63 - (m0 + r) : m0 + r; v[r] = j < i ? bi * kk[r] * exn(gi - gb[j]) : 0.f; }
                if (d) *(LAS f32x4*)(Af + i * 68 + (60 - m0)) = (f32x4){v[3], v[2], v[1], v[0]}; else *(LAS f32x4*)(Af + i * 68 + m0) = (f32x4){v[0], v[1], v[2], v[3]};
                asm volatile("" ::: "memory"); } }
        asm volatile("s_waitcnt lgkmcnt(0)" ::: "memory");
        {
            LAS unsigned char* Tl = wl + lane * 2;
            float T[64]; f32x4 rw[16];
            rw[0] = *(const LAS f32x4*)(Af + 68);
            T[0] = (lane == 0) ? 1.0f : 0.0f;
            *(LAS unsigned short*)Tl = (unsigned short)f2bf(T[0]);
#pragma unroll
            for (int i = 1; i < 64; ++i) {
                float ac[4] = {(i == lane) ? 1.0f : 0.0f, 0.f, 0.f, 0.f};
#pragma unroll
                for (int j4 = 0; j4 < (i + 3) / 4; ++j4) {
#pragma unroll
                    for (int e = 0; e < 4; ++e) if (j4 * 4 + e < i) ac[e] -= rw[j4][e] * T[j4 * 4 + e];
                    if (i + 1 < 64) { asm volatile("" ::: "memory"); rw[j4] = *(const LAS f32x4*)(Af + (i + 1) * 68 + j4 * 4); } }
                if (i + 1 < 64 && (i + 4) / 4 > (i + 3) / 4) rw[(i + 3) / 4] = *(const LAS f32x4*)(Af + (i + 1) * 68 + ((i + 3) / 4) * 4);
                const float acc = (ac[0] + ac[1]) + (ac[2] + ac[3]);
                T[i] = acc;
                asm volatile("" ::: "memory");
                *(LAS unsigned short*)(Tl + i * 272) = (unsigned short)f2bf(acc);
            }
        }
        asm volatile("s_waitcnt lgkmcnt(0)" ::: "memory");
#pragma unroll
        for (int it = 0; it < 8; ++it) { const int row = it * 8 + (lane >> 3), seg = lane & 7;
            *(u32x4*)(Z + ((unsigned)(cb + row) * NZ + ZC_GQKV + (h * 2 + d) * 64 + seg * 8)) = *(const LAS u32x4*)(wl + row * 272 + seg * 16); }
        asm volatile("s_waitcnt lgkmcnt(0)" ::: "memory");
    }
}

__device__ __forceinline__ void chain_gdn(const TC tc, KP P, LAS unsigned char* lds, int l, int chain) {
    const int tid = tc.tid, lane = tid & 63, wave = __builtin_amdgcn_readfirstlane(tid >> 6), fr = lane & 15, fq = lane >> 4;
    const int b = chain >> 3, h = (chain >> 1) & 3, d = chain & 1;
    unsigned char* ws = P->ws;
    const bf16_t* Z = (const bf16_t*)(ws + WS_Z);
    const bf16_t* QC = (const bf16_t*)(ws + WS_HB);
    const float* AB = (const float*)(ws + WS_AB);
    bf16_t* Og = (bf16_t*)(ws + (d ? WS_OB : WS_OF));
    const int ocol = 512 + h * 64;
    LAS unsigned char* Tm = lds; LAS unsigned char* QKm = lds + mx::IMG; LAS unsigned char* Kg = lds + 2 * mx::IMG; LAS unsigned char* Qg = lds + 3 * mx::IMG; LAS unsigned char* KdT = lds + 4 * mx::IMG;
    LAS unsigned char* VT = lds + 5 * mx::IMG; LAS unsigned char* RT = lds + 6 * mx::IMG; LAS unsigned char* VnT = lds + 7 * mx::IMG; LAS unsigned char* ST = lds + 8 * mx::IMG;
    LAS unsigned char* Qn = lds + 10 * mx::IMG; LAS unsigned char* Kn = lds + 11 * mx::IMG;
    LAS float* garb = (LAS float*)(lds + 12 * mx::IMG);
    for (int i = tid; i < 2 * mx::IMG / 16; i += 512) *(LAS u32x4*)(ST + i * 16) = (u32x4){0u, 0u, 0u, 0u};
    for (int i = tid; i < mx::IMG / 16; i += 512) *(LAS u32x4*)(QKm + i * 16) = (u32x4){0u, 0u, 0u, 0u};
    f32x4 S0 = (f32x4){0.f, 0.f, 0.f, 0.f}, S1 = S0;
    struct RS { u32x4 rt, rq, rk; u32x2 rv0, rv1, rk0, rk1; float rla, rbe; };
    RS RA, RB; RA.rla = RA.rbe = RB.rla = RB.rbe = 0.f;
    auto fetch = [&](int p, RS& R) {
        int t2 = tid; asm volatile("" : "+v"(t2)); const int tok = t2 >> 3, seg = t2 & 7, tp = t2 & 31, fs = t2 >> 5;
        auto& rt = R.rt; auto& rq = R.rq; auto& rk = R.rk; auto& rv0 = R.rv0; auto& rv1 = R.rv1; auto& rk0 = R.rk0; auto& rk1 = R.rk1; auto& rla = R.rla; auto& rbe = R.rbe;
        const int c = p < 4 ? (d ? 3 - p : p) : 4 + (d ? 67 - p : p - 4);
        const int cb = __builtin_amdgcn_readfirstlane(nat_row(b, c, 0)), r0 = seq_row0(b, d, p * 64), dirs = d ? -1 : 1;
        rt = *(const u32x4*)(Z + ((unsigned)(cb + tok) * NZ + ZC_GQKV + (h * 2 + d) * 64 + seg * 8));
        const bf16_t* qr = QC + ((unsigned)(r0 + dirs * tok) * 768 + h * 64 + seg * 8);
        rq = *(const u32x4*)qr; rk = *(const u32x4*)(qr + 256);
        const bf16_t* z0 = QC + ((unsigned)(r0 + dirs * 2 * tp) * 768 + h * 64 + fs * 4); const bf16_t* z1 = z0 + dirs * 768;
        rv0 = *(const u32x2*)(z0 + 512); rv1 = *(const u32x2*)(z1 + 512); rk0 = *(const u32x2*)(z0 + 256); rk1 = *(const u32x2*)(z1 + 256);
        if (tid < 64) { rla = AB[(unsigned)(cb + tid) * 16 + d * 4 + h]; rbe = AB[(unsigned)(r0 + dirs * tid) * 16 + 8 + d * 4 + h]; }
    };
    fetch(0, RA); fetch(1, RB);
    if (tid < 64) { garb[tid] = RA.rla; garb[64 + tid] = RA.rbe; }
    __syncthreads();
    const int mt = wave & 3, n0 = wave >> 2, n1 = n0 + 2;
    auto step = [&](int p, RS& R, RS& RN) {
        int t2 = tid; asm volatile("" : "+v"(t2)); const int tok = t2 >> 3, seg = t2 & 7, tp = t2 & 31, fs = t2 >> 5;
        auto& rt = R.rt; auto& rq = R.rq; auto& rk = R.rk; auto& rv0 = R.rv0; auto& rv1 = R.rv1; auto& rk0 = R.rk0; auto& rk1 = R.rk1; auto& rla = R.rla; auto& rbe = R.rbe;
        const LAS float* gar = garb + (p & 1) * 128;
        { *(LAS u32x4*)(Tm + tok * mx::PITCH + seg * 16) = rt;
          const float gi = gar[tok], eg = exn(gi);
          { const unsigned* pq = (const unsigned*)&rq; const unsigned* pk = (const unsigned*)&rk; u32x4 wq, wk; unsigned* oq = (unsigned*)&wq; unsigned* ok = (unsigned*)&wk;
#pragma unroll
            for (int e = 0; e < 4; ++e) { oq[e] = pk2(bflo(pq[e]) * eg, bfhi(pq[e]) * eg); ok[e] = pk2(bflo(pk[e]) * eg, bfhi(pk[e]) * eg); }
            *(LAS u32x4*)(Qg + tok * mx::PITCH + seg * 16) = wq; *(LAS u32x4*)(Kg + tok * mx::PITCH + seg * 16) = wk; }
          *(LAS u32x4*)(Qn + tok * mx::PITCH + seg * 16) = rq; *(LAS u32x4*)(Kn + tok * mx::PITCH + seg * 16) = rk;
          const float g63 = gar[63], s0 = exn(g63 - gar[2 * tp]), s1 = exn(g63 - gar[2 * tp + 1]);
#pragma unroll
          for (int e = 0; e < 4; ++e) { const int f = fs * 4 + e;
              *(LAS unsigned*)(VT + f * mx::PITCH + tp * 4) = mx::rawe(rv0, e) | (mx::rawe(rv1, e) << 16);
              *(LAS unsigned*)(KdT + f * mx::PITCH + tp * 4) = pk2(mx::bfe(rk0, e) * s0, mx::bfe(rk1, e) * s1); } }
        __syncthreads();
        if (p + 2 < 68) fetch(p + 2, R);
        const LAS unsigned char* STc = ST + (p & 1) * mx::IMG; LAS unsigned char* STn = ST + ((p + 1) & 1) * mx::IMG;
        { const bf16x8 x0 = mx::frag(Kg, mt, 0, fr, fq), x1 = mx::frag(Kg, mt, 1, fr, fq), ya0 = mx::frag(STc, n0, 0, fr, fq), ya1 = mx::frag(STc, n0, 1, fr, fq), yb0 = mx::frag(STc, n1, 0, fr, fq), yb1 = mx::frag(STc, n1, 1, fr, fq);
          const u32x2 va = *(const LAS u32x2*)(VT + (n0 * 16 + fr) * mx::PITCH + (mt * 16 + fq * 4) * 2), vb = *(const LAS u32x2*)(VT + (n1 * 16 + fr) * mx::PITCH + (mt * 16 + fq * 4) * 2);
          const f32x4 be = *(const LAS f32x4*)(gar + 64 + mt * 16 + fq * 4);
          f32x4 a0 = (f32x4){0.f, 0.f, 0.f, 0.f}, a1 = a0;
          a0 = MFMA16(x0, ya0, a0); a1 = MFMA16(x0, yb0, a1); a0 = MFMA16(x1, ya1, a0); a1 = MFMA16(x1, yb1, a1);
          mx::store4(RT, n0 * 16 + fr, mt * 16 + fq * 4, be[0] * (bflo(va.x) - a0[0]), be[1] * (bfhi(va.x) - a0[1]), be[2] * (bflo(va.y) - a0[2]), be[3] * (bfhi(va.y) - a0[3]));
          mx::store4(RT, n1 * 16 + fr, mt * 16 + fq * 4, be[0] * (bflo(vb.x) - a1[0]), be[1] * (bfhi(vb.x) - a1[1]), be[2] * (bflo(vb.y) - a1[2]), be[3] * (bfhi(vb.y) - a1[3])); }
        { int pm0, pn0, pm1, pn1; { int i0 = wave, i1 = wave + 8; if (i1 >= 10) i1 -= 8; mx::tile10(i0, pm0, pn0); mx::tile10(i1, pm1, pn1); }
          const bf16x8 ka0 = mx::frag(Kn, pm0, 0, fr, fq), ka1 = mx::frag(Kn, pm0, 1, fr, fq), kb0 = mx::frag(Kn, pm1, 0, fr, fq), kb1 = mx::frag(Kn, pm1, 1, fr, fq);
          const bf16x8 qa0 = mx::frag(Qn, pn0, 0, fr, fq), qa1 = mx::frag(Qn, pn0, 1, fr, fq), qb0 = mx::frag(Qn, pn1, 0, fr, fq), qb1 = mx::frag(Qn, pn1, 1, fr, fq);
          f32x4 a0 = (f32x4){0.f, 0.f, 0.f, 0.f}, a1 = a0;
          a0 = MFMA16(ka0, qa0, a0); a1 = MFMA16(kb0, qb0, a1); a0 = MFMA16(ka1, qa1, a0); a1 = MFMA16(kb1, qb1, a1);
          { const int i = pn0 * 16 + fr, j0 = pm0 * 16 + fq * 4; const float gi = gar[i]; const f32x4 gj = *(const LAS f32x4*)(gar + j0);
            mx::store4(QKm, i, j0, j0 <= i ? a0[0] * exn(gi - gj[0]) : 0.f, j0 + 1 <= i ? a0[1] * exn(gi - gj[1]) : 0.f, j0 + 2 <= i ? a0[2] * exn(gi - gj[2]) : 0.f, j0 + 3 <= i ? a0[3] * exn(gi - gj[3]) : 0.f); }
          { const int i = pn1 * 16 + fr, j0 = pm1 * 16 + fq * 4; const float gi = gar[i]; const f32x4 gj = *(const LAS f32x4*)(gar + j0);
            mx::store4(QKm, i, j0, j0 <= i ? a1[0] * exn(gi - gj[0]) : 0.f, j0 + 1 <= i ? a1[1] * exn(gi - gj[1]) : 0.f, j0 + 2 <= i ? a1[2] * exn(gi - gj[2]) : 0.f, j0 + 3 <= i ? a1[3] * exn(gi - gj[3]) : 0.f); } }
        __syncthreads();
        { const bf16x8 x0 = mx::frag(Tm, mt, 0, fr, fq), x1 = mx::frag(Tm, mt, 1, fr, fq), ya0 = mx::frag(RT, n0, 0, fr, fq), ya1 = mx::frag(RT, n0, 1, fr, fq), yb0 = mx::frag(RT, n1, 0, fr, fq), yb1 = mx::frag(RT, n1, 1, fr, fq);
          f32x4 a0 = (f32x4){0.f, 0.f, 0.f, 0.f}, a1 = a0;
          a0 = MFMA16(x0, ya0, a0); a1 = MFMA16(x0, yb0, a1); a0 = MFMA16(x1, ya1, a0); a1 = MFMA16(x1, yb1, a1);
          mx::store4(VnT, n0 * 16 + fr, mt * 16 + fq * 4, a0[0], a0[1], a0[2], a0[3]);
          mx::store4(VnT, n1 * 16 + fr, mt * 16 + fq * 4, a1[0], a1[1], a1[2], a1[3]); }
        __syncthreads();
        { const float dg = exn(gar[63]);
          const bf16x8 vx0 = mx::frag(VnT, mt, 0, fr, fq), vx1 = mx::frag(VnT, mt, 1, fr, fq), sx0 = mx::frag(STc, mt, 0, fr, fq), sx1 = mx::frag(STc, mt, 1, fr, fq), kx0 = mx::frag(KdT, mt, 0, fr, fq), kx1 = mx::frag(KdT, mt, 1, fr, fq);
          const bf16x8 pa0 = mx::frag(QKm, n0, 0, fr, fq), pa1 = mx::frag(QKm, n0, 1, fr, fq), pb0 = mx::frag(QKm, n1, 0, fr, fq), pb1 = mx::frag(QKm, n1, 1, fr, fq);
          const bf16x8 qa0 = mx::frag(Qg, n0, 0, fr, fq), qa1 = mx::frag(Qg, n0, 1, fr, fq), qb0 = mx::frag(Qg, n1, 0, fr, fq), qb1 = mx::frag(Qg, n1, 1, fr, fq);
          const bf16x8 va0 = mx::frag(VnT, n0, 0, fr, fq), va1 = mx::frag(VnT, n0, 1, fr, fq), vb0 = mx::frag(VnT, n1, 0, fr, fq), vb1 = mx::frag(VnT, n1, 1, fr, fq);
          f32x4 oa = (f32x4){0.f, 0.f, 0.f, 0.f}, ob = oa, sa = S0 * dg, sb = S1 * dg;
          oa = MFMA16(vx0, pa0, oa); ob = MFMA16(vx0, pb0, ob); sa = MFMA16(kx0, va0, sa); sb = MFMA16(kx0, vb0, sb);
          oa = MFMA16(vx1, pa1, oa); ob = MFMA16(vx1, pb1, ob); sa = MFMA16(kx1, va1, sa); sb = MFMA16(kx1, vb1, sb);
          oa = MFMA16(sx0, qa0, oa); ob = MFMA16(sx0, qb0, ob);
          oa = MFMA16(sx1, qa1, oa); ob = MFMA16(sx1, qb1, ob);
          S0 = sa; S1 = sb;
          mx::store4(STn, n0 * 16 + fr, mt * 16 + fq * 4, sa[0], sa[1], sa[2], sa[3]);
          mx::store4(STn, n1 * 16 + fr, mt * 16 + fq * 4, sb[0], sb[1], sb[2], sb[3]);
          const int r0 = seq_row0(b, d, p * 64), dirs = d ? -1 : 1;
          { const unsigned off = (unsigned)(r0 + dirs * (n0 * 16 + fr)) * DM + ocol + mt * 16 + fq * 4; u32x2 w; w.x = pk2(oa[0], oa[1]); w.y = pk2(oa[2], oa[3]); *(u32x2*)(Og + off) = w; }
          { const unsigned off = (unsigned)(r0 + dirs * (n1 * 16 + fr)) * DM + ocol + mt * 16 + fq * 4; u32x2 w; w.x = pk2(ob[0], ob[1]); w.y = pk2(ob[2], ob[3]); *(u32x2*)(Og + off) = w; } }
        if (tid < 64 && p + 1 < 68) { LAS float* gn = garb + ((p + 1) & 1) * 128; gn[tid] = RN.rla; gn[64 + tid] = RN.rbe; }
        __syncthreads();
    };
    for (int p = 0; p < 68; p += 2) { step(p, RA, RB); step(p + 1, RB, RA); }
}

constexpr int S5_XT = 128 * 80, S5_H = 16 * 272, S5_CH = 2 * S5_XT + 2 * S5_H;
static_assert(4 * S5_CH <= LDS_BYTES - 64, "S5 LDS");
__device__ __forceinline__ void chain_s5m(const TC tc, KP P, LAS unsigned char* lds, int l, int item) {
    const int tid = tc.tid, lane = tid & 63, wave = __builtin_amdgcn_readfirstlane(tid >> 6), fr = lane & 15, fq = lane >> 4;
    const int b = item >> 3, d = (item >> 2) & 1, gq = item & 3, ch = wave & 3, g = gq * 4 + ch;
    const bool isA = wave < 4;
    unsigned char* ws = P->ws;
    const bf16_t* Z = (const bf16_t*)(ws + WS_Z);
    bf16_t* Og = (bf16_t*)(ws + (d ? WS_OB : WS_OF));
    LAS unsigned char* base = lds + ch * S5_CH;
    const float* sp0 = (const float*)(ws + WS_S5P) + (size_t)((l * 2 + d) * 16 + g) * 64 * 34;
    bf16x8 bbf[8], ccf[4]; float ar = 0.f, ai = 0.f, hr = 0.f, hi = 0.f;
    if (isA) {
#pragma unroll
        for (int nt = 0; nt < 8; ++nt) { const int s = nt * 16 + fr, p = s & 63; const float* sp = sp0 + p * 34 + (s < 64 ? 2 : 18) + (fq & 1) * 8;
            u32x4 w = (u32x4){0u, 0u, 0u, 0u};
            if (fq < 2) { w.x = pk2(sp[0], sp[1]); w.y = pk2(sp[2], sp[3]); w.z = pk2(sp[4], sp[5]); w.w = pk2(sp[6], sp[7]); }
            bbf[nt] = __builtin_bit_cast(bf16x8, w); }
#pragma unroll
        for (int ks = 0; ks < 4; ++ks) { const int p0 = ks * 16 + fq * 4;
            const float* cr = P->in[21] + ((size_t)(l * 16 + g) * 16 + fr) * 64 + p0; const float* ci = P->in[22] + ((size_t)(l * 16 + g) * 16 + fr) * 64 + p0;
            u32x4 w; w.x = pk2(cr[0], -ci[0]); w.y = pk2(cr[1], -ci[1]); w.z = pk2(cr[2], -ci[2]); w.w = pk2(cr[3], -ci[3]);
            ccf[ks] = __builtin_bit_cast(bf16x8, w); }
    } else { ar = sp0[lane * 34]; ai = sp0[lane * 34 + 1]; }
    u32x4 uf = (u32x4){0u, 0u, 0u, 0u}, uf2 = uf;
    auto fetchu = [&](int it, u32x4& dst) { if (fq < 2) dst = *(const u32x4*)(Z + ((unsigned)(seq_row0(b, d, it * 16) + (d ? -fr : fr)) * NZ + ZC_SU + g * 16 + fq * 8)); };
    if (isA) { fetchu(0, uf); fetchu(1, uf2); }
    constexpr int NST = TSEQ / 16;
#pragma unroll 1
    for (int it = 0; it < NST + 2; ++it) {
        if (isA) {
            if (it < NST) {
                const bf16x8 ua = __builtin_bit_cast(bf16x8, uf);
                uf = uf2; if (it + 2 < NST) fetchu(it + 2, uf2);
                LAS unsigned char* xt = base + (it & 1) * S5_XT;
#pragma unroll
                for (int nt = 0; nt < 8; ++nt) { f32x4 acc = (f32x4){0.f, 0.f, 0.f, 0.f}; acc = MFMA16(ua, bbf[nt], acc);
                    *(LAS f32x4*)(xt + (nt * 16 + fr) * 80 + fq * 16) = acc; }
            }
            if (it >= 2) {
                const LAS unsigned char* hh = base + 2 * S5_XT + (it & 1) * S5_H;
                f32x4 acc = (f32x4){0.f, 0.f, 0.f, 0.f};
#pragma unroll
                for (int ks = 0; ks < 4; ++ks) acc = MFMA16(ccf[ks], *(const LAS bf16x8*)(hh + fr * 272 + (ks * 32 + fq * 8) * 2), acc);
                const unsigned off = (unsigned)(seq_row0(b, d, (it - 2) * 16) + (d ? -fr : fr)) * DM + 768 + g * 16 + fq * 4; u32x2 w; w.x = pk2(acc[0], acc[1]); w.y = pk2(acc[2], acc[3]);
                *(u32x2*)(Og + off) = w;
            }
        } else if (it >= 1 && it <= NST) {
            const LAS unsigned char* xt = base + ((it - 1) & 1) * S5_XT; LAS unsigned char* hh = base + 2 * S5_XT + ((it - 1) & 1) * S5_H;
#pragma unroll
            for (int tq = 0; tq < 4; ++tq) { const f32x4 xr = *(const LAS f32x4*)(xt + lane * 80 + tq * 16), xi = *(const LAS f32x4*)(xt + (64 + lane) * 80 + tq * 16);
#pragma unroll
                for (int e = 0; e < 4; ++e) { const float nr = ar * hr - ai * hi + xr[e], ni = ar * hi + ai * hr + xi[e]; hr = nr; hi = ni;
                    *(LAS unsigned*)(hh + (tq * 4 + e) * 272 + lane * 4) = pk2(hr, hi); } }
        }
        __syncthreads();
    }
}

#ifndef CHAIN_NEW
#define CHAIN_NEW 15
#endif
__device__ __forceinline__ void phase_mixscan(const TC tc, KP P, LAS unsigned char* lds, int l) {
    for (int item = tc.bid; item < (CHAIN_DUP ? 512 : 256); item += tc.G) {
        const int kind = (item >> 6) & 3, c = item & 63;
        if (item >= 256 && !((CHAIN_DUP >> kind) & 1)) continue;
#ifdef CHAIN_ONLY
        if (kind != CHAIN_ONLY) continue;
#endif
        if (kind == 0) { if (CHAIN_NEW & 1) chain_hgrn(tc, P, lds, l, c); else chain_matrix<0>(tc, P, lds, l, c); }
        else if (kind == 1) { if (CHAIN_NEW & 2) chain_ret(tc, P, lds, l, c); else chain_matrix<1>(tc, P, lds, l, c); }
        else if (kind == 2) { if (CHAIN_NEW & 4) chain_gdn(tc, P, lds, l, c); else chain_matrix<2>(tc, P, lds, l, c); }
        else { if (CHAIN_NEW & 8) chain_s5m(tc, P, lds, l, c); else chain_s5(tc, P, lds, l, c); }
    }
}

__device__ __forceinline__ void phase_combine(const TC tc, KP P, int l, int r0) {
    const int tid = tc.tid, lane = tid & 63, wave = tid >> 6;
    const int gw = tc.bid * 8 + wave, NGW = tc.G * 8;
    unsigned char* ws = P->ws;
    const bf16_t* Z = (const bf16_t*)(ws + WS_Z);
    const bf16_t* OF = (const bf16_t*)(ws + WS_OF); const bf16_t* OB = (const bf16_t*)(ws + WS_OB);
    bf16_t* CAT = (bf16_t*)(ws + WS_HB);
    const float* ghg = P->in[10] + l * 64; const float* ggd = P->in[15] + l * 64; const float* dsk = P->in[23] + l * DG;
    const int hc = (lane & 15) * 4;
    const f32x4 g_h = *(const f32x4*)(ghg + hc), g_g = *(const f32x4*)(ggd + hc);
    const f32x4 dv = *(const f32x4*)(dsk + lane * 4);
    u32x2 cf[4], cb[4], cz[4], nf[4], nb[4], nz[4];
    auto ld = [&](int r, u32x2 (&f)[4], u32x2 (&bk)[4], u32x2 (&z)[4]) {
        const bf16_t* zr = Z + (size_t)r * NZ + lane * 4;
#pragma unroll
        for (int m = 0; m < 4; ++m) { f[m] = *(const u32x2*)(OF + (size_t)r * DM + m * 256 + lane * 4); bk[m] = *(const u32x2*)(OB + (size_t)r * DM + m * 256 + lane * 4); }
        z[0] = *(const u32x2*)(zr + ZC_HG); z[1] = *(const u32x2*)(zr + ZC_RG); z[2] = *(const u32x2*)(zr + ZC_GG); z[3] = *(const u32x2*)(zr + ZC_SU);
    };
    if (r0 + gw < MALL) ld(r0 + gw, nf, nb, nz);
    for (int r = r0 + gw; r < MALL; r += NGW) {
#pragma unroll
        for (int m = 0; m < 4; ++m) { cf[m] = nf[m]; cb[m] = nb[m]; cz[m] = nz[m]; }
        if (r + NGW < MALL) ld(r + NGW, nf, nb, nz);
#pragma unroll
        for (int mx = 0; mx < 3; ++mx) {
            const u32x2 a = cf[mx], bb = cb[mx];
            f32x4 o = (f32x4){bflo(a.x) + bflo(bb.x), bfhi(a.x) + bfhi(bb.x), bflo(a.y) + bflo(bb.y), bfhi(a.y) + bfhi(bb.y)};
            float ss = (o.x * o.x + o.y * o.y) + (o.z * o.z + o.w * o.w);
            ss += __shfl_xor(ss, 1); ss += __shfl_xor(ss, 2); ss += __shfl_xor(ss, 4); ss += __shfl_xor(ss, 8);
            const float rn = rsqrtf(ss * (1.0f / 64.0f) + EPS);
            o = o * rn; if (mx == 0) o = o * g_h; if (mx == 2) o = o * g_g;
            const u32x2 gt = cz[mx];
            u32x2 w; w.x = pk2(o.x * siluf_(bflo(gt.x)), o.y * siluf_(bfhi(gt.x))); w.y = pk2(o.z * siluf_(bflo(gt.y)), o.w * siluf_(bfhi(gt.y)));
            *(u32x2*)(CAT + (size_t)r * DM + mx * 256 + lane * 4) = w;
        }
        { const u32x2 a = cf[3], bb = cb[3], uu = cz[3];
          const float y0 = bflo(a.x) + bflo(bb.x) + bflo(uu.x) * dv.x, y1 = bfhi(a.x) + bfhi(bb.x) + bfhi(uu.x) * dv.y, y2 = bflo(a.y) + bflo(bb.y) + bflo(uu.y) * dv.z, y3 = bfhi(a.y) + bfhi(bb.y) + bfhi(uu.y) * dv.w;
          u32x2 w; w.x = pk2(gelu_tanh(y0), gelu_tanh(y1)); w.y = pk2(gelu_tanh(y2), gelu_tanh(y3));
          *(u32x2*)(CAT + (size_t)r * DM + 768 + lane * 4) = w; }
    }
}

__device__ __forceinline__ void phase_glu(const TC tc, KP P, LAS unsigned char* lds, int l, int r0) {
    const int tid = tc.tid, lane = tid & 63, wave = tid >> 6;
    const int gw = tc.bid * 8 + wave, NGW = tc.G * 8;
    const int ntile = (MALL - r0) / 16;
    if (tc.bid * 8 >= ntile) return;
    unsigned char* ws = P->ws;
    const bf16_t* wg = (const bf16_t*)(ws + WS_W + (size_t)l * SZ_WL + SZ_WIN + SZ_WOUT + SZ_W1 + SZ_W2);
    for (int i = tid; i < 256 * 32; i += 512) { const int n = i >> 5, c = i & 31; *(LAS u32x4*)(lds + n * 528 + c * 16) = *(const u32x4*)(wg + n * 256 + c * 8); }
    __syncthreads();
    bf16_t* CAT = (bf16_t*)(ws + WS_HB);
    const float* bias = P->in[25] + l * DG;
    const int fr = lane & 15, fq = lane >> 4;
    for (int t = gw; t < ntile; t += NGW) {
        bf16_t* rowp = CAT + (size_t)(r0 + t * 16 + fr) * DM + 768;
        bf16x8 af[8];
#pragma unroll
        for (int ks = 0; ks < 8; ++ks) af[ks] = *(const bf16x8*)(rowp + ks * 32 + fq * 8);
        f32x4 acc[16];
#pragma unroll
        for (int nt = 0; nt < 16; ++nt) acc[nt] = (f32x4){0.f, 0.f, 0.f, 0.f};
#pragma unroll
        for (int ks = 0; ks < 8; ++ks)
#pragma unroll
            for (int nt = 0; nt < 16; ++nt) { const bf16x8 wf = *(const LAS bf16x8*)(lds + (nt * 16 + fr) * 528 + (ks * 32 + fq * 8) * 2);
                acc[nt] = __builtin_amdgcn_mfma_f32_16x16x32_bf16(wf, af[ks], acc[nt], 0, 0, 0); if ((nt & 7) == 7) asm volatile("" ::: "memory"); }
#pragma unroll
        for (int nt = 0; nt < 16; ++nt) { const int c = nt * 16 + 4 * fq; asm volatile("" ::: "memory"); const f32x4 bv = *(const f32x4*)(bias + c); const u32x2 y = *(const u32x2*)(rowp + c);
            u32x2 w; w.x = pk2(bflo(y.x) * sigmoidf_(acc[nt][0] + bv[0]), bfhi(y.x) * sigmoidf_(acc[nt][1] + bv[1])); w.y = pk2(bflo(y.y) * sigmoidf_(acc[nt][2] + bv[2]), bfhi(y.y) * sigmoidf_(acc[nt][3] + bv[3]));
            *(u32x2*)(rowp + c) = w; }
    }
}

__device__ __forceinline__ void phase_final(const TC tc, KP P) {
    const int tid = tc.tid, lane = tid & 63, wave = tid >> 6;
    const int gw = tc.bid * 8 + wave, NGW = tc.G * 8;
    const float* g = P->in[29];
    f32x4 gg[4], x[4], nx[4];
#pragma unroll
    for (int j = 0; j < 4; ++j) gg[j] = ((const f32x4*)g)[j * 64 + lane];
    if (gw < MLAT) {
#pragma unroll
        for (int j = 0; j < 4; ++j) nx[j] = ((const f32x4*)(P->out + (size_t)gw * DM))[j * 64 + lane]; }
    for (int r = gw; r < MLAT; r += NGW) {
        float* xr = P->out + (size_t)r * DM;
#pragma unroll
        for (int j = 0; j < 4; ++j) x[j] = nx[j];
        if (r + NGW < MLAT) {
#pragma unroll
            for (int j = 0; j < 4; ++j) nx[j] = ((const f32x4*)(xr + (size_t)NGW * DM))[j * 64 + lane]; }
        float ss = 0.f;
#pragma unroll
        for (int j = 0; j < 4; ++j) ss += (x[j].x * x[j].x + x[j].y * x[j].y) + (x[j].z * x[j].z + x[j].w * x[j].w);
        const float rstd = rsqrtf(wave_sum(ss) * (1.0f / DM) + EPS);
#pragma unroll
        for (int j = 0; j < 4; ++j) ((f32x4*)xr)[j * 64 + lane] = x[j] * rstd * gg[j];
    }
}

#define XB_TMO      128
#define XB_XCNT(j)  (256  + 64 * (j))
#define XB_XSUB(j)  (1280 + 64 * (j))
#define XB_XGEN(j)  (2304 + 64 * (j))
#define XB_TOP      3328
#define XB_TOPGEN   3392
#define XCD_BAR_WORDS 3456
#define XB_SPIN_CAP (1u << 22)
__device__ __forceinline__ unsigned xb_ld(unsigned* p)              { return __hip_atomic_load(p, __ATOMIC_RELAXED, __HIP_MEMORY_SCOPE_AGENT); }
__device__ __forceinline__ unsigned xb_add(unsigned* p, unsigned v) { return __hip_atomic_fetch_add(p, v, __ATOMIC_RELAXED, __HIP_MEMORY_SCOPE_AGENT); }
__device__ __forceinline__ unsigned xb_xcc_id() { return (unsigned)__builtin_amdgcn_s_getreg((3 << 11) | 20) & 0xFu; }
#define XB_SPIN(cond, bar) do { unsigned _sp = 0; while (cond) { __builtin_amdgcn_s_sleep(1); \
    if ((++_sp & 255u) == 0u) { if (xb_ld(&(bar)[XB_TMO])) break; if (_sp > XB_SPIN_CAP) { atomicAdd(&(bar)[XB_TMO], 1u); break; } } } } while (0)
__device__ __forceinline__ void xcd_barrier_complete(unsigned* bar, unsigned x, unsigned G, unsigned& nloc, unsigned& nx) {
    unsigned sum, cnt, mine, sp = 0u;
    for (;;) {
        sum = 0u; cnt = 0u; mine = 0u;
#pragma unroll
        for (unsigned j = 0; j < 16; ++j) { const unsigned c = xb_ld(&bar[XB_XCNT(j)]); sum += c; cnt += (c > 0u) ? 1u : 0u; mine = (j == x) ? c : mine; }
        if (sum == G) break;
        __builtin_amdgcn_s_sleep(1);
        if ((++sp & 255u) == 0u) { if (xb_ld(&bar[XB_TMO])) break; if (sp > XB_SPIN_CAP) { atomicAdd(&bar[XB_TMO], 1u); break; } }
    }
    nloc = mine > 0u ? mine : 1u; nx = cnt > 0u ? cnt : 1u;
}
__device__ __forceinline__ void xcd_barrier(unsigned* bar, volatile LAS unsigned* st, int tid, unsigned G) {
    asm volatile("s_waitcnt vmcnt(0)" ::: "memory");
    __syncthreads();
    if (tid == 0) {
        __builtin_amdgcn_s_waitcnt(0);
        const unsigned x = xb_xcc_id();
        unsigned nloc = st[0], nx = st[1];
        if (nloc == 0u) { xcd_barrier_complete(bar, x, G, nloc, nx); st[0] = nloc; st[1] = nx; }
        const unsigned old = xb_add(&bar[XB_XSUB(x)], 1u);
        const unsigned gen = old / nloc;
        if (old + 1u == (gen + 1u) * nloc) {
            __builtin_amdgcn_fence(__ATOMIC_RELEASE, "agent");
            asm volatile("s_waitcnt vmcnt(0)" ::: "memory");
            const unsigned og = xb_add(&bar[XB_TOP], 1u);
            const unsigned tg = og / nx;
            if (og + 1u == (tg + 1u) * nx) xb_add(&bar[XB_TOPGEN], 1u);
            else XB_SPIN(xb_ld(&bar[XB_TOPGEN]) == tg, bar);
            __builtin_amdgcn_fence(__ATOMIC_ACQUIRE, "agent");
            xb_add(&bar[XB_XGEN(x)], 1u);
            asm volatile("s_waitcnt vmcnt(0)" ::: "memory");
        } else {
            XB_SPIN(xb_ld(&bar[XB_XGEN(x)]) == gen, bar);
            __builtin_amdgcn_fence(__ATOMIC_ACQUIRE, "agent");
            asm volatile("s_waitcnt vmcnt(0)" ::: "memory");
        }
    }
    __syncthreads();
}

__global__ void __launch_bounds__(512, 2) mega(Params Pk) {
    extern __shared__ __attribute__((aligned(16))) unsigned char lds_raw[];
    LAS unsigned char* lds = (LAS unsigned char*)lds_raw;
    cg::grid_group grid = cg::this_grid();
    volatile LAS unsigned* bst = (volatile LAS unsigned*)(lds + LDS_BYTES - 64);
    if (threadIdx.x < 16) bst[threadIdx.x] = 0u;
    __syncthreads();
    if (threadIdx.x == 0) (void)xb_add((unsigned*)(Pk.ws + WS_CTL) + XB_XCNT(xb_xcc_id()), 1u);
#ifndef PROBE_DUP
#define PROBE_DUP 0
#endif
    for (int phx = Pk.ph_lo * 2; phx < Pk.ph_hi * 2; ++phx) {
        const int ph = phx >> 1;
        if (phx & 1) { if (!(PROBE_DUP && ph >= 1 && ph < NPHASE - 1 && ((PROBE_DUP >> ((ph - 1) % NSP)) & 1))) continue; xcd_barrier((unsigned*)(Pk.ws + WS_CTL), bst, threadIdx.x, gridDim.x); }
        KP P = (KP)__builtin_amdgcn_kernarg_segment_ptr();
        asm volatile("" : "+s"(P));
        TC tc; tc.tid = threadIdx.x; tc.bid = blockIdx.x; tc.G = gridDim.x;
        asm volatile("" : "+v"(tc.tid)); asm volatile("" : "+s"(tc.bid)); asm volatile("" : "+s"(tc.G));
        unsigned char* ws = P->ws;
#ifndef PHMASK
#define PHMASK 0xFFFF
#endif
        if (ph == 0) { if (PHMASK & 1) phase_prologue(tc, P, lds); }
        else if (ph == NPHASE - 1) { if (PHMASK & 2) phase_final(tc, P); }
        else {
            const int l = (ph - 1) / NSP, sp = (ph - 1) % NSP;
            const int pm_off = (l == DEPTH - 1) ? 8 : 0, r0 = pm_off * 256, Mrows = MALL - r0;
#define WL(off) ((const bf16_t*)(ws + WS_W + (size_t)l * SZ_WL + (off)))
#define HB_ ((bf16_t*)(ws + WS_HB))
#define XC_ ((float*)(ws + WS_XC))
#define MODL ((const float*)(ws + WS_MOD) + (size_t)l * 9 * 6144)
            switch (sp) {
            case 0: if (PHMASK & (1 << 2)) phase_norm(tc, P, lds, l, 0, (l == 0) ? P->in[0] : (const float*)P->out, (l == 0) ? P->in[2] : (const float*)XC_, 0, true); break;
            case 1: if (PHMASK & (1 << 3)) { pg8::Gemm g{HB_, WL(0), MALL, NZ, DM, DM}; pg8::StaticOrder S; S.init(MALL, NZ, tc.G, tc.bid); pg8::EpiBf<0> E{(bf16_t*)(ws + WS_Z), NZ}; pg8::gemm_phase(tc, lds, g, S, E); } break;
            case 2: if (PHMASK & (1 << 4)) phase_mixpre(tc, P, l); break;
            case 3: if (PHMASK & (1 << 5)) { if (CHAIN_NEW & 4) phase_gdnpre(tc, P, lds, l); } break;
            case 4: if (PHMASK & (1 << 6)) phase_mixscan(tc, P, lds, l); break;
            case 5: if (PHMASK & (1 << 7)) phase_combine(tc, P, l, r0); break;
            case 6: if (PHMASK & (1 << 8)) phase_glu(tc, P, lds, l, r0); break;
            case 7: if (PHMASK & (1 << 9)) { pg8::Gemm g{HB_ + (size_t)r0 * DM, WL(SZ_WIN), Mrows, DM, DM, DM}; pg8::StaticOrder S; S.init(Mrows, DM, tc.G, tc.bid);
                      pg8::EpiRes E{(l == 0) ? P->in[0] : (const float*)P->out, (l == 0) ? P->in[2] : (const float*)XC_, P->out, XC_, MODL + 2 * DM, pm_off}; pg8::gemm_phase(tc, lds, g, S, E); } break;
            case 8: if (PHMASK & (1 << 10)) phase_norm(tc, P, lds, l, 1, P->out, XC_, r0, false); break;
            case 9: if (PHMASK & (1 << 11)) { pg8::Gemm g{HB_ + (size_t)r0 * DM, WL(SZ_WIN + SZ_WOUT), Mrows, DFF, DM, DM}; pg8::StaticOrder S; S.init(Mrows, DFF, tc.G, tc.bid); pg8::EpiBf<1> E{(bf16_t*)(ws + WS_U) + (size_t)r0 * DFF, DFF}; pg8::gemm_phase(tc, lds, g, S, E); } break;
            case 10: if (PHMASK & (1 << 12)) { pg8::Gemm g{(const bf16_t*)(ws + WS_U) + (size_t)r0 * DFF, WL(SZ_WIN + SZ_WOUT + SZ_W1), Mrows, DM, DFF, DFF}; pg8::StaticOrder S; S.init(Mrows, DM, tc.G, tc.bid);
                      pg8::EpiRes E{P->out, XC_, P->out, XC_, MODL + 5 * DM, pm_off}; pg8::gemm_phase(tc, lds, g, S, E); } break;
            }
        }
        if (ph + 1 < Pk.ph_hi) { if (ph == Pk.ph_lo) grid.sync(); else xcd_barrier((unsigned*)(P->ws + WS_CTL), bst, tc.tid, (unsigned)tc.G); }
    }
}

extern "C" void kernel_launch(void* const* d_in, const int* in_sizes, int n_in, void* d_out, int out_size, void* d_ws, size_t ws_size, hipStream_t stream) {
    static int grid = 0;
    if (grid == 0) {
        if (n_in != 30 || in_sizes[0] != MLAT * DM || out_size != MLAT * DM || ws_size < WS_TOTAL) {
            fprintf(stderr, "kernel_launch: unexpected shapes: n_in %d in0 %d out %d ws %zu (need %zu)\n", n_in, n_in > 0 ? in_sizes[0] : -1, out_size, ws_size, (size_t)WS_TOTAL); grid = -1; return; }
        int dev = 0, cus = 0, per_cu = 0;
        hipGetDevice(&dev); hipDeviceGetAttribute(&cus, hipDeviceAttributeMultiprocessorCount, dev);
        if (hipFuncSetAttribute((const void*)mega, hipFuncAttributeMaxDynamicSharedMemorySize, LDS_BYTES) != hipSuccess) { fprintf(stderr, "kernel_launch: hipFuncSetAttribute failed\n"); grid = -1; return; }
        if (hipOccupancyMaxActiveBlocksPerMultiprocessor(&per_cu, (const void*)mega, 512, LDS_BYTES) != hipSuccess || per_cu < 1) { fprintf(stderr, "kernel_launch: occupancy query failed (%d)\n", per_cu); (void)hipGetLastError(); per_cu = 1; }
        grid = cus * 1;
        if (per_cu < 1) grid = -1;
    }
    if (grid < 0) return;
    if (hipMemsetAsync((char*)d_ws + WS_CTL, 0, CTL_BYTES, stream) != hipSuccess) { fprintf(stderr, "kernel_launch: memset failed\n"); return; }
    Params p{};
    for (int i = 0; i < 30; ++i) p.in[i] = (const float*)d_in[i];
    p.out = (float*)d_out; p.ws = (unsigned char*)d_ws;
#if MK_MULTI
    for (int ph = 0; ph < NPHASE; ++ph) { p.ph_lo = ph; p.ph_hi = ph + 1; hipLaunchKernelGGL(mega, dim3(grid), dim3(512), LDS_BYTES, stream, p); }
#else
    p.ph_lo = 0; p.ph_hi = NPHASE;
    void* args[] = {&p};
    hipError_t e = hipLaunchCooperativeKernel((const void*)mega, dim3(grid), dim3(512), args, LDS_BYTES, stream);
    if (e != hipSuccess) fprintf(stderr, "cooperative launch failed: %s (grid %d)\n", hipGetErrorString(e), grid);
#endif
}
```

```cpp
#include <hip/hip_runtime.h>
#include <hip/hip_cooperative_groups.h>
#include <cstdio>
#include <cstdint>
namespace cg = cooperative_groups;

#ifndef MK_MULTI
#define MK_MULTI 0
#endif
#ifndef CHAIN_DUP
#define CHAIN_DUP 0
#endif
#ifndef HG_DUP
#define HG_DUP 0
#endif

#define LAS __attribute__((address_space(3)))
typedef unsigned short bf16_t;
typedef short bf16x8 __attribute__((ext_vector_type(8)));
typedef float f32x4 __attribute__((ext_vector_type(4)));
typedef float f32x2 __attribute__((ext_vector_type(2)));
typedef unsigned u32x4 __attribute__((ext_vector_type(4)));
typedef unsigned u32x2 __attribute__((ext_vector_type(2)));

constexpr int NB = 8, TLAT = 4096, TCTX = 256, DM = 1024, DEPTH = 2, DG = 256, DIN = 3600, NZ = 3584, DFF = 4096;
constexpr int MCTX = NB * TCTX, MLAT = NB * TLAT, MALL = MCTX + MLAT;
constexpr int TSEQ = TCTX + TLAT;
constexpr float EPS = 1e-6f;
constexpr int ZC_HQ = 0, ZC_HI = 256, ZC_HG = 512, ZC_HF = 768, ZC_RQ = 1280, ZC_RK = 1536, ZC_RV = 1792, ZC_RG = 2048, ZC_GQKV = 2304, ZC_GG = 3072, ZC_SU = 3328;

constexpr size_t SZ_WIN = (size_t)NZ * DM * 2, SZ_WOUT = (size_t)DM * DM * 2, SZ_W1 = (size_t)DFF * DM * 2, SZ_W2 = (size_t)DM * DFF * 2, SZ_GLU = (size_t)DG * DG * 2, SZ_WAB = 16 * DM * 4;
constexpr size_t SZ_WL = SZ_WIN + SZ_WOUT + SZ_W1 + SZ_W2 + SZ_GLU + SZ_WAB;
constexpr size_t WS_W = 0;
constexpr size_t WS_MOD = WS_W + 2 * SZ_WL;
constexpr size_t WS_ROPE = WS_MOD + (size_t)2 * 9 * 6144 * 4;
constexpr size_t WS_LB = WS_ROPE + (size_t)TSEQ * 32 * 2 * 4;
constexpr size_t WS_S5P = WS_LB + 4096;
constexpr size_t WS_XC = WS_S5P + (size_t)2 * 2 * 16 * 64 * 34 * 4;
constexpr size_t WS_AB = WS_XC + (size_t)MCTX * DM * 4;
constexpr size_t WS_HB = WS_AB + (size_t)MALL * 16 * 4;
constexpr size_t WS_Z = WS_HB + (size_t)MALL * DM * 2;
constexpr size_t WS_OF = WS_Z + (size_t)MALL * NZ * 2;
constexpr size_t WS_OB = WS_OF + (size_t)MALL * DM * 2;
constexpr size_t WS_END = WS_OB + (size_t)MALL * DM * 2;
constexpr size_t WS_CTL = WS_END;
constexpr size_t CTL_BYTES = 16384;
constexpr size_t WS_TOTAL = WS_CTL + CTL_BYTES;
constexpr size_t WS_U = WS_Z;
static_assert(WS_U + (size_t)MALL * DFF * 2 <= WS_END, "U overlay");
static_assert(WS_MOD % 256 == 0 && WS_ROPE % 256 == 0 && WS_S5P % 256 == 0 && WS_XC % 256 == 0 && WS_AB % 256 == 0 && WS_HB % 256 == 0 && WS_Z % 256 == 0 && WS_OF % 256 == 0, "align");

constexpr int LDS_BYTES = 147456;
constexpr int NSP = 11, NPHASE = 2 + 2 * NSP;

struct Params {
    const float* in[30];
    float* out;
    unsigned char* ws;
    int ph_lo, ph_hi;
};
typedef const __attribute__((address_space(4))) Params* KP;
struct TC { int tid, bid, G; };

__device__ __forceinline__ unsigned f2bf(float f) { unsigned u = __builtin_bit_cast(unsigned, f); return (u + 0x7fffu + ((u >> 16) & 1u)) >> 16; }
typedef __bf16 bf16x2_t __attribute__((ext_vector_type(2)));
__device__ __forceinline__ unsigned pk2(float lo, float hi) { const f32x2 v = {lo, hi}; return __builtin_bit_cast(unsigned, __builtin_convertvector(v, bf16x2_t)); }
__device__ __forceinline__ float bflo(unsigned w) { return __builtin_bit_cast(float, w << 16); }
__device__ __forceinline__ float bfhi(unsigned w) { return __builtin_bit_cast(float, w & 0xffff0000u); }
__device__ __forceinline__ float wave_sum(float v) {
#define WS_DPP(ctrl, rmask, bc) v += __builtin_bit_cast(float, __builtin_amdgcn_update_dpp(0, __builtin_bit_cast(int, v), ctrl, rmask, 0xf, bc))
    WS_DPP(0x111, 0xf, true); WS_DPP(0x112, 0xf, true); WS_DPP(0x114, 0xf, true); WS_DPP(0x118, 0xf, true);
    WS_DPP(0x142, 0xa, false);
    WS_DPP(0x143, 0xc, false);
#undef WS_DPP
    return __builtin_bit_cast(float, __builtin_amdgcn_readlane(__builtin_bit_cast(int, v), 63));
}
__device__ __forceinline__ float quad_sum(float x) {
    x += __builtin_bit_cast(float, __builtin_amdgcn_mov_dpp(__builtin_bit_cast(int, x), 0xB1, 0xf, 0xf, true));
    x += __builtin_bit_cast(float, __builtin_amdgcn_mov_dpp(__builtin_bit_cast(int, x), 0x4E, 0xf, 0xf, true));
    return x;
}
__device__ __forceinline__ float sigmoidf_(float x) { return __builtin_amdgcn_rcpf(1.0f + __builtin_amdgcn_exp2f(-1.4426950408889634f * x)); }
__device__ __forceinline__ float siluf_(float x) { return x / (1.0f + __expf(-x)); }
__device__ __forceinline__ float gelu_tanh(float x) { const float u = 0.7978845608028654f * (x + 0.044715f * x * x * x); return 0.5f * x * (1.0f + tanhf(u)); }
__device__ __forceinline__ float reduce16(float (&p)[16], int lane) {
    bool b = (lane & 32) != 0;
#pragma unroll
    for (int i = 0; i < 8; ++i) { const float keep = b ? p[i + 8] : p[i], send = b ? p[i] : p[i + 8]; p[i] = keep + __shfl_xor(send, 32); }
    b = (lane & 16) != 0;
#pragma unroll
    for (int i = 0; i < 4; ++i) { const float keep = b ? p[i + 4] : p[i], send = b ? p[i] : p[i + 4]; p[i] = keep + __shfl_xor(send, 16); }
    b = (lane & 8) != 0;
#pragma unroll
    for (int i = 0; i < 2; ++i) { const float keep = b ? p[i + 2] : p[i], send = b ? p[i] : p[i + 2]; p[i] = keep + __shfl_xor(send, 8); }
    b = (lane & 4) != 0;
    { const float keep = b ? p[1] : p[0], send = b ? p[0] : p[1]; p[0] = keep + __shfl_xor(send, 4); }
    p[0] += __shfl_xor(p[0], 2); p[0] += __shfl_xor(p[0], 1);
    return p[0];
}
__device__ __forceinline__ int seq_row(int b, int d, int j) {
    if (j < TCTX) return b * TCTX + (d ? (TCTX - 1 - j) : j);
    const int t = j - TCTX; return MCTX + b * TLAT + (d ? (TLAT - 1 - t) : t);
}

__device__ __forceinline__ int seq_row0(int b, int d, int j0) { return __builtin_amdgcn_readfirstlane(seq_row(b, d, j0)); }

namespace pg8 {
constexpr int BM = 256, BK = 64, HALF = 128, HTB = HALF * BK * 2, STAGE_BYTES = 8 * HTB, NXCD = 8, WGM = 8;
__host__ __device__ __forceinline__ int lds_byte(int r, int c) { const int st = (r >> 4) * 2 + (c >> 5), rr = r & 15, cc = c & 31, ob = rr * 64 + cc * 2; return st * 1024 + (ob ^ (((ob >> 9) & 1) << 5)); }
__host__ __device__ __forceinline__ void stage_rc(int b, int& R, int& C) { const int st = b / 1024, sb = b % 1024, swz = sb ^ (((sb >> 9) & 1) << 5); R = (st >> 1) * 16 + swz / 64; C = (st & 1) * 32 + (swz % 64) / 2; }
__host__ __device__ __forceinline__ int perm32(int rho) { const int n = rho >> 4, i = rho & 15; return 8 * (i >> 2) + 4 * n + (i & 3); }
struct Unit { int pm, pn, k0, nt, split; };
struct Gemm { const bf16_t* A; const bf16_t* Bt; int M, N, K, lda; };
struct StaticOrder {
    int nM, nN, nwg, G, c;
    __device__ void init(int M, int N, int G_, int c_) { nM = M / BM; nN = N / BM; nwg = nM * nN; G = G_; c = c_; }
    __device__ bool next(int i, Unit& u) const {
        const long L = (long)i * G + c; if (L >= nwg) return false;
        int wgid = (int)L; { const int q = nwg / NXCD, r = nwg % NXCD, xcd = wgid % NXCD, off = wgid / NXCD; wgid = (xcd < r ? xcd * (q + 1) : r * (q + 1) + (xcd - r) * q) + off; }
        const int nig = WGM * nN, gid = wgid / nig, fm = gid * WGM, gsz = (nM - fm) < WGM ? (nM - fm) : WGM;
        u.pm = fm + ((wgid % nig) % gsz); u.pn = (wgid % nig) / gsz; u.k0 = 0; u.nt = KT; u.split = 0; return true;
    }
    int KT;
};
struct SplitOrder {
    StaticOrder base; int G, c, KT;
    __device__ void init(int N, int K, int G_, int c_) { base.init(MLAT, N, G_, c_); base.KT = K / BK; G = G_; c = c_; KT = K / BK; }
    __device__ bool next(int i, Unit& u) const {
        const int L = i * G + c;
        if (L < base.nwg) { base.next(i, u); u.pm += 8; return true; }
        const int idx = L - base.nwg; if (idx >= 256) return false;
#ifdef SPLIT_OFF
        if (idx >= 32) return false; u.pm = idx >> 2; u.pn = idx & 3; u.k0 = 0; u.nt = KT; u.split = 0; return true;
#endif
        const int ks = idx & 7, tile = idx >> 3; u.pm = tile >> 2; u.pn = tile & 3; u.k0 = ks * (KT / 8) * BK; u.nt = KT / 8; u.split = ks + 1; return true;
    }
};
template <class Epi, class Sched>
__device__ __forceinline__ void gemm_phase(const TC tc, LAS unsigned char* lds, const Gemm g, const Sched& S, const Epi& E) {
    const int tid = tc.tid, wid = __builtin_amdgcn_readfirstlane(tid >> 6), lane = tid & 63, wr = wid >> 2, wc = wid & 3, fr = lane & 15, fq = lane >> 4;
    const int K = g.K, lda = g.lda;
    unsigned voffA[2], voffB[2];
#pragma unroll
    for (int i = 0; i < 2; ++i) { int R, C; stage_rc(tid * 16 + i * 8192, R, C); const int Rb = Epi::PERM ? ((R & ~31) + perm32(R & 31)) : R;
        voffA[i] = (unsigned)(R * lda + C) * 2u; voffB[i] = (unsigned)(Rb * K + C) * 2u; }
    const size_t kstep = (size_t)(BK * 2);
    const size_t hstepA = (size_t)HALF * lda * 2, hstepB = (size_t)HALF * K * 2;
    const size_t tstepA = 2 * hstepA, tstepB = 2 * hstepB;
    const unsigned ldsw = (unsigned)wid * 1024u;
    const int aoff = lds_byte(wr * 64 + fr, fq * 8), boff = lds_byte(wc * 32 + fr, fq * 8);
#define PG8_SA(b, h) (((b) * 2 + (h)) * HTB)
#define PG8_SB(b, h) ((4 + (b) * 2 + (h)) * HTB)
#define PG8_STAGE(bufoff, gbase, voff) do { _Pragma("unroll") for (int _i = 0; _i < 2; ++_i) \
        __builtin_amdgcn_global_load_lds((const unsigned*)((const char*)(gbase) + (voff)[_i]), (LAS unsigned*)(lds + (bufoff) + ldsw + _i * 8192), 16, 0, 0); } while (0)
#define PG8_LDA(dst, b, h) do { _Pragma("unroll") for (int m = 0; m < 4; ++m) _Pragma("unroll") for (int k = 0; k < 2; ++k) dst[m][k] = *(const LAS bf16x8*)(lds + PG8_SA(b, h) + aoff + m * 2048 + k * 1024); } while (0)
#define PG8_LDB(dst, b, h) do { _Pragma("unroll") for (int n = 0; n < 2; ++n) _Pragma("unroll") for (int k = 0; k < 2; ++k) dst[n][k] = *(const LAS bf16x8*)(lds + PG8_SB(b, h) + boff + n * 2048 + k * 1024); } while (0)
#define PG8_MMA(ai, bj, At, Bt) do { __builtin_amdgcn_s_setprio(1); _Pragma("unroll") for (int m = 0; m < 4; ++m) _Pragma("unroll") for (int n = 0; n < 2; ++n) _Pragma("unroll") for (int k = 0; k < 2; ++k) \
        acc[ai][bj][m][n] = __builtin_amdgcn_mfma_f32_16x16x32_bf16(Bt[n][k], At[m][k], acc[ai][bj][m][n], 0, 0, 0); __builtin_amdgcn_s_setprio(0); } while (0)
#define PG8_WAIT_V(n) asm volatile("s_waitcnt vmcnt(" #n ")" ::: "memory")
#define PG8_WAIT_L(n) asm volatile("s_waitcnt lgkmcnt(" #n ")" ::: "memory")
#define PG8_BAR __builtin_amdgcn_s_barrier()
#define PG8_SCHED __builtin_amdgcn_sched_barrier(0)
    Unit cur, nxt; int ui = 0;
    if (!S.next(0, cur)) return;
    f32x4 acc[2][2][4][2];
#pragma unroll
    for (int a = 0; a < 2; ++a)
#pragma unroll
        for (int b = 0; b < 2; ++b)
#pragma unroll
            for (int m = 0; m < 4; ++m)
#pragma unroll
                for (int n = 0; n < 2; ++n) acc[a][b][m][n] = (f32x4){0.f, 0.f, 0.f, 0.f};
    bf16x8 At[4][2], B0[2][2], B1[2][2];
    const char* cA = (const char*)g.A + (size_t)cur.pm * tstepA + (size_t)cur.k0 * 2; const char* cB = (const char*)g.Bt + (size_t)cur.pn * tstepB + (size_t)cur.k0 * 2;
    PG8_STAGE(PG8_SB(0, 0), cB, voffB); PG8_STAGE(PG8_SB(0, 1), cB + hstepB, voffB); PG8_STAGE(PG8_SA(0, 0), cA, voffA); PG8_STAGE(PG8_SA(0, 1), cA + hstepA, voffA);
    if (wr == 1) PG8_BAR;
    PG8_WAIT_V(2); PG8_BAR;
    PG8_STAGE(PG8_SB(1, 0), cB + kstep, voffB); PG8_STAGE(PG8_SA(1, 0), cA + kstep, voffA); PG8_STAGE(PG8_SB(1, 1), cB + hstepB + kstep, voffB);
    PG8_WAIT_V(6); PG8_BAR;
    for (;;) {
        const bool has_next = S.next(ui + 1, nxt);
        const char* nA = has_next ? (const char*)g.A + (size_t)nxt.pm * tstepA + (size_t)nxt.k0 * 2 : cA; const char* nB = has_next ? (const char*)g.Bt + (size_t)nxt.pn * tstepB + (size_t)nxt.k0 * 2 : cB;
        const int nt = cur.nt;
        for (int t = 0; t < nt; t += 2) {
            const bool last = (t == nt - 2);
            const char* a1 = cA + (size_t)(t + 1) * kstep;
            const char* a2 = last ? nA : cA + (size_t)(t + 2) * kstep; const char* b2 = last ? nB : cB + (size_t)(t + 2) * kstep;
            const char* a3 = a2 + kstep; const char* b3 = b2 + kstep;
            PG8_LDB(B0, 0, 0); PG8_LDB(B1, 0, 1); PG8_SCHED; PG8_LDA(At, 0, 0); PG8_STAGE(PG8_SA(1, 1), a1 + hstepA, voffA);
            PG8_WAIT_V(8); PG8_WAIT_L(0); PG8_BAR; PG8_MMA(0, 0, At, B0); PG8_MMA(0, 1, At, B1); PG8_BAR; PG8_SCHED;
            PG8_LDA(At, 0, 1); PG8_STAGE(PG8_SB(0, 0), b2, voffB); PG8_STAGE(PG8_SB(0, 1), b2 + hstepB, voffB); PG8_STAGE(PG8_SA(0, 0), a2, voffA);
            PG8_WAIT_V(8); PG8_WAIT_L(0); PG8_BAR; PG8_MMA(1, 0, At, B0); PG8_MMA(1, 1, At, B1); PG8_BAR; PG8_SCHED;
            PG8_LDB(B0, 1, 0); PG8_LDB(B1, 1, 1); PG8_SCHED; PG8_LDA(At, 1, 0); PG8_STAGE(PG8_SA(0, 1), a2 + hstepA, voffA);
            PG8_WAIT_V(8); PG8_WAIT_L(0); PG8_BAR; PG8_MMA(0, 0, At, B0); PG8_MMA(0, 1, At, B1); PG8_BAR; PG8_SCHED;
            PG8_LDA(At, 1, 1); PG8_STAGE(PG8_SB(1, 0), b3, voffB); PG8_STAGE(PG8_SB(1, 1), b3 + hstepB, voffB); PG8_STAGE(PG8_SA(1, 0), a3, voffA);
            PG8_WAIT_V(8); PG8_WAIT_L(0); PG8_BAR; PG8_MMA(1, 0, At, B0); PG8_MMA(1, 1, At, B1); PG8_BAR; PG8_SCHED;
        }
        if (wr == 0) PG8_BAR;
        E(acc, cur, wr, wc, fr, fq);
        if (!has_next) break;
#pragma unroll
        for (int a = 0; a < 2; ++a)
#pragma unroll
            for (int b = 0; b < 2; ++b)
#pragma unroll
                for (int m = 0; m < 4; ++m)
#pragma unroll
                    for (int n = 0; n < 2; ++n) acc[a][b][m][n] = (f32x4){0.f, 0.f, 0.f, 0.f};
        cur = nxt; cA = nA; cB = nB; ++ui;
        if (wr == 1) PG8_BAR;
    }
    PG8_WAIT_V(0);
    PG8_BAR;
#undef PG8_SA
#undef PG8_SB
#undef PG8_STAGE
#undef PG8_LDA
#undef PG8_LDB
#undef PG8_MMA
#undef PG8_WAIT_V
#undef PG8_WAIT_L
#undef PG8_BAR
#undef PG8_SCHED
}

template <int ACT> struct EpiBf {
    static constexpr bool PERM = true;
    bf16_t* O; int ldc;
    __device__ __forceinline__ void operator()(const f32x4 (&acc)[2][2][4][2], const Unit& u, int wr, int wc, int fr, int fq) const {
        const int row0 = u.pm * BM + wr * 64 + fr, col0 = u.pn * BM + wc * 32 + 8 * fq;
#pragma unroll
        for (int ai = 0; ai < 2; ++ai)
#pragma unroll
            for (int m = 0; m < 4; ++m) { bf16_t* rowp = O + (size_t)(row0 + ai * HALF + m * 16) * ldc + col0;
#pragma unroll
                for (int bj = 0; bj < 2; ++bj) { f32x4 v0 = acc[ai][bj][m][0], v1 = acc[ai][bj][m][1];
                    if (ACT == 1) {
#pragma unroll
                        for (int e = 0; e < 4; ++e) { const float a = fmaxf(v0[e], 0.f), b = fmaxf(v1[e], 0.f); v0[e] = a * a; v1[e] = b * b; } }
                    u32x4 w; w.x = pk2(v0[0], v0[1]); w.y = pk2(v0[2], v0[3]); w.z = pk2(v1[0], v1[1]); w.w = pk2(v1[2], v1[3]);
                    *(u32x4*)(rowp + bj * HALF) = w; } }
    }
};
struct EpiRes {
    static constexpr bool PERM = false;
    const float* in_lat; const float* in_ctx; float* out_lat; float* out_ctx; const float* gate; int pm_off;
    float* slab;
    __device__ __forceinline__ void operator()(const f32x4 (&acc)[2][2][4][2], const Unit& u, int wr, int wc, int fr, int fq) const {
        if (u.split) {
            float* sp = slab + ((size_t)(u.split - 1) * MCTX + (size_t)u.pm * 256) * DM + u.pn * BM + wc * 32 + 4 * fq;
#pragma unroll
            for (int ai = 0; ai < 2; ++ai)
#pragma unroll
                for (int m = 0; m < 4; ++m) { int fr2 = fr; asm volatile("" : "+v"(fr2)); float* rp = sp + (size_t)(ai * HALF + wr * 64 + m * 16 + fr2) * DM;
#pragma unroll
                    for (int bj = 0; bj < 2; ++bj)
#pragma unroll
                        for (int n = 0; n < 2; ++n) *(f32x4*)(rp + bj * HALF + n * 16) = acc[ai][bj][m][n];
                    asm volatile("" ::: "memory"); }
            return;
        }
        const int gpm = u.pm + pm_off;
        const float* rin; float* rout; int v;
        if (gpm < 8) { rin = in_ctx + (size_t)gpm * 256 * DM; rout = out_ctx + (size_t)gpm * 256 * DM; v = 8; }
        else { rin = in_lat + (size_t)(gpm - 8) * 256 * DM; rout = out_lat + (size_t)(gpm - 8) * 256 * DM; v = (gpm - 8) >> 4; }
        const int col0 = u.pn * BM + wc * 32 + 4 * fq;
        const float* gp = gate + (size_t)v * 6144 + col0;
        f32x4 gv[2][2];
#pragma unroll
        for (int bj = 0; bj < 2; ++bj)
#pragma unroll
            for (int n = 0; n < 2; ++n) gv[bj][n] = *(const f32x4*)(gp + bj * HALF + n * 16);
#pragma unroll
        for (int ai = 0; ai < 2; ++ai)
#pragma unroll
            for (int m = 0; m < 4; ++m) { const size_t off = (size_t)(ai * HALF + wr * 64 + m * 16 + fr) * DM + col0;
#pragma unroll
                for (int bj = 0; bj < 2; ++bj)
#pragma unroll
                    for (int n = 0; n < 2; ++n) { const f32x4 x = *(const f32x4*)(rin + off + bj * HALF + n * 16); *(f32x4*)(rout + off + bj * HALF + n * 16) = x + gv[bj][n] * acc[ai][bj][m][n]; }
                asm volatile("" ::: "memory"); }
    }
};
}

__device__ __forceinline__ void transpose_item(const float* W, int ldw, int c0, int K, bf16_t* WT, int nblk, LAS float* scr, int item, int lane) {
    const int kb = item / nblk, nb = item % nblk, k0 = 64 * kb, n0 = 32 * nb;
#pragma unroll 8
    for (int i = 0; i < 32; ++i) { const int kk = 2 * i + (lane >> 5); scr[kk * 33 + (lane & 31)] = W[(size_t)(k0 + kk) * ldw + c0 + n0 + (lane & 31)]; }
    asm volatile("s_waitcnt lgkmcnt(0)" ::: "memory");
    const int c = lane & 7;
#pragma unroll
    for (int j = 0; j < 4; ++j) { const int n = (lane >> 3) + 8 * j; const LAS float* s = scr + (8 * c) * 33 + n;
        u32x4 o; o.x = pk2(s[0 * 33], s[1 * 33]); o.y = pk2(s[2 * 33], s[3 * 33]); o.z = pk2(s[4 * 33], s[5 * 33]); o.w = pk2(s[6 * 33], s[7 * 33]);
        *(u32x4*)(WT + (size_t)(n0 + n) * K + k0 + 8 * c) = o; }
    asm volatile("s_waitcnt lgkmcnt(0)" ::: "memory");
}

__device__ __forceinline__ void phase_prologue(const TC tc, KP P, LAS unsigned char* lds) {
    const int tid = tc.tid, lane = tid & 63, wave = tid >> 6;
    const int G = tc.G, gw = tc.bid * 8 + wave, NGW = G * 8;
    unsigned char* ws = P->ws;
    {
        LAS float* scr = (LAS float*)(lds + wave * 8704);
        constexpr int I_IN_A = 16 * 104, I_IN_B = 16 * 8, I_OUT = 16 * 32, I_1 = 16 * 128, I_2 = 64 * 32, I_G = 4 * 8;
        constexpr int I_L = I_IN_A + I_IN_B + I_OUT + I_1 + I_2 + I_G;
        for (int it = gw; it < 2 * I_L; it += NGW) {
            const int l = it / I_L; int r = it % I_L;
            unsigned char* wl = ws + WS_W + (size_t)l * SZ_WL;
            bf16_t* win = (bf16_t*)wl; bf16_t* wout = (bf16_t*)(wl + SZ_WIN); bf16_t* w1 = (bf16_t*)(wl + SZ_WIN + SZ_WOUT); bf16_t* w2 = (bf16_t*)(wl + SZ_WIN + SZ_WOUT + SZ_W1);
            bf16_t* wg = (bf16_t*)(wl + SZ_WIN + SZ_WOUT + SZ_W1 + SZ_W2);
            if (r < I_IN_A) { transpose_item(P->in[8] + (size_t)l * DM * DIN, DIN, 0, DM, win, 104, scr, r, lane); continue; } r -= I_IN_A;
            if (r < I_IN_B) { transpose_item(P->in[8] + (size_t)l * DM * DIN, DIN, 3344, DM, win + (size_t)3328 * DM, 8, scr, r, lane); continue; } r -= I_IN_B;
            if (r < I_OUT) { transpose_item(P->in[26] + (size_t)l * DM * DM, DM, 0, DM, wout, 32, scr, r, lane); continue; } r -= I_OUT;
            if (r < I_1) { transpose_item(P->in[27] + (size_t)l * DM * DFF, DFF, 0, DM, w1, 128, scr, r, lane); continue; } r -= I_1;
            if (r < I_2) { transpose_item(P->in[28] + (size_t)l * DFF * DM, DM, 0, DFF, w2, 32, scr, r, lane); continue; } r -= I_2;
            transpose_item(P->in[24] + (size_t)l * DG * DG, DG, 0, DG, wg, 8, scr, r, lane);
        }
    }
    const int gt = tc.bid * 512 + tid, NGT = G * 512;
    for (int i = gt; i < 2 * 16 * DM; i += NGT) { const int l = i / (16 * DM), c = (i / DM) % 16, k = i % DM;
        ((float*)(ws + WS_W + (size_t)l * SZ_WL + SZ_WL - SZ_WAB))[c * DM + k] = P->in[8][(size_t)l * DM * DIN + (size_t)k * DIN + 3328 + c]; }
    for (int i = gt; i < TSEQ * 32; i += NGT) { const int pos = i >> 5, f = i & 31;
        const float inv = powf(10000.0f, -(float)f / 32.0f); const float ang = (float)pos * inv; float s, c; sincosf(ang, &s, &c);
        ((f32x2*)(ws + WS_ROPE))[i] = (f32x2){c, s}; }
    for (int i = gt; i < 2 * DG; i += NGT) { const float a = P->in[9][i], b = P->in[9][2 * DG + i]; const float mx = fmaxf(a, b), ea = expf(a - mx), eb = expf(b - mx);
        float* lb = (float*)(ws + WS_LB); lb[i] = 0.f; lb[2 * DG + i] = eb / (ea + eb); }
    for (int i = gt; i < 2 * 2 * 16 * 64; i += NGT) { const int p = i & 63, g = (i >> 6) & 15, d = (i >> 10) & 1, l = i >> 11;
        const float lr = P->in[16][i], li = P->in[17][i]; const float dt = expf(P->in[18][(l * 2 + d) * 16 + g]);
        const float mag = expf(lr * dt); float sn, cs; sincosf(li * dt, &sn, &cs); const float ar = mag * cs, ai = mag * sn;
        const float den = lr * lr + li * li, nr = ar - 1.0f, ni = ai; const float fr = (nr * lr + ni * li) / den, fi = (ni * lr - nr * li) / den;
        float* o = (float*)(ws + WS_S5P) + (size_t)i * 34; o[0] = ar; o[1] = ai;
        const float* bre = P->in[19] + ((size_t)(l * 16 + g) * 64 + p) * 16; const float* bim = P->in[20] + ((size_t)(l * 16 + g) * 64 + p) * 16;
        for (int c = 0; c < 16; ++c) { o[2 + c] = fr * bre[c] - fi * bim[c]; o[18 + c] = fr * bim[c] + fi * bre[c]; } }
    __syncthreads();
    {
        LAS float* sc = (LAS float*)lds;
        LAS float* red = (LAS float*)(lds + 36864);
        for (int i = tid; i < 9 * DM; i += 512) { const int v = i >> 10, k = i & 1023; const float x = v < 8 ? P->in[1][v * DM + k] : P->in[3][k]; sc[i] = siluf_(x); }
        __syncthreads();
        for (int item = tc.bid; item < 2 * 96; item += G) {
            const int l = item / 96, cg0 = (item % 96) * 64;
            const int c4 = (tid & 15) * 4, kl = tid >> 4;
            const float* W = P->in[4] + (size_t)l * DM * 6144 + cg0 + c4;
            f32x4 a[9];
#pragma unroll
            for (int v = 0; v < 9; ++v) a[v] = (f32x4){0.f, 0.f, 0.f, 0.f};
            for (int k = kl; k < DM; k += 32) { const f32x4 w = *(const f32x4*)(W + (size_t)k * 6144);
#pragma unroll
                for (int v = 0; v < 9; ++v) a[v] += w * sc[v * DM + k]; }
#pragma unroll
            for (int v = 0; v < 9; ++v) *(LAS f32x4*)(red + kl * 576 + v * 64 + c4) = a[v];
            __syncthreads();
            for (int o = tid; o < 576; o += 512) { float s = 0.f; for (int q = 0; q < 32; ++q) s += red[q * 576 + o];
                const int v = o >> 6, c = cg0 + (o & 63);
                ((float*)(ws + WS_MOD))[((size_t)l * 9 + v) * 6144 + c] = s + P->in[5][l * 6144 + c]; }
            __syncthreads();
        }
    }
}

__device__ __forceinline__ void phase_norm(const TC tc, KP P, LAS unsigned char* lds, int l, int which, const float* src_lat, const float* src_ctx, int r0, bool do_ab, const float* slab = nullptr, const float* slabgate = nullptr, int r1 = MALL) {
    const int tid = tc.tid, lane = tid & 63, wave = tid >> 6;
    const int gw = tc.bid * 8 + wave, NGW = tc.G * 8;
    unsigned char* ws = P->ws;
    LAS float* wab = (LAS float*)lds;
    if (do_ab) { const float* src = (const float*)(ws + WS_W + (size_t)l * SZ_WL + SZ_WL - SZ_WAB);
        for (int i = tid; i < 16 * DM / 4; i += 512) ((LAS f32x4*)wab)[i] = ((const f32x4*)src)[i];
        __syncthreads(); }
    const float* gvec = P->in[which ? 7 : 6] + l * DM;
    const float* mod = (const float*)(ws + WS_MOD) + (size_t)l * 9 * 6144;
    bf16_t* H = (bf16_t*)(ws + WS_HB);
    float* AB = (float*)(ws + WS_AB);
    const int per = (r1 - r0 + NGW - 1) / NGW, rbeg = r0 + gw * per, rend = (rbeg + per < r1) ? rbeg + per : r1;
    int vcur = -1; f32x4 gs[4], sh[4], x[4], nx[4];
    auto rowptr = [&](int r) -> const float* { return r < MCTX ? src_ctx + (size_t)r * DM : src_lat + (size_t)(r - MCTX) * DM; };
    if (rbeg < rend) {
#pragma unroll
        for (int j = 0; j < 4; ++j) nx[j] = ((const f32x4*)rowptr(rbeg))[j * 64 + lane]; }
    for (int r = rbeg; r < rend; ++r) {
        const int v = r < MCTX ? 8 : (r - MCTX) >> 12;
#pragma unroll
        for (int j = 0; j < 4; ++j) x[j] = nx[j];
        if (r + 1 < rend) {
#pragma unroll
            for (int j = 0; j < 4; ++j) nx[j] = ((const f32x4*)rowptr(r + 1))[j * 64 + lane]; }
#ifdef SPLIT_OFF
        if (false) {
#else
        if (slab && r < MCTX) {
#endif
#pragma unroll
            for (int j = 0; j < 4; ++j) { f32x4 sacc = ((const f32x4*)(slab + (size_t)r * DM))[j * 64 + lane];
#pragma unroll
                for (int ks = 1; ks < 8; ++ks) sacc += ((const f32x4*)(slab + ((size_t)ks * MCTX + r) * DM))[j * 64 + lane];
                x[j] += ((const f32x4*)slabgate)[j * 64 + lane] * sacc; } }
        if (v != vcur) { vcur = v;
            const float* shp = mod + (size_t)v * 6144 + (which ? 3 : 0) * DM; const float* scl = mod + (size_t)v * 6144 + (which ? 4 : 1) * DM;
#pragma unroll
            for (int j = 0; j < 4; ++j) { gs[j] = ((const f32x4*)gvec)[j * 64 + lane] * (1.0f + ((const f32x4*)scl)[j * 64 + lane]); sh[j] = ((const f32x4*)shp)[j * 64 + lane]; } }
        float ss = 0.f;
#pragma unroll
        for (int j = 0; j < 4; ++j) ss += (x[j].x * x[j].x + x[j].y * x[j].y) + (x[j].z * x[j].z + x[j].w * x[j].w);
        const float rstd = rsqrtf(wave_sum(ss) * (1.0f / DM) + EPS);
#pragma unroll
        for (int j = 0; j < 4; ++j) { x[j] = x[j] * rstd * gs[j] + sh[j];
            u32x2 w; w.x = pk2(x[j].x, x[j].y); w.y = pk2(x[j].z, x[j].w);
            ((u32x2*)(H + (size_t)r * DM))[j * 64 + lane] = w; }
        if (do_ab) {
#pragma unroll 1
            for (int cq = 0; cq < 4; ++cq) {
                float p[4];
#pragma unroll
                for (int c = 0; c < 4; ++c) { float a = 0.f;
#pragma unroll
                    for (int j = 0; j < 4; ++j) { const f32x4 w = *(const LAS f32x4*)(wab + (cq * 4 + c) * DM + (j * 64 + lane) * 4); a += (x[j].x * w.x + x[j].y * w.y) + (x[j].z * w.z + x[j].w * w.w); }
                    p[c] = a; }
                bool bb = (lane & 32) != 0;
                { const float k0 = bb ? p[2] : p[0], s0 = bb ? p[0] : p[2], k1 = bb ? p[3] : p[1], s1 = bb ? p[1] : p[3]; p[0] = k0 + __shfl_xor(s0, 32); p[1] = k1 + __shfl_xor(s1, 32); }
                bb = (lane & 16) != 0;
                { const float k0 = bb ? p[1] : p[0], s0 = bb ? p[0] : p[1]; p[0] = k0 + __shfl_xor(s0, 16); }
                float tot = p[0];
                tot += __shfl_xor(tot, 8); tot += __shfl_xor(tot, 4); tot += __shfl_xor(tot, 2); tot += __shfl_xor(tot, 1);
                if ((lane & 15) == 0) { const int c = cq * 4 + 2 * ((lane >> 5) & 1) + ((lane >> 4) & 1);
                    float o;
                    if (c < 8) { const int d = c >> 2, h = c & 3; const float xx = tot + P->in[14][(l * 2 + d) * 4 + h]; const float sp = xx > 20.f ? xx : log1pf(expf(xx));
                        o = -expf(P->in[13][(l * 2 + d) * 4 + h]) * sp; }
                    else o = 1.0f / (1.0f + expf(-tot));
                    AB[(size_t)r * 16 + c] = o; }
            }
        }
    }
}

__device__ __forceinline__ void phase_mixpre(const TC tc, KP P, int l) {
    const int tid = tc.tid, lane = tid & 63, wave = tid >> 6;
    const int gw = tc.bid * 8 + wave, NGW = tc.G * 8;
    unsigned char* ws = P->ws;
    bf16_t* Z = (bf16_t*)(ws + WS_Z);
    bf16_t* QC = (bf16_t*)(ws + WS_HB);
    const float* lb = (const float*)(ws + WS_LB) + l * 2 * DG;
    const f32x2* rope = (const f32x2*)(ws + WS_ROPE);
    const float* cw = P->in[12] + (size_t)l * 9 * 768;
    f32x4 cwr[27];
#pragma unroll
    for (int i = 0; i < 27; ++i) cwr[i] = *(const f32x4*)(cw + (i / 3) * 768 + (i % 3) * 256 + lane * 4);
    for (int r = gw; r < MALL; r += NGW) {
        bf16_t* zr = Z + (size_t)r * NZ;
        int pos, b, s; bool isctx = r < MCTX;
        if (isctx) { b = r >> 8; s = r & 255; pos = s; } else { b = (r - MCTX) >> 12; s = (r - MCTX) & 4095; pos = TCTX + s; }
        { u32x2 w = ((u32x2*)(zr + ZC_HQ))[lane];
          w.x = pk2(siluf_(bflo(w.x)) * 0.125f, siluf_(bfhi(w.x)) * 0.125f); w.y = pk2(siluf_(bflo(w.y)) * 0.125f, siluf_(bfhi(w.y)) * 0.125f);
          ((u32x2*)(zr + ZC_HQ))[lane] = w; }
        { u32x4 w = ((u32x4*)(zr + ZC_HF))[lane]; const int c0 = lane * 8; unsigned* pw = (unsigned*)&w;
#pragma unroll
          for (int e = 0; e < 4; ++e) { const int c = c0 + 2 * e;
              const float f0 = bflo(pw[e]), f1 = bfhi(pw[e]);
              const float l0 = fmaxf(lb[c], 1e-30f), l1 = fmaxf(lb[c + 1], 1e-30f);
              const float s0 = 1.0f / (1.0f + expf(-f0)), s1 = 1.0f / (1.0f + expf(-f1));
              pw[e] = pk2(logf(l0 * (1.0f - s0) + s0), logf(l1 * (1.0f - s1) + s1)); }
          ((u32x4*)(zr + ZC_HF))[lane] = w; }
        {
#pragma unroll
          for (int qk = 0; qk < 2; ++qk) { bf16_t* base = zr + (qk ? ZC_RK : ZC_RQ) + (lane >> 4) * 64 + (lane & 15) * 2;
              const unsigned w1 = *(const unsigned*)base, w2 = *(const unsigned*)(base + 32);
              const f32x2 cs0 = rope[pos * 32 + (lane & 15) * 2], cs1 = rope[pos * 32 + (lane & 15) * 2 + 1];
              const float sc = qk ? 0.125f : 1.0f;
              const float a0 = bflo(w1), a1 = bfhi(w1), b0 = bflo(w2), b1 = bfhi(w2);
              *(unsigned*)base = pk2((a0 * cs0.x - b0 * cs0.y) * sc, (a1 * cs1.x - b1 * cs1.y) * sc);
              *(unsigned*)(base + 32) = pk2((a0 * cs0.y + b0 * cs0.x) * sc, (a1 * cs1.y + b1 * cs1.x) * sc); } }
        {
            float acc[3][4];
#pragma unroll
            for (int g = 0; g < 3; ++g)
#pragma unroll
                for (int e = 0; e < 4; ++e) acc[g][e] = 0.f;
            const int gx = isctx ? s : (s & 63), gy = isctx ? 0 : (s >> 6), W = isctx ? TCTX : 64, Hh = isctx ? 1 : 64;
#pragma unroll
            for (int dy = 0; dy < 3; ++dy) { const int yy = gy + dy - 1; if (yy < 0 || yy >= Hh) continue;
#pragma unroll
                for (int dx = 0; dx < 3; ++dx) { const int xx = gx + dx - 1; if (xx < 0 || xx >= W) continue;
                    const int rr = r + (dy - 1) * 64 + (dx - 1);
                    const bf16_t* zn = Z + (size_t)rr * NZ + ZC_GQKV + lane * 4;
#pragma unroll
                    for (int g = 0; g < 3; ++g) { const u32x2 w = *(const u32x2*)(zn + g * 256); const f32x4 k = cwr[(dy * 3 + dx) * 3 + g];
                        acc[g][0] += bflo(w.x) * k.x; acc[g][1] += bfhi(w.x) * k.y; acc[g][2] += bflo(w.y) * k.z; acc[g][3] += bfhi(w.y) * k.w; } } }
#pragma unroll
            for (int g = 0; g < 3; ++g) {
#pragma unroll
                for (int e = 0; e < 4; ++e) acc[g][e] = siluf_(acc[g][e]);
                if (g < 2) { float ss = (acc[g][0] * acc[g][0] + acc[g][1] * acc[g][1]) + (acc[g][2] * acc[g][2] + acc[g][3] * acc[g][3]);
                    ss += __shfl_xor(ss, 1); ss += __shfl_xor(ss, 2); ss += __shfl_xor(ss, 4); ss += __shfl_xor(ss, 8);
                    const float rn = rsqrtf(ss + EPS) * (g == 0 ? 0.125f : 1.0f);
#pragma unroll
                    for (int e = 0; e < 4; ++e) acc[g][e] *= rn; }
                u32x2 w; w.x = pk2(acc[g][0], acc[g][1]); w.y = pk2(acc[g][2], acc[g][3]);
                *(u32x2*)(QC + (size_t)r * 768 + g * 256 + lane * 4) = w; }
        }
    }
}

constexpr int TB = 32, NBATCH = TSEQ / TB;
constexpr int CH_ARR = TB * 64 * 4;
constexpr int CH_BUF = 4 * CH_ARR + 256;
constexpr int CH_OS = 2 * CH_BUF;
static_assert(CH_OS + 2 * CH_ARR <= LDS_BYTES, "chain LDS");

template <int KIND>
__device__ __forceinline__ void chain_matrix(const TC tc, KP P, LAS unsigned char* lds, int l, int chain) {
    const int tid = tc.tid, lane = tid & 63, wave = tid >> 6;
    const int b = chain >> 3, h = (chain >> 1) & 3, d = chain & 1;
    unsigned char* ws = P->ws;
    const bf16_t* Z = (const bf16_t*)(ws + WS_Z);
    const bf16_t* QC = (const bf16_t*)(ws + WS_HB);
    const float* AB = (const float*)(ws + WS_AB);
    bf16_t* O = (bf16_t*)(ws + (d ? WS_OB : WS_OF));
    const int ocol = KIND * 256 + h * 64;
    const bool loader = wave >= 4;
    const int lt = tid - 256, ltok = lt >> 3, lseg = lt & 7;
    float gam = 0.f;
    if (KIND == 1) gam = 1.0f / (1.0f + expf(-P->in[11][(l * 2 + d) * 4 + h]));
    auto load = [&](int n, int bi) {
        const int row = seq_row(b, d, n * TB + ltok);
        LAS float* base = (LAS float*)(lds + bi * CH_BUF) + ltok * 64 + lseg * 8;
        u32x4 q, k, v;
        if (KIND == 0) { const bf16_t* zr = Z + (size_t)row * NZ + h * 64 + lseg * 8; q = *(const u32x4*)(zr + ZC_HQ); k = *(const u32x4*)(zr + ZC_HF + d * 256); v = *(const u32x4*)(zr + ZC_HI); }
        else if (KIND == 1) { const bf16_t* zr = Z + (size_t)row * NZ + h * 64 + lseg * 8; q = *(const u32x4*)(zr + ZC_RQ); k = *(const u32x4*)(zr + ZC_RK); v = *(const u32x4*)(zr + ZC_RV); }
        else { const bf16_t* qr = QC + (size_t)row * 768 + h * 64 + lseg * 8; q = *(const u32x4*)qr; k = *(const u32x4*)(qr + 256); v = *(const u32x4*)(qr + 512);
            if (lseg == 0) { LAS float* sc = (LAS float*)(lds + bi * CH_BUF + 4 * CH_ARR); sc[ltok * 2] = expf(AB[(size_t)row * 16 + d * 4 + h]); sc[ltok * 2 + 1] = AB[(size_t)row * 16 + 8 + d * 4 + h]; } }
        const unsigned* pq = (const unsigned*)&q; const unsigned* pk = (const unsigned*)&k; const unsigned* pv = (const unsigned*)&v;
#pragma unroll
        for (int e = 0; e < 4; ++e) {
            base[2 * e] = bflo(pq[e]); base[2 * e + 1] = bfhi(pq[e]);
            base[3 * TB * 64 + 2 * e] = bflo(pv[e]); base[3 * TB * 64 + 2 * e + 1] = bfhi(pv[e]);
            if (KIND == 0) { const float l0 = bflo(pk[e]), l1 = bfhi(pk[e]); const float f0 = expf(l0), f1 = expf(l1);
                base[TB * 64 + 2 * e] = f0; base[TB * 64 + 2 * e + 1] = f1; base[2 * TB * 64 + 2 * e] = -expm1f(l0); base[2 * TB * 64 + 2 * e + 1] = -expm1f(l1); }
            else { base[TB * 64 + 2 * e] = bflo(pk[e]); base[TB * 64 + 2 * e + 1] = bfhi(pk[e]); }
        }
    };
    auto store = [&](int n, int bi) {
        const int row = seq_row(b, d, n * TB + ltok);
        const LAS float* os = (const LAS float*)(lds + CH_OS + bi * CH_ARR) + ltok * 64 + lseg * 8;
        u32x4 w; w.x = pk2(os[0], os[1]); w.y = pk2(os[2], os[3]); w.z = pk2(os[4], os[5]); w.w = pk2(os[6], os[7]);
        *(u32x4*)(O + (size_t)row * DM + ocol + lseg * 8) = w;
    };
    float S[16];
#pragma unroll
    for (int i = 0; i < 16; ++i) S[i] = 0.f;
    const int vl = lane >> 2, kg = lane & 3, vcol = (wave & 3) * 16 + vl;
    if (loader) load(0, 0);
    __syncthreads();
    for (int n = 0; n < NBATCH; ++n) {
        if (loader) { if (n + 1 < NBATCH) load(n + 1, (n + 1) & 1); if (n >= 1) store(n - 1, (n - 1) & 1); }
        else {
            const LAS float* A0 = (const LAS float*)(lds + (n & 1) * CH_BUF);
            const LAS float* sc = (const LAS float*)(lds + (n & 1) * CH_BUF + 4 * CH_ARR);
            LAS float* os = (LAS float*)(lds + CH_OS + (n & 1) * CH_ARR);
#pragma unroll 2
            for (int tt = 0; tt < TB; ++tt) {
                const LAS float* a = A0 + tt * 64 + kg * 16;
                float q[16], k[16];
#pragma unroll
                for (int i = 0; i < 4; ++i) { const f32x4 t4 = *(const LAS f32x4*)(a + 4 * i); q[4 * i] = t4.x; q[4 * i + 1] = t4.y; q[4 * i + 2] = t4.z; q[4 * i + 3] = t4.w; }
#pragma unroll
                for (int i = 0; i < 4; ++i) { const f32x4 t4 = *(const LAS f32x4*)(a + TB * 64 + 4 * i); k[4 * i] = t4.x; k[4 * i + 1] = t4.y; k[4 * i + 2] = t4.z; k[4 * i + 3] = t4.w; }
                const float vv = A0[3 * TB * 64 + tt * 64 + vcol];
                float o = 0.f;
                if (KIND == 0) {
                    float kk[16];
#pragma unroll
                    for (int i = 0; i < 4; ++i) { const f32x4 t4 = *(const LAS f32x4*)(a + 2 * TB * 64 + 4 * i); kk[4 * i] = t4.x; kk[4 * i + 1] = t4.y; kk[4 * i + 2] = t4.z; kk[4 * i + 3] = t4.w; }
#pragma unroll
                    for (int i = 0; i < 16; ++i) { S[i] = k[i] * S[i] + kk[i] * vv; o += q[i] * S[i]; }
                } else if (KIND == 1) {
#pragma unroll
                    for (int i = 0; i < 16; ++i) { S[i] = gam * S[i] + k[i] * vv; o += q[i] * S[i]; }
                } else {
                    const float alpha = sc[tt * 2], beta = sc[tt * 2 + 1];
                    float r = 0.f;
#pragma unroll
                    for (int i = 0; i < 16; ++i) r += k[i] * S[i];
                    r = quad_sum(r);
                    const float c = beta * (vv - alpha * r);
#pragma unroll
                    for (int i = 0; i < 16; ++i) { S[i] = alpha * S[i] + k[i] * c; o += q[i] * S[i]; }
                }
                o = quad_sum(o);
                if (kg == 0) os[tt * 64 + vcol] = o;
            }
        }
        __syncthreads();
    }
    if (loader) store(NBATCH - 1, (NBATCH - 1) & 1);
    __syncthreads();
}

constexpr int S5_US = 0, S5_YS = 2 * 4 * TB * 16 * 4;
__device__ __forceinline__ void chain_s5(const TC tc, KP P, LAS unsigned char* lds, int l, int item) {
    const int tid = tc.tid, lane = tid & 63, wave = tid >> 6;
    const int b = item >> 3, d = (item >> 2) & 1, gq = item & 3;
    unsigned char* ws = P->ws;
    const bf16_t* Z = (const bf16_t*)(ws + WS_Z);
    bf16_t* O = (bf16_t*)(ws + (d ? WS_OB : WS_OF));
    const bool loader = wave >= 4;
    const int lt = tid - 256, lch = lt >> 6, ltok = (lt >> 1) & 31, lhalf = lt & 1;
    auto load = [&](int n, int bi) {
        const int row = seq_row(b, d, n * TB + ltok);
        const u32x4 u = *(const u32x4*)(Z + (size_t)row * NZ + ZC_SU + gq * 64 + lch * 16 + lhalf * 8);
        LAS float* us = (LAS float*)(lds + S5_US) + ((bi * 4 + lch) * TB + ltok) * 16 + lhalf * 8; const unsigned* pu = (const unsigned*)&u;
#pragma unroll
        for (int e = 0; e < 4; ++e) { us[2 * e] = bflo(pu[e]); us[2 * e + 1] = bfhi(pu[e]); }
    };
    auto store = [&](int n, int bi) {
        const int row = seq_row(b, d, n * TB + ltok);
        const LAS float* ys = (const LAS float*)(lds + S5_YS) + ((bi * 4 + lch) * TB + ltok) * 16 + lhalf * 8;
        u32x4 w; w.x = pk2(ys[0], ys[1]); w.y = pk2(ys[2], ys[3]); w.z = pk2(ys[4], ys[5]); w.w = pk2(ys[6], ys[7]);
        *(u32x4*)(O + (size_t)row * DM + 768 + gq * 64 + lch * 16 + lhalf * 8) = w;
    };
    float bre[16], bim[16], cre[16], cim[16], ar = 0.f, ai = 0.f, hr = 0.f, hi = 0.f;
    if (!loader) {
        const int g = gq * 4 + wave;
        const float* sp = (const float*)(ws + WS_S5P) + ((size_t)((l * 2 + d) * 16 + g) * 64 + lane) * 34;
        ar = sp[0]; ai = sp[1];
#pragma unroll
        for (int c = 0; c < 16; ++c) { bre[c] = sp[2 + c]; bim[c] = sp[18 + c];
            cre[c] = P->in[21][((size_t)(l * 16 + g) * 16 + c) * 64 + lane]; cim[c] = P->in[22][((size_t)(l * 16 + g) * 16 + c) * 64 + lane]; }
    }
    if (loader) load(0, 0);
    __syncthreads();
    for (int n = 0; n < NBATCH; ++n) {
        if (loader) { if (n + 1 < NBATCH) load(n + 1, (n + 1) & 1); if (n >= 1) store(n - 1, (n - 1) & 1); }
        else {
            const LAS float* us = (const LAS float*)(lds + S5_US) + (((n & 1) * 4 + wave) * TB) * 16;
            LAS float* ys = (LAS float*)(lds + S5_YS) + (((n & 1) * 4 + wave) * TB) * 16;
            for (int tt = 0; tt < TB; ++tt) {
                float u[16];
#pragma unroll
                for (int i = 0; i < 4; ++i) { const f32x4 t4 = *(const LAS f32x4*)(us + tt * 16 + 4 * i); u[4 * i] = t4.x; u[4 * i + 1] = t4.y; u[4 * i + 2] = t4.z; u[4 * i + 3] = t4.w; }
                float xr = 0.f, xi = 0.f;
#pragma unroll
                for (int c = 0; c < 16; ++c) { xr += bre[c] * u[c]; xi += bim[c] * u[c]; }
                const float nhr = ar * hr - ai * hi + xr, nhi = ar * hi + ai * hr + xi; hr = nhr; hi = nhi;
                float p[16];
#pragma unroll
                for (int c = 0; c < 16; ++c) p[c] = cre[c] * hr - cim[c] * hi;
                const float tot = reduce16(p, lane);
                if ((lane & 3) == 0) { const int c = 8 * ((lane >> 5) & 1) + 4 * ((lane >> 4) & 1) + 2 * ((lane >> 3) & 1) + ((lane >> 2) & 1); ys[tt * 16 + c] = tot; }
            }
        }
        __syncthreads();
    }
    if (loader) store(NBATCH - 1, (NBATCH - 1) & 1);
    __syncthreads();
}

namespace mx {
constexpr int PITCH = 144, IMG = 64 * PITCH;
__device__ __forceinline__ bf16x8 frag(const LAS unsigned char* img, int t, int ks, int fr, int fq) { return *(const LAS bf16x8*)(img + (t * 16 + fr) * PITCH + (ks * 32 + fq * 8) * 2); }
__device__ __forceinline__ void store4(LAS unsigned char* img, int row, int col0, float a, float b, float c, float d) { u32x2 w; w.x = pk2(a, b); w.y = pk2(c, d); *(LAS u32x2*)(img + row * PITCH + col0 * 2) = w; }
__device__ __forceinline__ float bfe(const u32x2& w, int e) { return e == 0 ? bflo(w.x) : e == 1 ? bfhi(w.x) : e == 2 ? bflo(w.y) : bfhi(w.y); }
__device__ __forceinline__ unsigned rawe(const u32x2& w, int e) { return e == 0 ? (w.x & 0xffffu) : e == 1 ? (w.x >> 16) : e == 2 ? (w.y & 0xffffu) : (w.y >> 16); }
__device__ __forceinline__ void tile10(int idx, int& mt, int& nt) { nt = idx >= 6 ? 3 : idx >= 3 ? 2 : idx >= 1 ? 1 : 0; mt = idx - (nt * (nt + 1)) / 2; }
}
#define MFMA16(a, b, c) __builtin_amdgcn_mfma_f32_16x16x32_bf16(a, b, c, 0, 0, 0)
__device__ __forceinline__ float ex2(float x) { return __builtin_amdgcn_exp2f(x); }
__device__ __forceinline__ float exn(float x) { return __builtin_amdgcn_exp2f(x * 1.4426950408889634f); }

__device__ __forceinline__ void lin_attn_os(const LAS unsigned char* Qg, const LAS unsigned char* VT, const LAS unsigned char* Pm, const LAS unsigned char* KdT, const LAS unsigned char* STc, LAS unsigned char* STn,
                                           f32x4& S0, f32x4& S1, const f32x4 dec, bf16_t* Og, int r0, int dirs, int ocol, int wave, int fr, int fq) {
    const int mt = wave & 3, n0 = wave >> 2, n1 = n0 + 2;
    const bf16x8 vx0 = mx::frag(VT, mt, 0, fr, fq), vx1 = mx::frag(VT, mt, 1, fr, fq), sx0 = mx::frag(STc, mt, 0, fr, fq), sx1 = mx::frag(STc, mt, 1, fr, fq), kx0 = mx::frag(KdT, mt, 0, fr, fq), kx1 = mx::frag(KdT, mt, 1, fr, fq);
    const bf16x8 pa0 = mx::frag(Pm, n0, 0, fr, fq), pa1 = mx::frag(Pm, n0, 1, fr, fq), pb0 = mx::frag(Pm, n1, 0, fr, fq), pb1 = mx::frag(Pm, n1, 1, fr, fq);
    const bf16x8 qa0 = mx::frag(Qg, n0, 0, fr, fq), qa1 = mx::frag(Qg, n0, 1, fr, fq), qb0 = mx::frag(Qg, n1, 0, fr, fq), qb1 = mx::frag(Qg, n1, 1, fr, fq);
    const bf16x8 va0 = mx::frag(VT, n0, 0, fr, fq), va1 = mx::frag(VT, n0, 1, fr, fq), vb0 = mx::frag(VT, n1, 0, fr, fq), vb1 = mx::frag(VT, n1, 1, fr, fq);
    f32x4 oa = (f32x4){0.f, 0.f, 0.f, 0.f}, ob = oa, sa = S0 * dec, sb = S1 * dec;
    oa = MFMA16(vx0, pa0, oa); ob = MFMA16(vx0, pb0, ob); sa = MFMA16(kx0, va0, sa); sb = MFMA16(kx0, vb0, sb);
    oa = MFMA16(vx1, pa1, oa); ob = MFMA16(vx1, pb1, ob); sa = MFMA16(kx1, va1, sa); sb = MFMA16(kx1, vb1, sb);
    oa = MFMA16(sx0, qa0, oa); ob = MFMA16(sx0, qb0, ob);
    oa = MFMA16(sx1, qa1, oa); ob = MFMA16(sx1, qb1, ob);
    S0 = sa; S1 = sb;
    mx::store4(STn, n0 * 16 + fr, mt * 16 + fq * 4, sa[0], sa[1], sa[2], sa[3]);
    mx::store4(STn, n1 * 16 + fr, mt * 16 + fq * 4, sb[0], sb[1], sb[2], sb[3]);
    { const unsigned off = (unsigned)(r0 + dirs * (n0 * 16 + fr)) * DM + ocol + mt * 16 + fq * 4; u32x2 w; w.x = pk2(oa[0], oa[1]); w.y = pk2(oa[2], oa[3]); *(u32x2*)(Og + off) = w; }
    { const unsigned off = (unsigned)(r0 + dirs * (n1 * 16 + fr)) * DM + ocol + mt * 16 + fq * 4; u32x2 w; w.x = pk2(ob[0], ob[1]); w.y = pk2(ob[2], ob[3]); *(u32x2*)(Og + off) = w; }
}

__device__ __forceinline__ void chain_ret(const TC tc, KP P, LAS unsigned char* lds, int l, int chain) {
    const int tid = tc.tid, lane = tid & 63, wave = __builtin_amdgcn_readfirstlane(tid >> 6), fr = lane & 15, fq = lane >> 4;
    const int b = chain >> 3, h = (chain >> 1) & 3, d = chain & 1;
    unsigned char* ws = P->ws;
    const bf16_t* Z = (const bf16_t*)(ws + WS_Z);
    bf16_t* Og = (bf16_t*)(ws + (d ? WS_OB : WS_OF));
    const int ocol = 256 + h * 64;
    const float gam = 1.0f / (1.0f + expf(-P->in[11][(l * 2 + d) * 4 + h])), lg2 = log2f(gam);
    LAS unsigned char* Qn = lds; LAS unsigned char* Kn = lds + mx::IMG; LAS unsigned char* Qg = lds + 2 * mx::IMG; LAS unsigned char* VT = lds + 3 * mx::IMG; LAS unsigned char* KdT = lds + 4 * mx::IMG;
    LAS unsigned char* Pm = lds + 5 * mx::IMG; LAS unsigned char* ST = lds + 6 * mx::IMG;
    for (int i = tid; i < 3 * mx::IMG / 16; i += 512) *(LAS u32x4*)(Pm + i * 16) = (u32x4){0u, 0u, 0u, 0u};
    f32x4 S0 = (f32x4){0.f, 0.f, 0.f, 0.f}, S1 = S0;
    const f32x4 dec = (f32x4){1.f, 1.f, 1.f, 1.f} * exp2f(64.0f * lg2);
    const int tok = tid >> 3, seg = tid & 7, tp = tid & 31, fs = tid >> 5;
    struct RS { u32x4 rq, rk; u32x2 rv0, rv1, rk0, rk1; };
    RS RA, RB;
    auto fetch = [&](int p, RS& R) {
        auto& rq = R.rq; auto& rk = R.rk; auto& rv0 = R.rv0; auto& rv1 = R.rv1; auto& rk0 = R.rk0; auto& rk1 = R.rk1;
        const int r0 = seq_row0(b, d, p * 64), dirs = d ? -1 : 1;
        const bf16_t* zr = Z + ((unsigned)(r0 + dirs * tok) * NZ + h * 64 + seg * 8);
        rq = *(const u32x4*)(zr + ZC_RQ); rk = *(const u32x4*)(zr + ZC_RK);
        const bf16_t* z0 = Z + ((unsigned)(r0 + dirs * 2 * tp) * NZ + h * 64 + fs * 4); const bf16_t* z1 = z0 + dirs * NZ;
        rv0 = *(const u32x2*)(z0 + ZC_RV); rv1 = *(const u32x2*)(z1 + ZC_RV); rk0 = *(const u32x2*)(z0 + ZC_RK); rk1 = *(const u32x2*)(z1 + ZC_RK);
    };
    const float sc = ex2((float)(tok + 1) * lg2), s0 = ex2((float)(63 - 2 * tp) * lg2), s1 = ex2((float)(62 - 2 * tp) * lg2);
    int pmt[2], pnt[2]; float pf[2][4];
#pragma unroll
    for (int hh = 0; hh < 2; ++hh) { int idx = wave + 8 * hh; if (idx >= 10) idx -= 8; mx::tile10(idx, pmt[hh], pnt[hh]);
        const int e0 = 16 * (pnt[hh] - pmt[hh]) + fr - 4 * fq;
#pragma unroll
        for (int r = 0; r < 4; ++r) pf[hh][r] = (e0 - r) >= 0 ? ex2((float)(e0 - r) * lg2) : 0.f; }
    fetch(0, RA); fetch(1, RB);
    __syncthreads();
    auto step = [&](int p, RS& R) {
        auto& rq = R.rq; auto& rk = R.rk; auto& rv0 = R.rv0; auto& rv1 = R.rv1; auto& rk0 = R.rk0; auto& rk1 = R.rk1;
        { *(LAS u32x4*)(Qn + tok * mx::PITCH + seg * 16) = rq; *(LAS u32x4*)(Kn + tok * mx::PITCH + seg * 16) = rk;
          u32x4 g;
          g.x = pk2(bflo(rq.x) * sc, bfhi(rq.x) * sc); g.y = pk2(bflo(rq.y) * sc, bfhi(rq.y) * sc); g.z = pk2(bflo(rq.z) * sc, bfhi(rq.z) * sc); g.w = pk2(bflo(rq.w) * sc, bfhi(rq.w) * sc);
          *(LAS u32x4*)(Qg + tok * mx::PITCH + seg * 16) = g;
#pragma unroll
          for (int e = 0; e < 4; ++e) { const int f = fs * 4 + e;
              *(LAS unsigned*)(VT + f * mx::PITCH + tp * 4) = mx::rawe(rv0, e) | (mx::rawe(rv1, e) << 16);
              *(LAS unsigned*)(KdT + f * mx::PITCH + tp * 4) = pk2(mx::bfe(rk0, e) * s0, mx::bfe(rk1, e) * s1); } }
        __syncthreads();
        if (p + 2 < 68) fetch(p + 2, R);
        { const bf16x8 ka0 = mx::frag(Kn, pmt[0], 0, fr, fq), ka1 = mx::frag(Kn, pmt[0], 1, fr, fq), kb0 = mx::frag(Kn, pmt[1], 0, fr, fq), kb1 = mx::frag(Kn, pmt[1], 1, fr, fq);
          const bf16x8 qa0 = mx::frag(Qn, pnt[0], 0, fr, fq), qa1 = mx::frag(Qn, pnt[0], 1, fr, fq), qb0 = mx::frag(Qn, pnt[1], 0, fr, fq), qb1 = mx::frag(Qn, pnt[1], 1, fr, fq);
          f32x4 a0 = (f32x4){0.f, 0.f, 0.f, 0.f}, a1 = a0;
          a0 = MFMA16(ka0, qa0, a0); a1 = MFMA16(kb0, qb0, a1); a0 = MFMA16(ka1, qa1, a0); a1 = MFMA16(kb1, qb1, a1);
          mx::store4(Pm, pnt[0] * 16 + fr, pmt[0] * 16 + fq * 4, a0[0] * pf[0][0], a0[1] * pf[0][1], a0[2] * pf[0][2], a0[3] * pf[0][3]);
          mx::store4(Pm, pnt[1] * 16 + fr, pmt[1] * 16 + fq * 4, a1[0] * pf[1][0], a1[1] * pf[1][1], a1[2] * pf[1][2], a1[3] * pf[1][3]); }
        __syncthreads();
        lin_attn_os(Qg, VT, Pm, KdT, ST + (p & 1) * mx::IMG, ST + ((p + 1) & 1) * mx::IMG, S0, S1, dec, Og, seq_row0(b, d, p * 64), d ? -1 : 1, ocol, wave, fr, fq);
        __syncthreads();
    };
    for (int p = 0; p < 68; p += 2) { step(p, RA); step(p + 1, RB); }
}

__device__ __forceinline__ void chain_hgrn(const TC tc, KP P, LAS unsigned char* lds, int l, int chain) {
    const int tid = tc.tid, lane = tid & 63, wave = __builtin_amdgcn_readfirstlane(tid >> 6), fr = lane & 15, fq = lane >> 4;
    const int b = chain >> 3, h = (chain >> 1) & 3, d = chain & 1;
    unsigned char* ws = P->ws;
    const bf16_t* Z = (const bf16_t*)(ws + WS_Z);
    bf16_t* Og = (bf16_t*)(ws + (d ? WS_OB : WS_OF));
    const int ocol = h * 64;
    LAS unsigned char* Qa = lds; LAS unsigned char* Qg = lds + mx::IMG; LAS unsigned char* KdT = lds + 2 * mx::IMG; LAS unsigned char* VT = lds + 3 * mx::IMG; LAS unsigned char* Pm = lds + 4 * mx::IMG;
    LAS unsigned char* ST = lds + 5 * mx::IMG; LAS unsigned char* Kr = lds + 7 * mx::IMG;
    LAS float* Bf = (LAS float*)(lds + 11 * mx::IMG);
    LAS unsigned char* LT = lds + 11 * mx::IMG + 16384; LAS unsigned char* Lm = LT + mx::IMG;
    for (int i = tid; i < 64 * 32; i += 512) { const int r = i >> 5, c2 = (i & 31) * 2; *(LAS unsigned*)(Lm + r * mx::PITCH + c2 * 2) = (c2 <= r ? 0x3F80u : 0u) | (c2 + 1 <= r ? 0x3F800000u : 0u); }
    for (int i = tid; i < 3 * mx::IMG / 16; i += 512) *(LAS u32x4*)(Pm + i * 16) = (u32x4){0u, 0u, 0u, 0u};
    f32x4 S0 = (f32x4){0.f, 0.f, 0.f, 0.f}, S1 = S0;
    const int zf = ZC_HF + d * 256 + h * 64;
    struct RS { u32x4 rq, rl; u32x2 rv0, rv1, rl0, rl1; };
    RS RA, RB;
    auto fetch = [&](int p, RS& R) {
        int t2 = tid; asm volatile("" : "+v"(t2)); const int tok = t2 >> 3, seg = t2 & 7, tp = t2 & 31, fs = t2 >> 5;
        auto& rq = R.rq; auto& rl = R.rl; auto& rv0 = R.rv0; auto& rv1 = R.rv1; auto& rl0 = R.rl0; auto& rl1 = R.rl1;
        const int r0 = seq_row0(b, d, p * 64), dirs = d ? -1 : 1;
        const bf16_t* zr = Z + ((unsigned)(r0 + dirs * tok) * NZ + seg * 8);
        rq = *(const u32x4*)(zr + ZC_HQ + h * 64); rl = *(const u32x4*)(zr + zf);
        const bf16_t* z0 = Z + ((unsigned)(r0 + dirs * 2 * tp) * NZ + fs * 4); const bf16_t* z1 = z0 + dirs * NZ;
        rv0 = *(const u32x2*)(z0 + ZC_HI + h * 64); rv1 = *(const u32x2*)(z1 + ZC_HI + h * 64); rl0 = *(const u32x2*)(z0 + zf); rl1 = *(const u32x2*)(z1 + zf);
    };
    int pmt[2], pnt[2];
#pragma unroll
    for (int hh = 0; hh < 2; ++hh) { int idx = wave + 8 * hh; if (idx >= 10) idx -= 8; mx::tile10(idx, pmt[hh], pnt[hh]); }
    const int asub = wave >> 1;
    fetch(0, RA); fetch(1, RB);
    __syncthreads();
    auto step = [&](int p, RS& R) {
        int t2 = tid; asm volatile("" : "+v"(t2)); const int tok = t2 >> 3, seg = t2 & 7, tp = t2 & 31, fs = t2 >> 5;
        auto& rq = R.rq; auto& rl = R.rl; auto& rv0 = R.rv0; auto& rv1 = R.rv1; auto& rl0 = R.rl0; auto& rl1 = R.rl1;
#pragma unroll
        for (int e = 0; e < 4; ++e) *(LAS unsigned*)(LT + (fs * 4 + e) * mx::PITCH + tp * 4) = mx::rawe(rl0, e) | (mx::rawe(rl1, e) << 16);
        __syncthreads();
        { const int mtc = wave & 3, na = wave >> 2, nb = na + 2;
          const bf16x8 x0 = mx::frag(LT, mtc, 0, fr, fq), x1 = mx::frag(LT, mtc, 1, fr, fq), ya0 = mx::frag(Lm, na, 0, fr, fq), ya1 = mx::frag(Lm, na, 1, fr, fq), yb0 = mx::frag(Lm, nb, 0, fr, fq), yb1 = mx::frag(Lm, nb, 1, fr, fq);
          f32x4 a0 = (f32x4){0.f, 0.f, 0.f, 0.f}, a1 = a0;
          a0 = MFMA16(x0, ya0, a0); a1 = MFMA16(x0, yb0, a1); a0 = MFMA16(x1, ya1, a0); a1 = MFMA16(x1, yb1, a1);
          *(LAS f32x4*)(Bf + (na * 16 + fr) * 64 + mtc * 16 + fq * 4) = a0 * 1.4426950408889634f; *(LAS f32x4*)(Bf + (nb * 16 + fr) * 64 + mtc * 16 + fq * 4) = a1 * 1.4426950408889634f; }
        __syncthreads();
        float q[8], kk[8], bb[8];
        { const unsigned* pq = (const unsigned*)&rq; const unsigned* pl = (const unsigned*)&rl;
#pragma unroll
          for (int e = 0; e < 4; ++e) { q[2 * e] = bflo(pq[e]); q[2 * e + 1] = bfhi(pq[e]); kk[2 * e] = 1.0f - exn(bflo(pl[e])); kk[2 * e + 1] = 1.0f - exn(bfhi(pl[e])); } }
        { const f32x4 b0 = *(const LAS f32x4*)(Bf + tok * 64 + seg * 8), b1 = *(const LAS f32x4*)(Bf + tok * 64 + seg * 8 + 4);
          bb[0] = b0[0]; bb[1] = b0[1]; bb[2] = b0[2]; bb[3] = b0[3]; bb[4] = b1[0]; bb[5] = b1[1]; bb[6] = b1[2]; bb[7] = b1[3]; }
        {
          float o[8];
#pragma unroll
          for (int e = 0; e < 8; ++e) o[e] = q[e] * ex2(bb[e]);
          { u32x4 w; w.x = pk2(o[0], o[1]); w.y = pk2(o[2], o[3]); w.z = pk2(o[4], o[5]); w.w = pk2(o[6], o[7]); *(LAS u32x4*)(Qg + tok * mx::PITCH + seg * 16) = w; }
          for (int a2 = asub; a2 < 4; ++a2) {
              float rr[8];
              if (a2 == 0) {
#pragma unroll
                  for (int e = 0; e < 8; ++e) rr[e] = 0.f; }
              else { const f32x4 r0 = *(const LAS f32x4*)(Bf + (16 * a2 - 1) * 64 + seg * 8), r1 = *(const LAS f32x4*)(Bf + (16 * a2 - 1) * 64 + seg * 8 + 4);
                  rr[0] = r0[0]; rr[1] = r0[1]; rr[2] = r0[2]; rr[3] = r0[3]; rr[4] = r1[0]; rr[5] = r1[1]; rr[6] = r1[2]; rr[7] = r1[3]; }
              if (a2 == asub) {
#pragma unroll
                  for (int e = 0; e < 8; ++e) o[e] = q[e] * ex2(bb[e] - rr[e]);
                  u32x4 w; w.x = pk2(o[0], o[1]); w.y = pk2(o[2], o[3]); w.z = pk2(o[4], o[5]); w.w = pk2(o[6], o[7]); *(LAS u32x4*)(Qa + tok * mx::PITCH + seg * 16) = w; }
#pragma unroll
              for (int e = 0; e < 8; ++e) o[e] = kk[e] * ex2(rr[e] - bb[e]);
              u32x4 w; w.x = pk2(o[0], o[1]); w.y = pk2(o[2], o[3]); w.z = pk2(o[4], o[5]); w.w = pk2(o[6], o[7]); *(LAS u32x4*)(Kr + a2 * mx::IMG + tok * mx::PITCH + seg * 16) = w;
          }
#pragma unroll
          for (int e = 0; e < 4; ++e) { const int f = fs * 4 + e; const float b63 = Bf[63 * 64 + f];
              *(LAS unsigned*)(VT + f * mx::PITCH + tp * 4) = mx::rawe(rv0, e) | (mx::rawe(rv1, e) << 16);
              const float k0 = (1.0f - exn(mx::bfe(rl0, e))) * ex2(b63 - Bf[(2 * tp) * 64 + f]), k1 = (1.0f - exn(mx::bfe(rl1, e))) * ex2(b63 - Bf[(2 * tp + 1) * 64 + f]);
              *(LAS unsigned*)(KdT + f * mx::PITCH + tp * 4) = pk2(k0, k1); } }
        __syncthreads();
        for (int rep4 = 0; rep4 < 1 + ((HG_DUP >> 4) & 1); ++rep4) if (p + 2 < 68) fetch(p + 2, R);
        for (int rep3 = 0; rep3 < 1 + ((HG_DUP >> 2) & 1); ++rep3)
        { const LAS unsigned char* KrA = Kr + pnt[0] * mx::IMG; const LAS unsigned char* KrB = Kr + pnt[1] * mx::IMG;
          const bf16x8 ka0 = mx::frag(KrA, pmt[0], 0, fr, fq), ka1 = mx::frag(KrA, pmt[0], 1, fr, fq), kb0 = mx::frag(KrB, pmt[1], 0, fr, fq), kb1 = mx::frag(KrB, pmt[1], 1, fr, fq);
          const bf16x8 qa0 = mx::frag(Qa, pnt[0], 0, fr, fq), qa1 = mx::frag(Qa, pnt[0], 1, fr, fq), qb0 = mx::frag(Qa, pnt[1], 0, fr, fq), qb1 = mx::frag(Qa, pnt[1], 1, fr, fq);
          f32x4 a0 = (f32x4){0.f, 0.f, 0.f, 0.f}, a1 = a0;
          a0 = MFMA16(ka0, qa0, a0); a1 = MFMA16(kb0, qb0, a1); a0 = MFMA16(ka1, qa1, a0); a1 = MFMA16(kb1, qb1, a1);
          const int ea = 16 * (pnt[0] - pmt[0]) + fr - 4 * fq, eb = 16 * (pnt[1] - pmt[1]) + fr - 4 * fq;
          mx::store4(Pm, pnt[0] * 16 + fr, pmt[0] * 16 + fq * 4, ea >= 0 ? a0[0] : 0.f, ea >= 1 ? a0[1] : 0.f, ea >= 2 ? a0[2] : 0.f, ea >= 3 ? a0[3] : 0.f);
          mx::store4(Pm, pnt[1] * 16 + fr, pmt[1] * 16 + fq * 4, eb >= 0 ? a1[0] : 0.f, eb >= 1 ? a1[1] : 0.f, eb >= 2 ? a1[2] : 0.f, eb >= 3 ? a1[3] : 0.f); }
        f32x4 dec; { const f32x4 b63 = *(const LAS f32x4*)(Bf + 63 * 64 + (wave & 3) * 16 + fq * 4); dec = (f32x4){ex2(b63[0]), ex2(b63[1]), ex2(b63[2]), ex2(b63[3])}; }
        __syncthreads();
        if (HG_DUP & 8) { f32x4 t0 = S0, t1 = S1; lin_attn_os(Qg, VT, Pm, KdT, ST + (p & 1) * mx::IMG, ST + ((p + 1) & 1) * mx::IMG, t0, t1, dec, Og, seq_row0(b, d, p * 64), d ? -1 : 1, ocol, wave, fr, fq); asm volatile("" :: "v"(t0), "v"(t1)); }
        lin_attn_os(Qg, VT, Pm, KdT, ST + (p & 1) * mx::IMG, ST + ((p + 1) & 1) * mx::IMG, S0, S1, dec, Og, seq_row0(b, d, p * 64), d ? -1 : 1, ocol, wave, fr, fq);
        __syncthreads();
    };
    for (int p = 0; p < 68; p += 2) { step(p, RA); step(p + 1, RB); }
}

__device__ __forceinline__ int nat_row(int b, int c, int t) { return c < 4 ? b * TCTX + c * 64 + t : MCTX + b * TLAT + (c - 4) * 64 + t; }
constexpr int GP_WAVE = 64 * 68 * 4 + 512;
static_assert(8 * GP_WAVE <= LDS_BYTES - 64, "gdnpre LDS");
__device__ __forceinline__ void phase_gdnpre(const TC tc, KP P, LAS unsigned char* lds, int l) {
    const int tid = tc.tid, wave = __builtin_amdgcn_readfirstlane(tid >> 6);
    unsigned char* ws = P->ws;
    bf16_t* Z = (bf16_t*)(ws + WS_Z);
    const bf16_t* QC = (const bf16_t*)(ws + WS_HB);
    float* AB = (float*)(ws + WS_AB);
    LAS unsigned char* wl = lds + wave * GP_WAVE;
    LAS unsigned char* Kn = wl; LAS float* Af = (LAS float*)wl; LAS float* gb = (LAS float*)(wl + 64 * 68 * 4);
    for (int task = tc.bid * 8 + wave; task < NB * 68 * 4 * 2; task += tc.G * 8) {
        int t2 = tid; asm volatile("" : "+v"(t2)); const int lane = t2 & 63, fr = lane & 15, fq = lane >> 4;
        const int d = task & 1, h = (task >> 1) & 3, c = (task >> 3) % 68, b = (task >> 3) / 68;
        const int cb = __builtin_amdgcn_readfirstlane(nat_row(b, c, 0));
#pragma unroll
        for (int it = 0; it < 8; ++it) { const int row = it * 8 + (lane >> 3), seg = lane & 7;
            *(LAS u32x4*)(Kn + row * mx::PITCH + seg * 16) = *(const u32x4*)(QC + ((unsigned)(cb + row) * 768 + 256 + h * 64 + seg * 8)); }
        { const int t = d ? 63 - lane : lane; const float* ab = AB + (unsigned)(cb + t) * 16; float g = ab[d * 4 + h]; const float be = ab[8 + d * 4 + h];
#pragma unroll
          for (int o = 1; o < 64; o <<= 1) { const float x = __shfl_up(g, o); if (lane >= o) g += x; }
          AB[(unsigned)(cb + lane) * 16 + d * 4 + h] = g;
          gb[lane] = g; gb[64 + lane] = be; }
        asm volatile("s_waitcnt lgkmcnt(0)" ::: "memory");
        bf16x8 kf[4][2];
#pragma unroll
        for (int mt = 0; mt < 4; ++mt) { kf[mt][0] = mx::frag(Kn, mt, 0, fr, fq); kf[mt][1] = mx::frag(Kn, mt, 1, fr, fq); }
        asm volatile("s_waitcnt lgkmcnt(0)" ::: "memory");
#pragma unroll
        for (int nt = 0; nt < 4; ++nt) { const int n = nt * 16 + fr, i = d ? 63 - n : n; const float gi = gb[i], bi = gb[64 + i];
#pragma unroll
            for (int mt = 0; mt < 4; ++mt) { f32x4 kk = (f32x4){0.f, 0.f, 0.f, 0.f}; kk = MFMA16(kf[mt][0], kf[nt][0], kk); kk = MFMA16(kf[mt][1], kf[nt][1], kk);
                const int m0 = mt * 16 + fq * 4; float v[4];
#pragma unroll
                for (int r = 0; r < 4; ++r) { const int j = d ? 63 - (m0 + r) : m0 + r; v[r] = j < i ? bi * kk[r] * exn(gi - gb[j]) : 0.f; }
                if (d) *(LAS f32x4*)(Af + i * 68 + (60 - m0)) = (f32x4){v[3], v[2], v[1], v[0]}; else *(LAS f32x4*)(Af + i * 68 + m0) = (f32x4){v[0], v[1], v[2], v[3]};
                asm volatile("" ::: "memory"); } }
        asm volatile("s_waitcnt lgkmcnt(0)" ::: "memory");
        {
            LAS unsigned char* Tl = wl + lane * 2;
            float T[64]; f32x4 rw[16];
            rw[0] = *(const LAS f32x4*)(Af + 68);
            T[0] = (lane == 0) ? 1.0f : 0.0f;
            *(LAS unsigned short*)Tl = (unsigned short)f2bf(T[0]);
#pragma unroll
            for (int i = 1; i < 64; ++i) {
                float ac[4] = {(i == lane) ? 1.0f : 0.0f, 0.f, 0.f, 0.f};
#pragma unroll
                for (int j4 = 0; j4 < (i + 3) / 4; ++j4) {
#pragma unroll
                    for (int e = 0; e < 4; ++e) if (j4 * 4 + e < i) ac[e] -= rw[j4][e] * T[j4 * 4 + e];
                    if (i + 1 < 64) { asm volatile("" ::: "memory"); rw[j4] = *(const LAS f32x4*)(Af + (i + 1) * 68 + j4 * 4); } }
                if (i + 1 < 64 && (i + 4) / 4 > (i + 3) / 4) rw[(i + 3) / 4] = *(const LAS f32x4*)(Af + (i + 1) * 68 + ((i + 3) / 4) * 4);
                const float acc = (ac[0] + ac[1]) + (ac[2] + ac[3]);
                T[i] = acc;
                asm volatile("" ::: "memory");
                *(LAS unsigned short*)(Tl + i * 272) = (unsigned short)f2bf(acc);
            }
        }
        asm volatile("s_waitcnt lgkmcnt(0)" ::: "memory");
#pragma unroll
        for (int it = 0; it < 8; ++it) { const int row = it * 8 + (lane >> 3), seg = lane & 7;
            *(u32x4*)(Z + ((unsigned)(cb + row) * NZ + ZC_GQKV + (h * 2 + d) * 64 + seg * 8)) = *(const LAS u32x4*)(wl + row * 272 + seg * 16); }
        asm volatile("s_waitcnt lgkmcnt(0)" ::: "memory");
    }
}

__device__ __forceinline__ void chain_gdn(const TC tc, KP P, LAS unsigned char* lds, int l, int chain) {
    const int tid = tc.tid, lane = tid & 63, wave = __builtin_amdgcn_readfirstlane(tid >> 6), fr = lane & 15, fq = lane >> 4;
    const int b = chain >> 3, h = (chain >> 1) & 3, d = chain & 1;
    unsigned char* ws = P->ws;
    const bf16_t* Z = (const bf16_t*)(ws + WS_Z);
    const bf16_t* QC = (const bf16_t*)(ws + WS_HB);
    const float* AB = (const float*)(ws + WS_AB);
    bf16_t* Og = (bf16_t*)(ws + (d ? WS_OB : WS_OF));
    const int ocol = 512 + h * 64;
    LAS unsigned char* Tm = lds; LAS unsigned char* QKm = lds + mx::IMG; LAS unsigned char* Kg = lds + 2 * mx::IMG; LAS unsigned char* Qg = lds + 3 * mx::IMG; LAS unsigned char* KdT = lds + 4 * mx::IMG;
    LAS unsigned char* VT = lds + 5 * mx::IMG; LAS unsigned char* RT = lds + 6 * mx::IMG; LAS unsigned char* VnT = lds + 7 * mx::IMG; LAS unsigned char* ST = lds + 8 * mx::IMG;
    LAS unsigned char* Qn = lds + 10 * mx::IMG; LAS unsigned char* Kn = lds + 11 * mx::IMG;
    LAS float* garb = (LAS float*)(lds + 12 * mx::IMG);
    for (int i = tid; i < 2 * mx::IMG / 16; i += 512) *(LAS u32x4*)(ST + i * 16) = (u32x4){0u, 0u, 0u, 0u};
    for (int i = tid; i < mx::IMG / 16; i += 512) *(LAS u32x4*)(QKm + i * 16) = (u32x4){0u, 0u, 0u, 0u};
    f32x4 S0 = (f32x4){0.f, 0.f, 0.f, 0.f}, S1 = S0;
    struct RS { u32x4 rt, rq, rk; u32x2 rv0, rv1, rk0, rk1; float rla, rbe; };
    RS RA, RB; RA.rla = RA.rbe = RB.rla = RB.rbe = 0.f;
    auto fetch = [&](int p, RS& R) {
        int t2 = tid; asm volatile("" : "+v"(t2)); const int tok = t2 >> 3, seg = t2 & 7, tp = t2 & 31, fs = t2 >> 5;
        auto& rt = R.rt; auto& rq = R.rq; auto& rk = R.rk; auto& rv0 = R.rv0; auto& rv1 = R.rv1; auto& rk0 = R.rk0; auto& rk1 = R.rk1; auto& rla = R.rla; auto& rbe = R.rbe;
        const int c = p < 4 ? (d ? 3 - p : p) : 4 + (d ? 67 - p : p - 4);
        const int cb = __builtin_amdgcn_readfirstlane(nat_row(b, c, 0)), r0 = seq_row0(b, d, p * 64), dirs = d ? -1 : 1;
        rt = *(const u32x4*)(Z + ((unsigned)(cb + tok) * NZ + ZC_GQKV + (h * 2 + d) * 64 + seg * 8));
        const bf16_t* qr = QC + ((unsigned)(r0 + dirs * tok) * 768 + h * 64 + seg * 8);
        rq = *(const u32x4*)qr; rk = *(const u32x4*)(qr + 256);
        const bf16_t* z0 = QC + ((unsigned)(r0 + dirs * 2 * tp) * 768 + h * 64 + fs * 4); const bf16_t* z1 = z0 + dirs * 768;
        rv0 = *(const u32x2*)(z0 + 512); rv1 = *(const u32x2*)(z1 + 512); rk0 = *(const u32x2*)(z0 + 256); rk1 = *(const u32x2*)(z1 + 256);
        if (tid < 64) { rla = AB[(unsigned)(cb + tid) * 16 + d * 4 + h]; rbe = AB[(unsigned)(r0 + dirs * tid) * 16 + 8 + d * 4 + h]; }
    };
    fetch(0, RA); fetch(1, RB);
    if (tid < 64) { garb[tid] = RA.rla; garb[64 + tid] = RA.rbe; }
    __syncthreads();
    const int mt = wave & 3, n0 = wave >> 2, n1 = n0 + 2;
    auto step = [&](int p, RS& R, RS& RN) {
        int t2 = tid; asm volatile("" : "+v"(t2)); const int tok = t2 >> 3, seg = t2 & 7, tp = t2 & 31, fs = t2 >> 5;
        auto& rt = R.rt; auto& rq = R.rq; auto& rk = R.rk; auto& rv0 = R.rv0; auto& rv1 = R.rv1; auto& rk0 = R.rk0; auto& rk1 = R.rk1; auto& rla = R.rla; auto& rbe = R.rbe;
        const LAS float* gar = garb + (p & 1) * 128;
        { *(LAS u32x4*)(Tm + tok * mx::PITCH + seg * 16) = rt;
          const float gi = gar[tok], eg = exn(gi);
          { const unsigned* pq = (const unsigned*)&rq; const unsigned* pk = (const unsigned*)&rk; u32x4 wq, wk; unsigned* oq = (unsigned*)&wq; unsigned* ok = (unsigned*)&wk;
#pragma unroll
            for (int e = 0; e < 4; ++e) { oq[e] = pk2(bflo(pq[e]) * eg, bfhi(pq[e]) * eg); ok[e] = pk2(bflo(pk[e]) * eg, bfhi(pk[e]) * eg); }
            *(LAS u32x4*)(Qg + tok * mx::PITCH + seg * 16) = wq; *(LAS u32x4*)(Kg + tok * mx::PITCH + seg * 16) = wk; }
          *(LAS u32x4*)(Qn + tok * mx::PITCH + seg * 16) = rq; *(LAS u32x4*)(Kn + tok * mx::PITCH + seg * 16) = rk;
          const float g63 = gar[63], s0 = exn(g63 - gar[2 * tp]), s1 = exn(g63 - gar[2 * tp + 1]);
#pragma unroll
          for (int e = 0; e < 4; ++e) { const int f = fs * 4 + e;
              *(LAS unsigned*)(VT + f * mx::PITCH + tp * 4) = mx::rawe(rv0, e) | (mx::rawe(rv1, e) << 16);
              *(LAS unsigned*)(KdT + f * mx::PITCH + tp * 4) = pk2(mx::bfe(rk0, e) * s0, mx::bfe(rk1, e) * s1); } }
        __syncthreads();
        if (p + 2 < 68) fetch(p + 2, R);
        const LAS unsigned char* STc = ST + (p & 1) * mx::IMG; LAS unsigned char* STn = ST + ((p + 1) & 1) * mx::IMG;
        { const bf16x8 x0 = mx::frag(Kg, mt, 0, fr, fq), x1 = mx::frag(Kg, mt, 1, fr, fq), ya0 = mx::frag(STc, n0, 0, fr, fq), ya1 = mx::frag(STc, n0, 1, fr, fq), yb0 = mx::frag(STc, n1, 0, fr, fq), yb1 = mx::frag(STc, n1, 1, fr, fq);
          const u32x2 va = *(const LAS u32x2*)(VT + (n0 * 16 + fr) * mx::PITCH + (mt * 16 + fq * 4) * 2), vb = *(const LAS u32x2*)(VT + (n1 * 16 + fr) * mx::PITCH + (mt * 16 + fq * 4) * 2);
          const f32x4 be = *(const LAS f32x4*)(gar + 64 + mt * 16 + fq * 4);
          f32x4 a0 = (f32x4){0.f, 0.f, 0.f, 0.f}, a1 = a0;
          a0 = MFMA16(x0, ya0, a0); a1 = MFMA16(x0, yb0, a1); a0 = MFMA16(x1, ya1, a0); a1 = MFMA16(x1, yb1, a1);
          mx::store4(RT, n0 * 16 + fr, mt * 16 + fq * 4, be[0] * (bflo(va.x) - a0[0]), be[1] * (bfhi(va.x) - a0[1]), be[2] * (bflo(va.y) - a0[2]), be[3] * (bfhi(va.y) - a0[3]));
          mx::store4(RT, n1 * 16 + fr, mt * 16 + fq * 4, be[0] * (bflo(vb.x) - a1[0]), be[1] * (bfhi(vb.x) - a1[1]), be[2] * (bflo(vb.y) - a1[2]), be[3] * (bfhi(vb.y) - a1[3])); }
        { int pm0, pn0, pm1, pn1; { int i0 = wave, i1 = wave + 8; if (i1 >= 10) i1 -= 8; mx::tile10(i0, pm0, pn0); mx::tile10(i1, pm1, pn1); }
          const bf16x8 ka0 = mx::frag(Kn, pm0, 0, fr, fq), ka1 = mx::frag(Kn, pm0, 1, fr, fq), kb0 = mx::frag(Kn, pm1, 0, fr, fq), kb1 = mx::frag(Kn, pm1, 1, fr, fq);
          const bf16x8 qa0 = mx::frag(Qn, pn0, 0, fr, fq), qa1 = mx::frag(Qn, pn0, 1, fr, fq), qb0 = mx::frag(Qn, pn1, 0, fr, fq), qb1 = mx::frag(Qn, pn1, 1, fr, fq);
          f32x4 a0 = (f32x4){0.f, 0.f, 0.f, 0.f}, a1 = a0;
          a0 = MFMA16(ka0, qa0, a0); a1 = MFMA16(kb0, qb0, a1); a0 = MFMA16(ka1, qa1, a0); a1 = MFMA16(kb1, qb1, a1);
          { const int i = pn0 * 16 + fr, j0 = pm0 * 16 + fq * 4; const float gi = gar[i]; const f32x4 gj = *(const LAS f32x4*)(gar + j0);
            mx::store4(QKm, i, j0, j0 <= i ? a0[0] * exn(gi - gj[0]) : 0.f, j0 + 1 <= i ? a0[1] * exn(gi - gj[1]) : 0.f, j0 + 2 <= i ? a0[2] * exn(gi - gj[2]) : 0.f, j0 + 3 <= i ? a0[3] * exn(gi - gj[3]) : 0.f); }
          { const int i = pn1 * 16 + fr, j0 = pm1 * 16 + fq * 4; const float gi = gar[i]; const f32x4 gj = *(const LAS f32x4*)(gar + j0);
            mx::store4(QKm, i, j0, j0 <= i ? a1[0] * exn(gi - gj[0]) : 0.f, j0 + 1 <= i ? a1[1] * exn(gi - gj[1]) : 0.f, j0 + 2 <= i ? a1[2] * exn(gi - gj[2]) : 0.f, j0 + 3 <= i ? a1[3] * exn(gi - gj[3]) : 0.f); } }
        __syncthreads();
        { const bf16x8 x0 = mx::frag(Tm, mt, 0, fr, fq), x1 = mx::frag(Tm, mt, 1, fr, fq), ya0 = mx::frag(RT, n0, 0, fr, fq), ya1 = mx::frag(RT, n0, 1, fr, fq), yb0 = mx::frag(RT, n1, 0, fr, fq), yb1 = mx::frag(RT, n1, 1, fr, fq);
          f32x4 a0 = (f32x4){0.f, 0.f, 0.f, 0.f}, a1 = a0;
          a0 = MFMA16(x0, ya0, a0); a1 = MFMA16(x0, yb0, a1); a0 = MFMA16(x1, ya1, a0); a1 = MFMA16(x1, yb1, a1);
          mx::store4(VnT, n0 * 16 + fr, mt * 16 + fq * 4, a0[0], a0[1], a0[2], a0[3]);
          mx::store4(VnT, n1 * 16 + fr, mt * 16 + fq * 4, a1[0], a1[1], a1[2], a1[3]); }
        __syncthreads();
        { const float dg = exn(gar[63]);
          const bf16x8 vx0 = mx::frag(VnT, mt, 0, fr, fq), vx1 = mx::frag(VnT, mt, 1, fr, fq), sx0 = mx::frag(STc, mt, 0, fr, fq), sx1 = mx::frag(STc, mt, 1, fr, fq), kx0 = mx::frag(KdT, mt, 0, fr, fq), kx1 = mx::frag(KdT, mt, 1, fr, fq);
          const bf16x8 pa0 = mx::frag(QKm, n0, 0, fr, fq), pa1 = mx::frag(QKm, n0, 1, fr, fq), pb0 = mx::frag(QKm, n1, 0, fr, fq), pb1 = mx::frag(QKm, n1, 1, fr, fq);
          const bf16x8 qa0 = mx::frag(Qg, n0, 0, fr, fq), qa1 = mx::frag(Qg, n0, 1, fr, fq), qb0 = mx::frag(Qg, n1, 0, fr, fq), qb1 = mx::frag(Qg, n1, 1, fr, fq);
          const bf16x8 va0 = mx::frag(VnT, n0, 0, fr, fq), va1 = mx::frag(VnT, n0, 1, fr, fq), vb0 = mx::frag(VnT, n1, 0, fr, fq), vb1 = mx::frag(VnT, n1, 1, fr, fq);
          f32x4 oa = (f32x4){0.f, 0.f, 0.f, 0.f}, ob = oa, sa = S0 * dg, sb = S1 * dg;
          oa = MFMA16(vx0, pa0, oa); ob = MFMA16(vx0, pb0, ob); sa = MFMA16(kx0, va0, sa); sb = MFMA16(kx0, vb0, sb);
          oa = MFMA16(vx1, pa1, oa); ob = MFMA16(vx1, pb1, ob); sa = MFMA16(kx1, va1, sa); sb = MFMA16(kx1, vb1, sb);
          oa = MFMA16(sx0, qa0, oa); ob = MFMA16(sx0, qb0, ob);
          oa = MFMA16(sx1, qa1, oa); ob = MFMA16(sx1, qb1, ob);
          S0 = sa; S1 = sb;
          mx::store4(STn, n0 * 16 + fr, mt * 16 + fq * 4, sa[0], sa[1], sa[2], sa[3]);
          mx::store4(STn, n1 * 16 + fr, mt * 16 + fq * 4, sb[0], sb[1], sb[2], sb[3]);
          const int r0 = seq_row0(b, d, p * 64), dirs = d ? -1 : 1;
          { const unsigned off = (unsigned)(r0 + dirs * (n0 * 16 + fr)) * DM + ocol + mt * 16 + fq * 4; u32x2 w; w.x = pk2(oa[0], oa[1]); w.y = pk2(oa[2], oa[3]); *(u32x2*)(Og + off) = w; }
          { const unsigned off = (unsigned)(r0 + dirs * (n1 * 16 + fr)) * DM + ocol + mt * 16 + fq * 4; u32x2 w; w.x = pk2(ob[0], ob[1]); w.y = pk2(ob[2], ob[3]); *(u32x2*)(Og + off) = w; } }
        if (tid < 64 && p + 1 < 68) { LAS float* gn = garb + ((p + 1) & 1) * 128; gn[tid] = RN.rla; gn[64 + tid] = RN.rbe; }
        __syncthreads();
    };
    for (int p = 0; p < 68; p += 2) { step(p, RA, RB); step(p + 1, RB, RA); }
}

constexpr int S5_XT = 128 * 80, S5_H = 16 * 272, S5_CH = 2 * S5_XT + 2 * S5_H;
static_assert(4 * S5_CH <= LDS_BYTES - 64, "S5 LDS");
__device__ __forceinline__ void chain_s5m(const TC tc, KP P, LAS unsigned char* lds, int l, int item) {
    const int tid = tc.tid, lane = tid & 63, wave = __builtin_amdgcn_readfirstlane(tid >> 6), fr = lane & 15, fq = lane >> 4;
    const int b = item >> 3, d = (item >> 2) & 1, gq = item & 3, ch = wave & 3, g = gq * 4 + ch;
    const bool isA = wave < 4;
    unsigned char* ws = P->ws;
    const bf16_t* Z = (const bf16_t*)(ws + WS_Z);
    bf16_t* Og = (bf16_t*)(ws + (d ? WS_OB : WS_OF));
    LAS unsigned char* base = lds + ch * S5_CH;
    const float* sp0 = (const float*)(ws + WS_S5P) + (size_t)((l * 2 + d) * 16 + g) * 64 * 34;
    bf16x8 bbf[8], ccf[4]; float ar = 0.f, ai = 0.f, hr = 0.f, hi = 0.f;
    if (isA) {
#pragma unroll
        for (int nt = 0; nt < 8; ++nt) { const int s = nt * 16 + fr, p = s & 63; const float* sp = sp0 + p * 34 + (s < 64 ? 2 : 18) + (fq & 1) * 8;
            u32x4 w = (u32x4){0u, 0u, 0u, 0u};
            if (fq < 2) { w.x = pk2(sp[0], sp[1]); w.y = pk2(sp[2], sp[3]); w.z = pk2(sp[4], sp[5]); w.w = pk2(sp[6], sp[7]); }
            bbf[nt] = __builtin_bit_cast(bf16x8, w); }
#pragma unroll
        for (int ks = 0; ks < 4; ++ks) { const int p0 = ks * 16 + fq * 4;
            const float* cr = P->in[21] + ((size_t)(l * 16 + g) * 16 + fr) * 64 + p0; const float* ci = P->in[22] + ((size_t)(l * 16 + g) * 16 + fr) * 64 + p0;
            u32x4 w; w.x = pk2(cr[0], -ci[0]); w.y = pk2(cr[1], -ci[1]); w.z = pk2(cr[2], -ci[2]); w.w = pk2(cr[3], -ci[3]);
            ccf[ks] = __builtin_bit_cast(bf16x8, w); }
    } else { ar = sp0[lane * 34]; ai = sp0[lane * 34 + 1]; }
    u32x4 uf = (u32x4){0u, 0u, 0u, 0u}, uf2 = uf;
    auto fetchu = [&](int it, u32x4& dst) { if (fq < 2) dst = *(const u32x4*)(Z + ((unsigned)(seq_row0(b, d, it * 16) + (d ? -fr : fr)) * NZ + ZC_SU + g * 16 + fq * 8)); };
    if (isA) { fetchu(0, uf); fetchu(1, uf2); }
    constexpr int NST = TSEQ / 16;
#pragma unroll 1
    for (int it = 0; it < NST + 2; ++it) {
        if (isA) {
            if (it < NST) {
                const bf16x8 ua = __builtin_bit_cast(bf16x8, uf);
                uf = uf2; if (it + 2 < NST) fetchu(it + 2, uf2);
                LAS unsigned char* xt = base + (it & 1) * S5_XT;
#pragma unroll
                for (int nt = 0; nt < 8; ++nt) { f32x4 acc = (f32x4){0.f, 0.f, 0.f, 0.f}; acc = MFMA16(ua, bbf[nt], acc);
                    *(LAS f32x4*)(xt + (nt * 16 + fr) * 80 + fq * 16) = acc; }
            }
            if (it >= 2) {
                const LAS unsigned char* hh = base + 2 * S5_XT + (it & 1) * S5_H;
                f32x4 acc = (f32x4){0.f, 0.f, 0.f, 0.f};
#pragma unroll
                for (int ks = 0; ks < 4; ++ks) acc = MFMA16(ccf[ks], *(const LAS bf16x8*)(hh + fr * 272 + (ks * 32 + fq * 8) * 2), acc);
                const unsigned off = (unsigned)(seq_row0(b, d, (it - 2) * 16) + (d ? -fr : fr)) * DM + 768 + g * 16 + fq * 4; u32x2 w; w.x = pk2(acc[0], acc[1]); w.y = pk2(acc[2], acc[3]);
                *(u32x2*)(Og + off) = w;
            }
        } else if (it >= 1 && it <= NST) {
            const LAS unsigned char* xt = base + ((it - 1) & 1) * S5_XT; LAS unsigned char* hh = base + 2 * S5_XT + ((it - 1) & 1) * S5_H;
#pragma unroll
            for (int tq = 0; tq < 4; ++tq) { const f32x4 xr = *(const LAS f32x4*)(xt + lane * 80 + tq * 16), xi = *(const LAS f32x4*)(xt + (64 + lane) * 80 + tq * 16);
#pragma unroll
                for (int e = 0; e < 4; ++e) { const float nr = ar * hr - ai * hi + xr[e], ni = ar * hi + ai * hr + xi[e]; hr = nr; hi = ni;
                    *(LAS unsigned*)(hh + (tq * 4 + e) * 272 + lane * 4) = pk2(hr, hi); } }
        }
        __syncthreads();
    }
}

#ifndef CHAIN_NEW
#define CHAIN_NEW 15
#endif
__device__ __forceinline__ void phase_mixscan(const TC tc, KP P, LAS unsigned char* lds, int l) {
    for (int item = tc.bid; item < (CHAIN_DUP ? 512 : 256); item += tc.G) {
        const int kind = (item >> 6) & 3, c = item & 63;
        if (item >= 256 && !((CHAIN_DUP >> kind) & 1)) continue;
#ifdef CHAIN_ONLY
        if (kind != CHAIN_ONLY) continue;
#endif
        if (kind == 0) { if (CHAIN_NEW & 1) chain_hgrn(tc, P, lds, l, c); else chain_matrix<0>(tc, P, lds, l, c); }
        else if (kind == 1) { if (CHAIN_NEW & 2) chain_ret(tc, P, lds, l, c); else chain_matrix<1>(tc, P, lds, l, c); }
        else if (kind == 2) { if (CHAIN_NEW & 4) chain_gdn(tc, P, lds, l, c); else chain_matrix<2>(tc, P, lds, l, c); }
        else { if (CHAIN_NEW & 8) chain_s5m(tc, P, lds, l, c); else chain_s5(tc, P, lds, l, c); }
    }
}

__device__ __forceinline__ void phase_combine(const TC tc, KP P, int l, int r0) {
    const int tid = tc.tid, lane = tid & 63, wave = tid >> 6;
    const int gw = tc.bid * 8 + wave, NGW = tc.G * 8;
    unsigned char* ws = P->ws;
    const bf16_t* Z = (const bf16_t*)(ws + WS_Z);
    const bf16_t* OF = (const bf16_t*)(ws + WS_OF); const bf16_t* OB = (const bf16_t*)(ws + WS_OB);
    bf16_t* CAT = (bf16_t*)(ws + WS_HB);
    const float* ghg = P->in[10] + l * 64; const float* ggd = P->in[15] + l * 64; const float* dsk = P->in[23] + l * DG;
    const int hc = (lane & 15) * 4;
    const f32x4 g_h = *(const f32x4*)(ghg + hc), g_g = *(const f32x4*)(ggd + hc);
    const f32x4 dv = *(const f32x4*)(dsk + lane * 4);
    u32x2 cf[4], cb[4], cz[4], nf[4], nb[4], nz[4];
    auto ld = [&](int r, u32x2 (&f)[4], u32x2 (&bk)[4], u32x2 (&z)[4]) {
        const bf16_t* zr = Z + (size_t)r * NZ + lane * 4;
#pragma unroll
        for (int m = 0; m < 4; ++m) { f[m] = *(const u32x2*)(OF + (size_t)r * DM + m * 256 + lane * 4); bk[m] = *(const u32x2*)(OB + (size_t)r * DM + m * 256 + lane * 4); }
        z[0] = *(const u32x2*)(zr + ZC_HG); z[1] = *(const u32x2*)(zr + ZC_RG); z[2] = *(const u32x2*)(zr + ZC_GG); z[3] = *(const u32x2*)(zr + ZC_SU);
    };
    if (r0 + gw < MALL) ld(r0 + gw, nf, nb, nz);
    for (int r = r0 + gw; r < MALL; r += NGW) {
#pragma unroll
        for (int m = 0; m < 4; ++m) { cf[m] = nf[m]; cb[m] = nb[m]; cz[m] = nz[m]; }
        if (r + NGW < MALL) ld(r + NGW, nf, nb, nz);
#pragma unroll
        for (int mx = 0; mx < 3; ++mx) {
            const u32x2 a = cf[mx], bb = cb[mx];
            f32x4 o = (f32x4){bflo(a.x) + bflo(bb.x), bfhi(a.x) + bfhi(bb.x), bflo(a.y) + bflo(bb.y), bfhi(a.y) + bfhi(bb.y)};
            float ss = (o.x * o.x + o.y * o.y) + (o.z * o.z + o.w * o.w);
            ss += __shfl_xor(ss, 1); ss += __shfl_xor(ss, 2); ss += __shfl_xor(ss, 4); ss += __shfl_xor(ss, 8);
            const float rn = rsqrtf(ss * (1.0f / 64.0f) + EPS);
            o = o * rn; if (mx == 0) o = o * g_h; if (mx == 2) o = o * g_g;
            const u32x2 gt = cz[mx];
            u32x2 w; w.x = pk2(o.x * siluf_(bflo(gt.x)), o.y * siluf_(bfhi(gt.x))); w.y = pk2(o.z * siluf_(bflo(gt.y)), o.w * siluf_(bfhi(gt.y)));
            *(u32x2*)(CAT + (size_t)r * DM + mx * 256 + lane * 4) = w;
        }
        { const u32x2 a = cf[3], bb = cb[3], uu = cz[3];
          const float y0 = bflo(a.x) + bflo(bb.x) + bflo(uu.x) * dv.x, y1 = bfhi(a.x) + bfhi(bb.x) + bfhi(uu.x) * dv.y, y2 = bflo(a.y) + bflo(bb.y) + bflo(uu.y) * dv.z, y3 = bfhi(a.y) + bfhi(bb.y) + bfhi(uu.y) * dv.w;
          u32x2 w; w.x = pk2(gelu_tanh(y0), gelu_tanh(y1)); w.y = pk2(gelu_tanh(y2), gelu_tanh(y3));
          *(u32x2*)(CAT + (size_t)r * DM + 768 + lane * 4) = w; }
    }
}

__device__ __forceinline__ void phase_glu(const TC tc, KP P, LAS unsigned char* lds, int l, int r0) {
    const int tid = tc.tid, lane = tid & 63, wave = tid >> 6;
    const int gw = tc.bid * 8 + wave, NGW = tc.G * 8;
    const int ntile = (MALL - r0) / 16;
    if (tc.bid * 8 >= ntile) return;
    unsigned char* ws = P->ws;
    const bf16_t* wg = (const bf16_t*)(ws + WS_W + (size_t)l * SZ_WL + SZ_WIN + SZ_WOUT + SZ_W1 + SZ_W2);
    for (int i = tid; i < 256 * 32; i += 512) { const int n = i >> 5, c = i & 31; *(LAS u32x4*)(lds + n * 528 + c * 16) = *(const u32x4*)(wg + n * 256 + c * 8); }
    __syncthreads();
    bf16_t* CAT = (bf16_t*)(ws + WS_HB);
    const float* bias = P->in[25] + l * DG;
    const int fr = lane & 15, fq = lane >> 4;
    for (int t = gw; t < ntile; t += NGW) {
        bf16_t* rowp = CAT + (size_t)(r0 + t * 16 + fr) * DM + 768;
        bf16x8 af[8];
#pragma unroll
        for (int ks = 0; ks < 8; ++ks) af[ks] = *(const bf16x8*)(rowp + ks * 32 + fq * 8);
        f32x4 acc[16];
#pragma unroll
        for (int nt = 0; nt < 16; ++nt) acc[nt] = (f32x4){0.f, 0.f, 0.f, 0.f};
#pragma unroll
        for (int ks = 0; ks < 8; ++ks)
#pragma unroll
            for (int nt = 0; nt < 16; ++nt) { const bf16x8 wf = *(const LAS bf16x8*)(lds + (nt * 16 + fr) * 528 + (ks * 32 + fq * 8) * 2);
                acc[nt] = __builtin_amdgcn_mfma_f32_16x16x32_bf16(wf, af[ks], acc[nt], 0, 0, 0); if ((nt & 7) == 7) asm volatile("" ::: "memory"); }
#pragma unroll
        for (int nt = 0; nt < 16; ++nt) { const int c = nt * 16 + 4 * fq; asm volatile("" ::: "memory"); const f32x4 bv = *(const f32x4*)(bias + c); const u32x2 y = *(const u32x2*)(rowp + c);
            u32x2 w; w.x = pk2(bflo(y.x) * sigmoidf_(acc[nt][0] + bv[0]), bfhi(y.x) * sigmoidf_(acc[nt][1] + bv[1])); w.y = pk2(bflo(y.y) * sigmoidf_(acc[nt][2] + bv[2]), bfhi(y.y) * sigmoidf_(acc[nt][3] + bv[3]));
            *(u32x2*)(rowp + c) = w; }
    }
}

__device__ __forceinline__ void phase_final(const TC tc, KP P) {
    const int tid = tc.tid, lane = tid & 63, wave = tid >> 6;
    const int gw = tc.bid * 8 + wave, NGW = tc.G * 8;
    const float* g = P->in[29];
    f32x4 gg[4], x[4], nx[4];
#pragma unroll
    for (int j = 0; j < 4; ++j) gg[j] = ((const f32x4*)g)[j * 64 + lane];
    if (gw < MLAT) {
#pragma unroll
        for (int j = 0; j < 4; ++j) nx[j] = ((const f32x4*)(P->out + (size_t)gw * DM))[j * 64 + lane]; }
    for (int r = gw; r < MLAT; r += NGW) {
        float* xr = P->out + (size_t)r * DM;
#pragma unroll
        for (int j = 0; j < 4; ++j) x[j] = nx[j];
        if (r + NGW < MLAT) {
#pragma unroll
            for (int j = 0; j < 4; ++j) nx[j] = ((const f32x4*)(xr + (size_t)NGW * DM))[j * 64 + lane]; }
        float ss = 0.f;
#pragma unroll
        for (int j = 0; j < 4; ++j) ss += (x[j].x * x[j].x + x[j].y * x[j].y) + (x[j].z * x[j].z + x[j].w * x[j].w);
        const float rstd = rsqrtf(wave_sum(ss) * (1.0f / DM) + EPS);
#pragma unroll
        for (int j = 0; j < 4; ++j) ((f32x4*)xr)[j * 64 + lane] = x[j] * rstd * gg[j];
    }
}

#define XB_TMO      128
#define XB_XCNT(j)  (256  + 64 * (j))
#define XB_XSUB(j)  (1280 + 64 * (j))
#define XB_XGEN(j)  (2304 + 64 * (j))
#define XB_TOP      3328
#define XB_TOPGEN   3392
#define XCD_BAR_WORDS 3456
#define XB_SPIN_CAP (1u << 22)
__device__ __forceinline__ unsigned xb_ld(unsigned* p)              { return __hip_atomic_load(p, __ATOMIC_RELAXED, __HIP_MEMORY_SCOPE_AGENT); }
__device__ __forceinline__ unsigned xb_add(unsigned* p, unsigned v) { return __hip_atomic_fetch_add(p, v, __ATOMIC_RELAXED, __HIP_MEMORY_SCOPE_AGENT); }
__device__ __forceinline__ unsigned xb_xcc_id() { return (unsigned)__builtin_amdgcn_s_getreg((3 << 11) | 20) & 0xFu; }
#define XB_SPIN(cond, bar) do { unsigned _sp = 0; while (cond) { __builtin_amdgcn_s_sleep(1); \
    if ((++_sp & 255u) == 0u) { if (xb_ld(&(bar)[XB_TMO])) break; if (_sp > XB_SPIN_CAP) { atomicAdd(&(bar)[XB_TMO], 1u); break; } } } } while (0)
__device__ __forceinline__ void xcd_barrier_complete(unsigned* bar, unsigned x, unsigned G, unsigned& nloc, unsigned& nx) {
    unsigned sum, cnt, mine, sp = 0u;
    for (;;) {
        sum = 0u; cnt = 0u; mine = 0u;
#pragma unroll
        for (unsigned j = 0; j < 16; ++j) { const unsigned c = xb_ld(&bar[XB_XCNT(j)]); sum += c; cnt += (c > 0u) ? 1u : 0u; mine = (j == x) ? c : mine; }
        if (sum == G) break;
        __builtin_amdgcn_s_sleep(1);
        if ((++sp & 255u) == 0u) { if (xb_ld(&bar[XB_TMO])) break; if (sp > XB_SPIN_CAP) { atomicAdd(&bar[XB_TMO], 1u); break; } }
    }
    nloc = mine > 0u ? mine : 1u; nx = cnt > 0u ? cnt : 1u;
}
__device__ __forceinline__ void xcd_barrier(unsigned* bar, volatile LAS unsigned* st, int tid, unsigned G) {
    asm volatile("s_waitcnt vmcnt(0)" ::: "memory");
    __syncthreads();
    if (tid == 0) {
        __builtin_amdgcn_s_waitcnt(0);
        const unsigned x = xb_xcc_id();
        unsigned nloc = st[0], nx = st[1];
        if (nloc == 0u) { xcd_barrier_complete(bar, x, G, nloc, nx); st[0] = nloc; st[1] = nx; }
        const unsigned old = xb_add(&bar[XB_XSUB(x)], 1u);
        const unsigned gen = old / nloc;
        if (old + 1u == (gen + 1u) * nloc) {
            __builtin_amdgcn_fence(__ATOMIC_RELEASE, "agent");
            asm volatile("s_waitcnt vmcnt(0)" ::: "memory");
            const unsigned og = xb_add(&bar[XB_TOP], 1u);
            const unsigned tg = og / nx;
            if (og + 1u == (tg + 1u) * nx) xb_add(&bar[XB_TOPGEN], 1u);
            else XB_SPIN(xb_ld(&bar[XB_TOPGEN]) == tg, bar);
            __builtin_amdgcn_fence(__ATOMIC_ACQUIRE, "agent");
            xb_add(&bar[XB_XGEN(x)], 1u);
            asm volatile("s_waitcnt vmcnt(0)" ::: "memory");
        } else {
            XB_SPIN(xb_ld(&bar[XB_XGEN(x)]) == gen, bar);
            __builtin_amdgcn_fence(__ATOMIC_ACQUIRE, "agent");
            asm volatile("s_waitcnt vmcnt(0)" ::: "memory");
        }
    }
    __syncthreads();
}

__global__ void __launch_bounds__(512, 2) mega(Params Pk) {
    extern __shared__ __attribute__((aligned(16))) unsigned char lds_raw[];
    LAS unsigned char* lds = (LAS unsigned char*)lds_raw;
    cg::grid_group grid = cg::this_grid();
    volatile LAS unsigned* bst = (volatile LAS unsigned*)(lds + LDS_BYTES - 64);
    if (threadIdx.x < 16) bst[threadIdx.x] = 0u;
    __syncthreads();
    if (threadIdx.x == 0) (void)xb_add((unsigned*)(Pk.ws + WS_CTL) + XB_XCNT(xb_xcc_id()), 1u);
#ifndef PROBE_DUP
#define PROBE_DUP 0
#endif
    for (int phx = Pk.ph_lo * 2; phx < Pk.ph_hi * 2; ++phx) {
        const int ph = phx >> 1;
        if (phx & 1) { if (!(PROBE_DUP && ph >= 1 && ph < NPHASE - 1 && ((PROBE_DUP >> ((ph - 1) % NSP)) & 1))) continue; xcd_barrier((unsigned*)(Pk.ws + WS_CTL), bst, threadIdx.x, gridDim.x); }
        KP P = (KP)__builtin_amdgcn_kernarg_segment_ptr();
        asm volatile("" : "+s"(P));
        TC tc; tc.tid = threadIdx.x; tc.bid = blockIdx.x; tc.G = gridDim.x;
        asm volatile("" : "+v"(tc.tid)); asm volatile("" : "+s"(tc.bid)); asm volatile("" : "+s"(tc.G));
        unsigned char* ws = P->ws;
#ifndef PHMASK
#define PHMASK 0xFFFF
#endif
        if (ph == 0) { if (PHMASK & 1) phase_prologue(tc, P, lds); }
        else if (ph == NPHASE - 1) { if (PHMASK & 2) phase_final(tc, P); }
        else {
            const int l = (ph - 1) / NSP, sp = (ph - 1) % NSP;
            const int pm_off = (l == DEPTH - 1) ? 8 : 0, r0 = pm_off * 256, Mrows = MALL - r0;
#define WL(off) ((const bf16_t*)(ws + WS_W + (size_t)l * SZ_WL + (off)))
#define HB_ ((bf16_t*)(ws + WS_HB))
#define XC_ ((float*)(ws + WS_XC))
#define MODL ((const float*)(ws + WS_MOD) + (size_t)l * 9 * 6144)
            switch (sp) {
            case 0: if (PHMASK & (1 << 2)) {
#pragma unroll 1
                      for (int part = (l == 0) ? 1 : 0; part < 2; ++part) {
                          const bool cpart = (l != 0) && part == 0;
                          phase_norm(tc, P, lds, l, 0, (l == 0) ? P->in[0] : (const float*)P->out, (l == 0) ? P->in[2] : (const float*)XC_, (l != 0 && part == 1) ? MCTX : 0, true,
                                     cpart ? (const float*)(ws + WS_OB) : (const float*)nullptr, (const float*)(ws + WS_MOD) + (size_t)8 * 6144 + 5 * DM, cpart ? MCTX : MALL);
                          __syncthreads(); } } break;
            case 1: if (PHMASK & (1 << 3)) { pg8::Gemm g{HB_, WL(0), MALL, NZ, DM, DM}; pg8::StaticOrder S; S.init(MALL, NZ, tc.G, tc.bid); S.KT = DM / 64; pg8::EpiBf<0> E{(bf16_t*)(ws + WS_Z), NZ}; pg8::gemm_phase(tc, lds, g, S, E); } break;
            case 2: if (PHMASK & (1 << 4)) phase_mixpre(tc, P, l); break;
            case 3: if (PHMASK & (1 << 5)) { if (CHAIN_NEW & 4) phase_gdnpre(tc, P, lds, l); } break;
            case 4: if (PHMASK & (1 << 6)) phase_mixscan(tc, P, lds, l); break;
            case 5: if (PHMASK & (1 << 7)) phase_combine(tc, P, l, r0); break;
            case 6: if (PHMASK & (1 << 8)) phase_glu(tc, P, lds, l, r0); break;
            case 7: if (PHMASK & (1 << 9)) { pg8::Gemm g{HB_ + (size_t)r0 * DM, WL(SZ_WIN), Mrows, DM, DM, DM}; pg8::StaticOrder S; S.init(Mrows, DM, tc.G, tc.bid); S.KT = DM / 64;
                      pg8::EpiRes E{(l == 0) ? P->in[0] : (const float*)P->out, (l == 0) ? P->in[2] : (const float*)XC_, P->out, XC_, MODL + 2 * DM, pm_off, nullptr}; pg8::gemm_phase(tc, lds, g, S, E); } break;
            case 8: if (PHMASK & (1 << 10)) phase_norm(tc, P, lds, l, 1, P->out, XC_, r0, false); break;
            case 9: if (PHMASK & (1 << 11)) { pg8::Gemm g{HB_ + (size_t)r0 * DM, WL(SZ_WIN + SZ_WOUT), Mrows, DFF, DM, DM}; pg8::StaticOrder S; S.init(Mrows, DFF, tc.G, tc.bid); S.KT = DM / 64; pg8::EpiBf<1> E{(bf16_t*)(ws + WS_U) + (size_t)r0 * DFF, DFF}; pg8::gemm_phase(tc, lds, g, S, E); } break;
            case 10: if (PHMASK & (1 << 12)) {
                      if (l == 0) {
                          pg8::Gemm g{(const bf16_t*)(ws + WS_U), WL(SZ_WIN + SZ_WOUT + SZ_W1), MALL, DM, DFF, DFF}; pg8::SplitOrder S; S.init(DM, DFF, tc.G, tc.bid);
                          pg8::EpiRes E{P->out, XC_, P->out, XC_, MODL + 5 * DM, 0, (float*)(ws + WS_OB)}; pg8::gemm_phase(tc, lds, g, S, E);
                      } else {
                          pg8::Gemm g{(const bf16_t*)(ws + WS_U) + (size_t)r0 * DFF, WL(SZ_WIN + SZ_WOUT + SZ_W1), Mrows, DM, DFF, DFF}; pg8::StaticOrder S; S.init(Mrows, DM, tc.G, tc.bid); S.KT = DFF / 64;
                          pg8::EpiRes E{P->out, XC_, P->out, XC_, MODL + 5 * DM, pm_off, nullptr}; pg8::gemm_phase(tc, lds, g, S, E); }
                  } break;
            }
        }
        if (ph + 1 < Pk.ph_hi) { if (ph == Pk.ph_lo) grid.sync(); else xcd_barrier((unsigned*)(P->ws + WS_CTL), bst, tc.tid, (unsigned)tc.G); }
    }
}

extern "C" void kernel_launch(void* const* d_in, const int* in_sizes, int n_in, void* d_out, int out_size, void* d_ws, size_t ws_size, hipStream_t stream) {
    static int grid = 0;
    if (grid == 0) {
        if (n_in != 30 || in_sizes[0] != MLAT * DM || out_size != MLAT * DM || ws_size < WS_TOTAL) {
            fprintf(stderr, "kernel_launch: unexpected shapes: n_in %d in0 %d out %d ws %zu (need %zu)\n", n_in, n_in > 0 ? in_sizes[0] : -1, out_size, ws_size, (size_t)WS_TOTAL); grid = -1; return; }
        int dev = 0, cus = 0, per_cu = 0;
        hipGetDevice(&dev); hipDeviceGetAttribute(&cus, hipDeviceAttributeMultiprocessorCount, dev);
        if (hipFuncSetAttribute((const void*)mega, hipFuncAttributeMaxDynamicSharedMemorySize, LDS_BYTES) != hipSuccess) { fprintf(stderr, "kernel_launch: hipFuncSetAttribute failed\n"); grid = -1; return; }
        if (hipOccupancyMaxActiveBlocksPerMultiprocessor(&per_cu, (const void*)mega, 512, LDS_BYTES) != hipSuccess || per_cu < 1) { fprintf(stderr, "kernel_launch: occupancy query failed (%d)\n", per_cu); (void)hipGetLastError(); per_cu = 1; }
        grid = cus * 1;
        if (per_cu < 1) grid = -1;
    }
    if (grid < 0) return;
    if (hipMemsetAsync((char*)d_ws + WS_CTL, 0, CTL_BYTES, stream) != hipSuccess) { fprintf(stderr, "kernel_launch: memset failed\n"); return; }
    Params p{};
    for (int i = 0; i < 30; ++i) p.in[i] = (const float*)d_in[i];
    p.out = (float*)d_out; p.ws = (unsigned char*)d_ws;
#if MK_MULTI
    for (int ph = 0; ph < NPHASE; ++ph) { p.ph_lo = ph; p.ph_hi = ph + 1; hipLaunchKernelGGL(mega, dim3(grid), dim3(512), LDS_BYTES, stream, p); }
#else
    p.ph_lo = 0; p.ph_hi = NPHASE;
    void* args[] = {&p};
    hipError_t e = hipLaunchCooperativeKernel((const void*)mega, dim3(grid), dim3(512), args, LDS_BYTES, stream);
    if (e != hipSuccess) fprintf(stderr, "cooperative launch failed: %s (grid %d)\n", hipGetErrorString(e), grid);
#endif
}
```
